# Optimizing an MI355X kernel written in HIP

```python
import jax, jax.numpy as jnp
from jax import lax
import numpy as np

D_MODEL = 1024
BATCH = 8
SEQ = 8192
DEPTH = 4

N_A_LAYERS = DEPTH // 2
N_B_LAYERS = DEPTH - N_A_LAYERS
BLK = 128
FOX_HEADS = 16
FOX_HEAD_DIM = D_MODEL // FOX_HEADS
FOX_WIDTH = FOX_HEADS * FOX_HEAD_DIM
FOX_IN = 4 * FOX_WIDTH + FOX_HEADS
DIL_GROUPS = ((128, 1), (512, 4), (2048, 16))
N_GROUPS = len(DIL_GROUPS)
DIL_HEADS = 8
DIL_HEAD_DIM = D_MODEL // DIL_HEADS
DIL_WIDTH = DIL_HEADS * DIL_HEAD_DIM
DIL_IN = (N_GROUPS + 1) * DIL_WIDTH
KV_OUT = 2 * N_GROUPS * DIL_WIDTH
REL_BUCKETS = 32
REL_MAX_DIST = 2048
RMS_EPS = 1e-6
NEG = -1e30

kernel_name = "yoco_fox_dilated_hybrid"


def rmsnorm(x, g):
    x32 = x.astype(jnp.float32)
    y = x32 * lax.rsqrt(jnp.mean(x32 * x32, axis=-1, keepdims=True) + RMS_EPS) * g.astype(jnp.float32)
    return y.astype(x.dtype)


def t5_bucket(dist):
    d = np.asarray(dist)
    exact = REL_BUCKETS // 2
    large = exact + (np.log(np.maximum(d, 1) / exact) / np.log(REL_MAX_DIST / exact)
                     * (REL_BUCKETS - exact)).astype(np.int32)
    large = np.minimum(large, REL_BUCKETS - 1)
    return np.where(d < exact, d, large).astype(np.int32)


def fox_attention(q, k, v, c):
    bsz, seq, nh, hd = q.shape
    nb = seq // BLK
    scale = hd ** -0.5
    q_blocks = (q.astype(jnp.float32) * scale).reshape(bsz, nb, BLK, nh, hd).transpose(1, 0, 2, 3, 4)
    c_t = c.transpose(0, 2, 1)
    c_blocks = c.reshape(bsz, nb, BLK, nh).transpose(1, 0, 3, 2)
    offs = jnp.arange(BLK)

    def one_block(args):
        i, qi, ci = args
        q_pos = i * BLK + offs

        def step(j, carry):
            m, l, acc = carry
            kj = lax.dynamic_slice_in_dim(k, j * BLK, BLK, axis=1).astype(jnp.float32)
            vj = lax.dynamic_slice_in_dim(v, j * BLK, BLK, axis=1).astype(jnp.float32)
            cj = lax.dynamic_slice_in_dim(c_t, j * BLK, BLK, axis=2)
            s = jnp.einsum('bqhd,bkhd->bhqk', qi, kj) + ci[..., :, None] - cj[..., None, :]
            causal = (j * BLK + offs)[None, :] <= q_pos[:, None]
            s = jnp.where(causal, s, NEG)
            m_new = jnp.maximum(m, s.max(-1))
            p = jnp.exp(s - m_new[..., None])
            corr = jnp.exp(m - m_new)
            l = l * corr + p.sum(-1)
            acc = acc * corr[..., None] + jnp.einsum('bhqk,bkhd->bhqd', p, vj)
            return (m_new, l, acc)

        init = (jnp.full((bsz, nh, BLK), NEG, jnp.float32),
                jnp.zeros((bsz, nh, BLK), jnp.float32),
                jnp.zeros((bsz, nh, BLK, hd), jnp.float32))
        m, l, acc = lax.fori_loop(0, i + 1, step, init)
        return acc / l[..., None]

    out = lax.map(one_block, (jnp.arange(nb), q_blocks, c_blocks))
    return out.transpose(1, 0, 3, 2, 4).reshape(bsz, seq, nh, hd)


def dilated_group(q, k, v, window, dilation, table):
    bsz, seq, nh, hd = q.shape
    span = BLK * dilation
    s_pad = -(-seq // span) * span
    sub_len = s_pad // dilation
    nbl = sub_len // BLK
    steps = window // dilation
    scale = hd ** -0.5

    def to_sub(t):
        t = jnp.pad(t.astype(jnp.float32), ((0, 0), (0, s_pad - seq), (0, 0), (0, 0)))
        return t.reshape(bsz, sub_len, dilation, nh, hd).transpose(0, 2, 1, 3, 4)

    def band(t):
        t = jnp.pad(t, ((0, 0), (0, 0), (BLK, 0), (0, 0), (0, 0))).reshape(bsz, dilation, nbl + 1, BLK, nh, hd)
        return jnp.concatenate([t[:, :, :-1], t[:, :, 1:]], axis=3)

    qs = to_sub(q).reshape(bsz, dilation, nbl, BLK, nh, hd) * scale
    kb = band(to_sub(k))
    vb = band(to_sub(v))

    qi = np.arange(BLK)[:, None]
    ki = np.arange(2 * BLK)[None, :]
    rel = qi + BLK - ki
    in_band = (rel >= 0) & (rel <= steps)
    key_idx = np.arange(nbl)[:, None, None] * BLK + ki[None] - BLK
    valid = jnp.asarray(in_band[None] & (key_idx >= 0))[:, None]
    buckets = t5_bucket(np.clip(rel, 0, steps) * dilation)
    bias = jnp.transpose(table.astype(jnp.float32)[buckets], (2, 0, 1))

    s = jnp.einsum('brnqhe,brnkhe->brnhqk', qs, kb) + bias
    s = jnp.where(valid, s, NEG)
    m = s.max(-1)
    p = jnp.exp(s - m[..., None])
    l = p.sum(-1)
    o = jnp.einsum('brnhqk,brnkhe->brnqhe', p, vb) / jnp.moveaxis(l, 3, 4)[..., None]

    def from_sub(t):
        rest = t.shape[4:]
        t = t.reshape((bsz, dilation, sub_len) + rest)
        t = jnp.moveaxis(t, 1, 2).reshape((bsz, s_pad) + rest)
        return t[:, :seq]

    return from_sub(o), from_sub(jnp.moveaxis(m, 3, 4)), from_sub(jnp.moveaxis(l, 3, 4))


def setup_inputs(seed: int = 0) -> dict:
    key = jax.random.key(seed)
    ks = jax.random.split(key, 12)
    f32 = jnp.float32
    return {
        "x": jax.random.normal(ks[0], (BATCH, SEQ, D_MODEL), f32),
        "rel_bias": 0.5 * jax.random.normal(ks[1], (REL_BUCKETS, N_GROUPS * DIL_HEADS), f32),
        "norm_a": 1.0 + 0.02 * jax.random.normal(ks[2], (N_A_LAYERS, D_MODEL), f32),
        "w_in_a": jax.random.normal(ks[3], (N_A_LAYERS, D_MODEL, FOX_IN), f32) * D_MODEL ** -0.5,
        "b_f_a": jax.random.uniform(ks[4], (N_A_LAYERS, FOX_HEADS), f32, minval=1.0, maxval=6.0),
        "w_out_a": jax.random.normal(ks[5], (N_A_LAYERS, FOX_WIDTH, D_MODEL), f32) * FOX_WIDTH ** -0.5,
        "norm_kv": 1.0 + 0.02 * jax.random.normal(ks[6], (D_MODEL,), f32),
        "w_kv": jax.random.normal(ks[7], (D_MODEL, KV_OUT), f32) * D_MODEL ** -0.5,
        "norm_b": 1.0 + 0.02 * jax.random.normal(ks[8], (N_B_LAYERS, D_MODEL), f32),
        "w_in_b": jax.random.normal(ks[9], (N_B_LAYERS, D_MODEL, DIL_IN), f32) * D_MODEL ** -0.5,
        "w_out_b": jax.random.normal(ks[10], (N_B_LAYERS, DIL_WIDTH, D_MODEL), f32) * DIL_WIDTH ** -0.5,
        "norm_f": 1.0 + 0.02 * jax.random.normal(ks[11], (D_MODEL,), f32),
    }


def reference(x, rel_bias, norm_a, w_in_a, b_f_a, w_out_a, norm_kv, w_kv, norm_b, w_in_b, w_out_b, norm_f):
    bsz, seq, _ = x.shape
    h = x
    k_shared = []
    v_shared = []
    for layer in range(DEPTH):
        if layer < N_A_LAYERS:
            i = layer
            u = rmsnorm(h, norm_a[i]) @ w_in_a[i]
            q = u[..., 0 * FOX_WIDTH:1 * FOX_WIDTH].reshape(bsz, seq, FOX_HEADS, FOX_HEAD_DIM)
            k = u[..., 1 * FOX_WIDTH:2 * FOX_WIDTH].reshape(bsz, seq, FOX_HEADS, FOX_HEAD_DIM)
            v = u[..., 2 * FOX_WIDTH:3 * FOX_WIDTH].reshape(bsz, seq, FOX_HEADS, FOX_HEAD_DIM)
            gate = u[..., 3 * FOX_WIDTH:4 * FOX_WIDTH]
            f_logit = u[..., 4 * FOX_WIDTH:].astype(jnp.float32) + b_f_a[i].astype(jnp.float32)
            c = jnp.cumsum(jax.nn.log_sigmoid(f_logit), axis=1)
            o = fox_attention(q, k, v, c).reshape(bsz, seq, FOX_WIDTH).astype(h.dtype)
            h = h + (o * jax.nn.silu(gate)) @ w_out_a[i]
            if layer == N_A_LAYERS - 1:
                kv = (rmsnorm(h, norm_kv) @ w_kv).reshape(bsz, seq, N_GROUPS, 2, DIL_HEADS, DIL_HEAD_DIM)
                k_shared = [kv[:, :, g, 0] for g in range(N_GROUPS)]
                v_shared = [kv[:, :, g, 1] for g in range(N_GROUPS)]
        else:
            i = layer - N_A_LAYERS
            u = rmsnorm(h, norm_b[i]) @ w_in_b[i]
            gate = u[..., N_GROUPS * DIL_WIDTH:]
            outs, ms, ls = [], [], []
            for g, (window, dilation) in enumerate(DIL_GROUPS):
                qg = u[..., g * DIL_WIDTH:(g + 1) * DIL_WIDTH].reshape(bsz, seq, DIL_HEADS, DIL_HEAD_DIM)
                o_g, m_g, l_g = dilated_group(qg, k_shared[g], v_shared[g], window, dilation,
                                              rel_bias[:, g * DIL_HEADS:(g + 1) * DIL_HEADS])
                outs.append(o_g)
                ms.append(m_g)
                ls.append(l_g)
            m_all = jnp.stack(ms)
            wts = jnp.stack(ls) * jnp.exp(m_all - m_all.max(0, keepdims=True))
            o = jnp.einsum('gbsh,gbshe->bshe', wts, jnp.stack(outs)) / wts.sum(0)[..., None]
            o = o.reshape(bsz, seq, DIL_WIDTH).astype(h.dtype)
            h = h + (o * jax.nn.silu(gate)) @ w_out_b[i]
    return rmsnorm(h, norm_f)
```

```cpp
#include <hip/hip_runtime.h>
#include <hip/hip_cooperative_groups.h>
#include <hip/hip_bf16.h>
#include <cstdio>
#include <cstdint>
#include <cmath>
namespace cg = cooperative_groups;
template <int M> __device__ __forceinline__ float xl_partner_lt32(float v) { static_assert(M >= 1 && M < 32, "xor mask"); return __builtin_bit_cast(float, __builtin_amdgcn_ds_swizzle(__builtin_bit_cast(int, v), (M << 10) | 0x1f)); }
template <int M> __device__ __forceinline__ float xr_sum(float v) { if constexpr (M == 32) { const unsigned u = __builtin_bit_cast(unsigned, v); auto rr = __builtin_amdgcn_permlane32_swap(u, u, false, false); return __builtin_bit_cast(float, (unsigned)rr[0]) + __builtin_bit_cast(float, (unsigned)rr[1]); } else return v + xl_partner_lt32<M>(v); }
template <int M> __device__ __forceinline__ float xr_max(float v) { if constexpr (M == 32) { const unsigned u = __builtin_bit_cast(unsigned, v); auto rr = __builtin_amdgcn_permlane32_swap(u, u, false, false); return __builtin_fmaxf(__builtin_bit_cast(float, (unsigned)rr[0]), __builtin_bit_cast(float, (unsigned)rr[1])); } else return __builtin_fmaxf(v, xl_partner_lt32<M>(v)); }
template <int M> __device__ __forceinline__ float xr_min(float v) { if constexpr (M == 32) { const unsigned u = __builtin_bit_cast(unsigned, v); auto rr = __builtin_amdgcn_permlane32_swap(u, u, false, false); return __builtin_fminf(__builtin_bit_cast(float, (unsigned)rr[0]), __builtin_bit_cast(float, (unsigned)rr[1])); } else return __builtin_fminf(v, xl_partner_lt32<M>(v)); }
__device__ __forceinline__ float xl_from_lane(float v, int src_lane) { return __builtin_bit_cast(float, __builtin_amdgcn_ds_bpermute(src_lane << 2, __builtin_bit_cast(int, v))); }
namespace pg8 {
#define PG8_LAS __attribute__((address_space(3)))
typedef unsigned short bf16_t;
typedef short bf16x8 __attribute__((ext_vector_type(8)));
typedef float f32x4 __attribute__((ext_vector_type(4)));
typedef unsigned u32x4 __attribute__((ext_vector_type(4)));
constexpr int BM = 256, BK = 64, HALF = 128, HTB = HALF * BK * 2  , STAGE_BYTES = 8 * HTB, NXCD = 8, WGM = 8;

__host__ __device__ __forceinline__ int lds_byte(int r, int c) { const int st = (r >> 4) * 2 + (c >> 5), rr = r & 15, cc = c & 31, ob = rr * 64 + cc * 2; return st * 1024 + (ob ^ (((ob >> 9) & 1) << 5)); }
__host__ __device__ __forceinline__ void stage_rc(int b, int& R, int& C) { const int st = b / 1024, sb = b % 1024, swz = sb ^ (((sb >> 9) & 1) << 5); R = (st >> 1) * 16 + swz / 64; C = (st & 1) * 32 + (swz % 64) / 2; }
__host__ __device__ __forceinline__ int perm32(int rho) { const int n = rho >> 4, i = rho & 15; return 8 * (i >> 2) + 4 * n + (i & 3); }

struct Unit { int pm, pn; };
struct Gemm { const bf16_t* A; const bf16_t* Bt; int M, N, K, lda; };

struct StaticOrder {
    int nM, nN, nwg, G, c;
    __host__ __device__ void init(int M, int N, int G_, int c_) { nM = M / BM; nN = N / BM; nwg = nM * nN; G = G_; c = c_; }
    __host__ __device__ bool next(int i, Unit& u) const {
        const long L = (long)i * G + c; if (L >= nwg) return false;
        int wgid = (int)L; { const int q = nwg / NXCD, r = nwg % NXCD, xcd = wgid % NXCD, off = wgid / NXCD; wgid = (xcd < r ? xcd * (q + 1) : r * (q + 1) + (xcd - r) * q) + off; }
        const int nig = WGM * nN, gid = wgid / nig, fm = gid * WGM, gsz = (nM - fm) < WGM ? (nM - fm) : WGM;
        u.pm = fm + ((wgid % nig) % gsz); u.pn = (wgid % nig) / gsz; return true;
    }
    __device__ __forceinline__ void a_ready(const Unit&) const {}
    __device__ __forceinline__ void done(const Unit&) const {}
};

__device__ __forceinline__ unsigned cvt_pk_bf16(float lo, float hi) { unsigned r; asm volatile("v_cvt_pk_bf16_f32 %0, %1, %2" : "=v"(r) : "v"(lo), "v"(hi)); return r; }
constexpr float RMS_EPS_F = 1e-6f;
struct EpiBf16Row {
    static constexpr bool PERM = true, AFTER_DRAIN = false;
    bf16_t* O; int ldc; const float* rowss; int split_cols; size_t split_stride; int qcols; float qscale;
    int kvmode;
    unsigned* nrm;
    __device__ __forceinline__ void prefetch(const Unit& u, int wr, int fr, float (&pre)[8]) const {
        typedef __attribute__((address_space(1))) const float gcf32; const int row0 = u.pm * BM + wr * 64 + fr;
#pragma unroll
        for (int i = 0; i < 8; ++i) pre[i] = ((gcf32*)rowss)[row0 + (i >> 2) * HALF + (i & 3) * 16];
    }
    __device__ __forceinline__ void operator()(const f32x4 (&acc)[2][2][4][2], const Unit& u, int wr, int wc, int fr, int fq, const float (&pre)[8]) const {
        typedef __attribute__((address_space(1))) u32x4 gu32x4;
        const int row0 = u.pm * BM + wr * 64 + fr; int colt = u.pn * BM; bf16_t* base = O;
        const float sc = (colt < qcols) ? qscale : 1.f; int t = 0;
        if (split_cols) { t = colt / split_cols; base += (size_t)t * split_stride; colt -= t * split_cols; }
        const int col0 = colt + wc * 32 + 8 * fq;
        const bool do_n = (nrm != nullptr) && (t < 2);
        float mx[2][2] = {{0.f, 0.f}, {0.f, 0.f}};
#pragma unroll
        for (int ai = 0; ai < 2; ++ai)
#pragma unroll
            for (int m = 0; m < 4; ++m) { const int r = row0 + ai * HALF + m * 16; const float rs = __builtin_amdgcn_rsqf(pre[ai * 4 + m] * (1.0f / 1024.0f) + RMS_EPS_F) * sc;
                bf16_t* rowp = base + (size_t)r * ldc + col0; size_t bjs = HALF;
                if (kvmode) { const int g = colt / 2048, kv = (colt >> 10) & 1, h0 = (colt >> 7) & 7, ld = 2 * g, b = r >> 13, tk = r & 8191;
                    const int pos = ((tk & ((1 << ld) - 1)) << (13 - ld)) + (tk >> ld);
                    rowp = O + ((((size_t)(b * 3 + g) * 2 + kv) * 8 + h0) * 8192 + pos) * 128 + wc * 32 + 8 * fq; bjs = (size_t)8192 * 128; }
#pragma unroll
                for (int bj = 0; bj < 2; ++bj) { const f32x4 v0 = acc[ai][bj][m][0] * rs, v1 = acc[ai][bj][m][1] * rs;
                    u32x4 w; w.x = cvt_pk_bf16(v0[0], v0[1]); w.y = cvt_pk_bf16(v0[2], v0[3]); w.z = cvt_pk_bf16(v1[0], v1[1]); w.w = cvt_pk_bf16(v1[2], v1[3]);
                    *(gu32x4*)(rowp + bj * bjs) = w;
                    if (do_n) { float ss = (v0[0] * v0[0] + v0[1] * v0[1]) + (v0[2] * v0[2] + v0[3] * v0[3]) + (v1[0] * v1[0] + v1[1] * v1[1]) + (v1[2] * v1[2] + v1[3] * v1[3]);
                        ss = xr_sum<16>(ss); ss = xr_sum<32>(ss); mx[ai][bj] = fmaxf(mx[ai][bj], ss); } } }
        if (do_n) {
#pragma unroll
            for (int ai = 0; ai < 2; ++ai)
#pragma unroll
                for (int bj = 0; bj < 2; ++bj) { float v = mx[ai][bj]; v = xr_max<1>(v); v = xr_max<2>(v); v = xr_max<4>(v); v = xr_max<8>(v);
                    if (fr == 0 && fq == 0) { const int b = u.pm >> 5, blk = ((u.pm & 31) << 1) + ai, head = (colt >> 6) + 2 * bj + (wc >> 1);
                        __hip_atomic_fetch_max(nrm + ((((size_t)(t * 8 + b) * 16 + head) * 64 + blk) * 2 + (wc & 1)), __float_as_uint(v), __ATOMIC_RELAXED, __HIP_MEMORY_SCOPE_AGENT); } }
        }
    }
};
constexpr size_t FIN_BSTRIDE = (size_t)8192 * 6144 * 2 / 4;
struct EpiResid {
    static constexpr bool PERM = false, AFTER_DRAIN = false;
    bf16_t* phi; bf16_t* plo; float* fin; float* rowss; int ldc; int dry; const float* xbase;
    template <bool FIN, bool XB> __device__ __forceinline__ void body(const f32x4 (&acc)[2][2][4][2], const Unit& u, int wr, int wc, int fr, int fq) const {
        typedef unsigned u32x2v __attribute__((ext_vector_type(2))); typedef __attribute__((address_space(1))) u32x2v gu2; typedef __attribute__((address_space(1))) f32x4 gf4;
        const int col0 = u.pn * BM + wc * 32 + 4 * fq, rbase = u.pm * BM + wr * 64 + fr;
        u32x2v H[2][4], L[2][4]; typedef __attribute__((address_space(1))) const f32x4 gcf4;
#define PG8_LOADG(g, b) do { const size_t off_ = (size_t)(rbase + ((g) >> 2) * HALF + ((g) & 3) * 16) * ldc + col0; \
        _Pragma("unroll") for (int c = 0; c < 4; ++c) { const size_t o4_ = off_ + (c >> 1) * HALF + (c & 1) * 16; if (XB) { const f32x4 xv_ = *(gcf4*)(xbase + o4_); H[b][c] = (u32x2v){__float_as_uint(xv_[0]), __float_as_uint(xv_[1])}; L[b][c] = (u32x2v){__float_as_uint(xv_[2]), __float_as_uint(xv_[3])}; } \
            else { H[b][c] = *(const gu2*)(phi + o4_); L[b][c] = *(const gu2*)(plo + o4_); } } } while (0)
        PG8_LOADG(0, 0);
#pragma unroll
        for (int g = 0; g < 8; ++g) { const int ai = g >> 2, m = g & 3, cb = g & 1;
            if (g < 7) PG8_LOADG(g + 1, cb ^ 1);
            const int r = rbase + ai * HALF + m * 16; const size_t off = (size_t)r * ldc + col0; float s = 0.f;
            float* frow = FIN ? fin + (size_t)(r >> 13) * FIN_BSTRIDE + (size_t)(r & 8191) * 1024 + col0 : nullptr;
#pragma unroll
            for (int c = 0; c < 4; ++c) { const int bj = c >> 1, n = c & 1; const size_t o4 = off + bj * HALF + n * 16; const u32x2v h = H[cb][c], l = L[cb][c];
                f32x4 o; if (XB) { o[0] = __uint_as_float(h.x); o[1] = __uint_as_float(h.y); o[2] = __uint_as_float(l.x); o[3] = __uint_as_float(l.y); }
                else { o[0] = __uint_as_float(h.x << 16) + __uint_as_float(l.x << 16); o[1] = __uint_as_float(h.x & 0xffff0000u) + __uint_as_float(l.x & 0xffff0000u);
                o[2] = __uint_as_float(h.y << 16) + __uint_as_float(l.y << 16); o[3] = __uint_as_float(h.y & 0xffff0000u) + __uint_as_float(l.y & 0xffff0000u); }
                o = o + acc[ai][bj][m][n];
                s += (o[0] * o[0] + o[1] * o[1]) + (o[2] * o[2] + o[3] * o[3]);
                if (FIN) *(gf4*)(frow + bj * HALF + n * 16) = o;
                else { u32x2v nh; nh.x = cvt_pk_bf16(o[0], o[1]); nh.y = cvt_pk_bf16(o[2], o[3]);
                    u32x2v nl; nl.x = cvt_pk_bf16(o[0] - __uint_as_float(nh.x << 16), o[1] - __uint_as_float(nh.x & 0xffff0000u)); nl.y = cvt_pk_bf16(o[2] - __uint_as_float(nh.y << 16), o[3] - __uint_as_float(nh.y & 0xffff0000u));
                    *(gu2*)(phi + o4) = nh; *(gu2*)(plo + o4) = nl; } }
            s = xr_sum<16>(s); s = xr_sum<32>(s);
            if (rowss && fq == 0) __hip_atomic_fetch_add(rowss + r, s, __ATOMIC_RELAXED, __HIP_MEMORY_SCOPE_AGENT);
        }
#undef PG8_LOADG
    }
    __device__ __forceinline__ void prefetch(const Unit&, int, int, float (&)[8]) const {}
    __device__ __forceinline__ void operator()(const f32x4 (&acc)[2][2][4][2], const Unit& u, int wr, int wc, int fr, int fq, const float (&)[8]) const {
        if (dry) { f32x4 t = acc[0][0][0][0];
#pragma unroll
            for (int a = 0; a < 2; ++a)
#pragma unroll
                for (int b = 0; b < 2; ++b)
#pragma unroll
                    for (int m = 0; m < 4; ++m)
#pragma unroll
                        for (int n = 0; n < 2; ++n) t += acc[a][b][m][n];
            if (t[0] + t[1] + t[2] + t[3] == 1.2345e30f) plo[0] = 0; return; }
        if (fin) body<true, false>(acc, u, wr, wc, fr, fq); else if (xbase) body<false, true>(acc, u, wr, wc, fr, fq); else body<false, false>(acc, u, wr, wc, fr, fq);
    }
};

template <class Epi, class Sched, bool ALIGN_EPI = false, bool SP2 = false>
__device__ __forceinline__ void gemm_phase(PG8_LAS unsigned char* lds, const Gemm g, const Sched& S, const Epi& E, const int tid_in) {
    const int tid = tid_in, wid = __builtin_amdgcn_readfirstlane(tid >> 6), lane = tid & 63, wr = wid >> 2, wc = wid & 3, fr = lane & 15, fq = lane >> 4;
    const int K = g.K, nt = K / BK;
    unsigned voffA[2], voffB[2];
#pragma unroll
    for (int i = 0; i < 2; ++i) { int R, C; stage_rc(tid * 16 + i * 8192, R, C); const int Rb = Epi::PERM ? ((R & ~31) + perm32(R & 31)) : R;
        voffA[i] = (unsigned)(R * g.lda + C) * 2u; voffB[i] = (unsigned)(Rb * K + C) * 2u; }
    const size_t kstep = (size_t)(BK * 2);
    const size_t hstepA = (size_t)HALF * g.lda * 2, hstepB = (size_t)HALF * K * 2;
    const size_t tstepA = 2 * hstepA, tstepB = 2 * hstepB;
    const unsigned ldsw = (unsigned)wid * 1024u;
    const int aoff = lds_byte(wr * 64 + fr, fq * 8), boff = lds_byte(wc * 32 + fr, fq * 8);
#define PG8_SA(b, h) (((b) * 2 + (h)) * HTB)
#define PG8_SB(b, h) ((4 + (b) * 2 + (h)) * HTB)
#define PG8_STAGE(bufoff, gbase, voff) do { _Pragma("unroll") for (int _i = 0; _i < 2; ++_i) \
        __builtin_amdgcn_global_load_lds((const unsigned*)((const char*)(gbase) + (voff)[_i]), (PG8_LAS unsigned*)(lds + (bufoff) + ldsw + _i * 8192), 16, 0, 0); } while (0)
#define PG8_LDA(dst, b, h) do { _Pragma("unroll") for (int m = 0; m < 4; ++m) _Pragma("unroll") for (int k = 0; k < 2; ++k) dst[m][k] = *(const PG8_LAS bf16x8*)(lds + PG8_SA(b, h) + aoff + m * 2048 + k * 1024); } while (0)
#define PG8_LDB(dst, b, h) do { _Pragma("unroll") for (int n = 0; n < 2; ++n) _Pragma("unroll") for (int k = 0; k < 2; ++k) dst[n][k] = *(const PG8_LAS bf16x8*)(lds + PG8_SB(b, h) + boff + n * 2048 + k * 1024); } while (0)
#define PG8_MMA(ai, bj, At, Bt) do { __builtin_amdgcn_s_setprio(1); _Pragma("unroll") for (int m = 0; m < 4; ++m) _Pragma("unroll") for (int n = 0; n < 2; ++n) _Pragma("unroll") for (int k = 0; k < 2; ++k) \
        acc[ai][bj][m][n] = __builtin_amdgcn_mfma_f32_16x16x32_bf16(Bt[n][k], At[m][k], acc[ai][bj][m][n], 0, 0, 0); __builtin_amdgcn_s_setprio(0); } while (0)
#define PG8_WAIT_V(n) asm volatile("s_waitcnt vmcnt(" #n ")" ::: "memory")
#define PG8_WAIT_L(n) asm volatile("s_waitcnt lgkmcnt(" #n ")" ::: "memory")
#define PG8_BAR __builtin_amdgcn_s_barrier()
#define PG8_SCHED __builtin_amdgcn_sched_barrier(0)
    Unit cur, nxt; int ui = 0;
    if (!S.next(0, cur)) return;
    f32x4 acc[2][2][4][2];
    float epre[8];
#pragma unroll
    for (int i = 0; i < 8; ++i) epre[i] = 0.f;
    E.prefetch(cur, wr, fr, epre);
#pragma unroll
    for (int a = 0; a < 2; ++a)
#pragma unroll
        for (int b = 0; b < 2; ++b)
#pragma unroll
            for (int m = 0; m < 4; ++m)
#pragma unroll
                for (int n = 0; n < 2; ++n) acc[a][b][m][n] = (f32x4){0.f, 0.f, 0.f, 0.f};
    bf16x8 At[4][2], B0[2][2], B1[2][2];
    const char* cA = (const char*)g.A + (size_t)cur.pm * tstepA; const char* cB = (const char*)g.Bt + (size_t)cur.pn * tstepB;
    S.a_ready(cur);
    if constexpr (SP2) {
        PG8_STAGE(PG8_SB(0, 0), cB, voffB); PG8_STAGE(PG8_SB(0, 1), cB + hstepB, voffB); PG8_STAGE(PG8_SA(0, 0), cA, voffA); PG8_STAGE(PG8_SA(0, 1), cA + hstepA, voffA);
        if (wr == 1) PG8_BAR;
        PG8_WAIT_V(2); PG8_BAR;
        PG8_STAGE(PG8_SB(1, 0), cB + kstep, voffB); PG8_STAGE(PG8_SA(1, 0), cA + kstep, voffA); PG8_STAGE(PG8_SB(1, 1), cB + hstepB + kstep, voffB);
        PG8_WAIT_V(6); PG8_BAR;
    } else {
        PG8_STAGE(PG8_SB(0, 0), cB, voffB); PG8_STAGE(PG8_SA(0, 0), cA, voffA); PG8_STAGE(PG8_SB(0, 1), cB + hstepB, voffB); PG8_STAGE(PG8_SA(0, 1), cA + hstepA, voffA);
        if (wr == 1) PG8_BAR;
        PG8_WAIT_V(4); PG8_BAR;
        PG8_STAGE(PG8_SB(1, 0), cB + kstep, voffB); PG8_STAGE(PG8_SA(1, 0), cA + kstep, voffA); PG8_STAGE(PG8_SB(1, 1), cB + hstepB + kstep, voffB);
        PG8_WAIT_V(6); PG8_BAR;
    }
    for (;;) {
        const bool has_next = S.next(ui + 1, nxt);
        const char* nA = has_next ? (const char*)g.A + (size_t)nxt.pm * tstepA : cA; const char* nB = has_next ? (const char*)g.Bt + (size_t)nxt.pn * tstepB : cB;
        for (int t = 0; t < nt; t += 2) {
            const bool last = (t == nt - 2);
            const char* a1 = cA + (size_t)(t + 1) * kstep;
            const char* a2 = last ? nA : cA + (size_t)(t + 2) * kstep; const char* b2 = last ? nB : cB + (size_t)(t + 2) * kstep;
            const char* a3 = a2 + kstep; const char* b3 = b2 + kstep;
            if (last && has_next) S.a_ready(nxt);
            if constexpr (SP2) {
            PG8_LDB(B0, 0, 0); PG8_LDB(B1, 0, 1); PG8_SCHED; PG8_LDA(At, 0, 0); PG8_STAGE(PG8_SA(1, 1), a1 + hstepA, voffA);
            PG8_WAIT_V(8); PG8_WAIT_L(0); PG8_BAR; PG8_MMA(0, 0, At, B0); PG8_MMA(0, 1, At, B1); PG8_BAR; PG8_SCHED;
            PG8_LDA(At, 0, 1); PG8_STAGE(PG8_SB(0, 0), b2, voffB); PG8_STAGE(PG8_SB(0, 1), b2 + hstepB, voffB); PG8_STAGE(PG8_SA(0, 0), a2, voffA);
            PG8_WAIT_V(8); PG8_WAIT_L(0); PG8_BAR; PG8_MMA(1, 0, At, B0); PG8_MMA(1, 1, At, B1); PG8_BAR; PG8_SCHED;
            PG8_LDB(B0, 1, 0); PG8_LDB(B1, 1, 1); PG8_SCHED; PG8_LDA(At, 1, 0); PG8_STAGE(PG8_SA(0, 1), a2 + hstepA, voffA);
            PG8_WAIT_V(8); PG8_WAIT_L(0); PG8_BAR; PG8_MMA(0, 0, At, B0); PG8_MMA(0, 1, At, B1); PG8_BAR; PG8_SCHED;
            PG8_LDA(At, 1, 1); PG8_STAGE(PG8_SB(1, 0), b3, voffB); PG8_STAGE(PG8_SB(1, 1), b3 + hstepB, voffB); PG8_STAGE(PG8_SA(1, 0), a3, voffA);
            PG8_WAIT_V(8); PG8_WAIT_L(0); PG8_BAR; PG8_MMA(1, 0, At, B0); PG8_MMA(1, 1, At, B1); PG8_BAR; PG8_SCHED;
            } else {
            PG8_LDB(B0, 0, 0); PG8_SCHED; PG8_LDA(At, 0, 0); PG8_STAGE(PG8_SA(1, 1), a1 + hstepA, voffA);
            PG8_WAIT_L(8); PG8_BAR; PG8_WAIT_L(0); PG8_MMA(0, 0, At, B0); PG8_BAR; PG8_SCHED;
            PG8_LDB(B1, 0, 1); PG8_STAGE(PG8_SB(0, 0), b2, voffB);
            PG8_BAR; PG8_WAIT_L(0); PG8_MMA(0, 1, At, B1); PG8_BAR;
            PG8_LDA(At, 0, 1); PG8_STAGE(PG8_SA(0, 0), a2, voffA);
            PG8_BAR; PG8_WAIT_L(0); PG8_MMA(1, 0, At, B0); PG8_BAR; PG8_SCHED;
            PG8_STAGE(PG8_SB(0, 1), b2 + hstepB, voffB);
            PG8_WAIT_V(6); PG8_BAR; PG8_MMA(1, 1, At, B1); PG8_BAR;
            PG8_LDB(B0, 1, 0); PG8_SCHED; PG8_LDA(At, 1, 0); PG8_STAGE(PG8_SA(0, 1), a2 + hstepA, voffA);
            PG8_WAIT_L(8); PG8_BAR; PG8_WAIT_L(0); PG8_MMA(0, 0, At, B0); PG8_BAR; PG8_SCHED;
            PG8_LDB(B1, 1, 1); PG8_STAGE(PG8_SB(1, 0), b3, voffB);
            PG8_BAR; PG8_WAIT_L(0); PG8_MMA(0, 1, At, B1); PG8_BAR;
            PG8_LDA(At, 1, 1); PG8_STAGE(PG8_SA(1, 0), a3, voffA);
            PG8_BAR; PG8_WAIT_L(0); PG8_MMA(1, 0, At, B0); PG8_BAR; PG8_SCHED;
            PG8_STAGE(PG8_SB(1, 1), b3 + hstepB, voffB);
            PG8_WAIT_V(6); PG8_BAR; PG8_MMA(1, 1, At, B1); PG8_BAR;
            }
        }
        if constexpr (ALIGN_EPI) { if (wr == 0) PG8_BAR; }
        if constexpr (!Epi::AFTER_DRAIN) { E(acc, cur, wr, wc, fr, fq, epre); S.done(cur); if (has_next) E.prefetch(nxt, wr, fr, epre); }
        if (!has_next) break;
#pragma unroll
        for (int a = 0; a < 2; ++a)
#pragma unroll
            for (int b = 0; b < 2; ++b)
#pragma unroll
                for (int m = 0; m < 4; ++m)
#pragma unroll
                    for (int n = 0; n < 2; ++n) acc[a][b][m][n] = (f32x4){0.f, 0.f, 0.f, 0.f};
        cur = nxt; cA = nA; cB = nB; ++ui;
        if constexpr (ALIGN_EPI) { if (wr == 1) PG8_BAR; }
    }
    PG8_WAIT_V(0);
    if constexpr (!ALIGN_EPI) { if (wr == 0) PG8_BAR; }
    PG8_BAR;
    if constexpr (Epi::AFTER_DRAIN) { E.fused(acc, cur, wr, wc, fr, fq, lds, wid, lane); S.done(cur); }
#undef PG8_SA
#undef PG8_SB
#undef PG8_STAGE
#undef PG8_LDA
#undef PG8_LDB
#undef PG8_MMA
#undef PG8_WAIT_V
#undef PG8_WAIT_L
#undef PG8_BAR
#undef PG8_SCHED
}
}
namespace attn_body {
using bf16=__hip_bfloat16;
using bf16x8=__attribute__((ext_vector_type(8)))short;
using s16x4=__attribute__((ext_vector_type(4)))short;
using f32x16=__attribute__((ext_vector_type(16)))float;
using u32x4=__attribute__((ext_vector_type(4)))unsigned;
constexpr int BATCH=8,NHEAD=16,SEQ=8192,D=64,DM=NHEAD*D;
constexpr int NW=8,QBLK=32,QB=QBLK*NW,KVBLK=64,NQB=SEQ/QB;
constexpr int ATTN_PITCH=DM, ATTN_UNIT_ROWS=QB;
__device__ __forceinline__ int crow(int r,int hi){return (r&3)+8*(r>>2)+4*hi;}
#define SBAR() __builtin_amdgcn_sched_barrier(0)
__device__ __forceinline__ void cmask(f32x16&p0,f32x16&p1,int jb,int qrel,int hi){
  const float NEG=-INFINITY; int kb=64*jb+4*hi;
  #pragma unroll
  for(int r=0;r<16;++r){int kv=kb+(r&3)+8*(r>>2); if(kv>qrel)p0[r]=NEG; if(kv+32>qrel)p1[r]=NEG;}
}

constexpr int NSLOT=3, SLOTB=8192;
constexpr int LDS_K=0, LDS_V=NSLOT*SLOTB, LDS_WS=2*NSLOT*SLOTB, LDS_OST=LDS_WS+NW*64*4, LDS_BYTES=LDS_OST+NW*4096;
constexpr int LDS_C2=LDS_BYTES, LDS_REL=LDS_C2+SEQ*4;
constexpr float C2=0.125f*1.4426950408889634f;
__device__ __forceinline__ void glds16(const void*gsrc,unsigned lds_dst){unsigned keep;
  asm volatile("s_mov_b32 %0, m0\n\ts_mov_b32 m0, %2\n\ts_nop 0\n\tglobal_load_lds_dwordx4 %1, off\n\ts_mov_b32 m0, %0":"=&s"(keep):"v"(gsrc),"s"(lds_dst):"memory");}
__device__ __forceinline__ void glds16s(const void*sbase,unsigned voff,unsigned lds_dst){unsigned keep;
  asm volatile("s_mov_b32 %0, m0\n\ts_mov_b32 m0, %3\n\ts_nop 0\n\tglobal_load_lds_dwordx4 %1, %2\n\ts_mov_b32 m0, %0":"=&s"(keep):"v"(voff),"s"(sbase),"s"(lds_dst):"memory");}
__device__ __forceinline__ float max3f(float a,float b,float c){float r;asm("v_max3_f32 %0, %1, %2, %3":"=v"(r):"v"(a),"v"(b),"v"(c));return r;}
__device__ __forceinline__ float max2f(float a,float b){float r;asm("v_max_f32_e32 %0, %1, %2":"=v"(r):"v"(a),"v"(b));return r;}
__device__ __forceinline__ float fadd_s(float a,float b){float r;asm("v_add_f32_e32 %0, %1, %2":"=v"(r):"v"(a),"v"(b));return r;}
__device__ __forceinline__ float fsub_s(float a,float b){float r;asm("v_sub_f32_e32 %0, %1, %2":"=v"(r):"v"(a),"v"(b));return r;}
typedef float f32x2_t __attribute__((ext_vector_type(2))); typedef __bf16 bf16x2_t __attribute__((ext_vector_type(2)));
__device__ __forceinline__ unsigned cvtpk_s(float lo,float hi){f32x2_t v={lo,hi};bf16x2_t b=__builtin_convertvector(v,bf16x2_t);return __builtin_bit_cast(unsigned,b);}
#define WAIT_BAR(N) asm volatile("s_waitcnt vmcnt(" #N ") lgkmcnt(0)\n\ts_barrier":::"memory")

__device__ __forceinline__ void qkt(f32x16&p0,f32x16&p1,const char*Kslot,const bf16x8*qr,int r32,int hi){
  const char*kb=Kslot+hi*1024+r32*16;
  #pragma unroll
  for(int d0=0;d0<4;++d0){
    const bf16x8 b0=*reinterpret_cast<const bf16x8*>(kb+d0*2048);
    const bf16x8 b1=*reinterpret_cast<const bf16x8*>(kb+d0*2048+512);
    {p0=__builtin_amdgcn_mfma_f32_32x32x16_bf16(b0,qr[d0],p0,0,0,0);p1=__builtin_amdgcn_mfma_f32_32x32x16_bf16(b1,qr[d0],p1,0,0,0);}}
}
typedef __attribute__((address_space(3))) const char* lds_cptr;
typedef short v4i16_t __attribute__((ext_vector_type(4)));
__device__ __forceinline__ void kload8(bf16x8*kf,lds_cptr kp){
  kf[0]=*(const __attribute__((address_space(3))) bf16x8*)(kp);      kf[1]=*(const __attribute__((address_space(3))) bf16x8*)(kp+512);
  kf[2]=*(const __attribute__((address_space(3))) bf16x8*)(kp+2048); kf[3]=*(const __attribute__((address_space(3))) bf16x8*)(kp+2560);
  kf[4]=*(const __attribute__((address_space(3))) bf16x8*)(kp+4096); kf[5]=*(const __attribute__((address_space(3))) bf16x8*)(kp+4608);
  kf[6]=*(const __attribute__((address_space(3))) bf16x8*)(kp+6144); kf[7]=*(const __attribute__((address_space(3))) bf16x8*)(kp+6656);
}
__device__ __forceinline__ void kload2(bf16x8*kf,lds_cptr kp,int j){ kf[2*j]=*(const __attribute__((address_space(3))) bf16x8*)(kp+j*2048); kf[2*j+1]=*(const __attribute__((address_space(3))) bf16x8*)(kp+j*2048+512); }
__device__ __forceinline__ s16x4 vtr(lds_cptr p){ return __builtin_bit_cast(s16x4,__builtin_amdgcn_ds_read_tr16_b64_v4i16((__attribute__((address_space(3))) v4i16_t*)p)); }
__device__ __forceinline__ float rowmax(const f32x16&p0,const f32x16&p1){
  float a=max3f(p0[0],p0[1],p1[0]),b=max3f(p0[2],p0[3],p1[1]);a=max3f(a,p1[2],p1[3]);
  #pragma unroll
  for(int r=4;r<16;r+=4){a=max3f(a,p0[r],p0[r+1]);b=max3f(b,p0[r+2],p0[r+3]);a=max3f(a,p1[r],p1[r+1]);b=max3f(b,p1[r+2],p1[r+3]);}
  const float m=max2f(a,b);
  auto rr=__builtin_amdgcn_permlane32_swap(__float_as_uint(m),__float_as_uint(m),false,false);
  return max2f(__uint_as_float(rr[0]),__uint_as_float(rr[1]));
}
__device__ __forceinline__ void pv(f32x16*o,int vb,bf16x8 pa0,bf16x8 pa1,bf16x8 pa2,bf16x8 pa3){
  #pragma unroll
  for(int d0=0;d0<2;++d0){s16x4 lo[4],hi[4];
    #pragma unroll
    for(int ks=0;ks<4;++ks){
      asm volatile("ds_read_b64_tr_b16 %0,%1 offset:%c2":"=&v"(lo[ks]):"v"(vb),"i"(d0*4096+ks*1024):"memory");
      asm volatile("ds_read_b64_tr_b16 %0,%1 offset:%c2":"=&v"(hi[ks]):"v"(vb),"i"(d0*4096+ks*1024+512):"memory");}
    asm volatile("s_waitcnt lgkmcnt(0)":::"memory");SBAR();
    #define PK(k) (bf16x8){lo[k][0],lo[k][1],lo[k][2],lo[k][3],hi[k][0],hi[k][1],hi[k][2],hi[k][3]}
    o[d0]=__builtin_amdgcn_mfma_f32_32x32x16_bf16(pa0,PK(0),o[d0],0,0,0);
    o[d0]=__builtin_amdgcn_mfma_f32_32x32x16_bf16(pa1,PK(1),o[d0],0,0,0);
    o[d0]=__builtin_amdgcn_mfma_f32_32x32x16_bf16(pa2,PK(2),o[d0],0,0,0);
    o[d0]=__builtin_amdgcn_mfma_f32_32x32x16_bf16(pa3,PK(3),o[d0],0,0,0);
    #undef PK
  }
}

#ifndef ATTN_STORE16
#define ATTN_STORE16(p,v) (*(u32x4*)(p)=(v))
#endif
typedef float f32x4_t __attribute__((ext_vector_type(4)));
__device__ __forceinline__ unsigned split2(float v,float&eff){ unsigned w=cvtpk_s(v,0.f); const float h=__uint_as_float(w<<16); w=cvtpk_s(v,fsub_s(v,h)); eff=fadd_s(h,__uint_as_float(w&0xffff0000u)); return w; }
template<int THRL> __device__ __forceinline__ void attn_unit(int b,int h,int qb,const bf16*Q,const bf16*__restrict__ K,const bf16*__restrict__ V,bf16*O,const bf16*__restrict__ Gt,const float*__restrict__ CL,const float*__restrict__ TOT,const float*__restrict__ NRM,char*shm,const int tid_in,unsigned*qown,const unsigned qbase){
  const int tid=tid_in,lane=tid&63,r32=lane&31,hi=lane>>5; const int wid=__builtin_amdgcn_readfirstlane(tid>>6);
  const long rowbase=(long)b*SEQ; const int q0=qb*QB;
  const bf16*Qw=Q+(rowbase+q0+wid*QBLK)*DM+h*D;
  const bf16*Kh=K+rowbase*DM+h*D,*Vh=V+rowbase*DM+h*D;
  const lds_cptr shm3=(lds_cptr)shm;
  const unsigned lds0=(unsigned)(uintptr_t)shm;
  float*wsf=(float*)(shm+LDS_WS)+wid*64;
  const unsigned koff=(unsigned)((lane*DM+wid*8)*2);
  const unsigned voff=(unsigned)(((16*(wid&3)+(lane>>2))*DM+(wid>>2)*32+(lane&3)*8)*2);
  const unsigned kdst=lds0+LDS_K+wid*1024, vdst=lds0+LDS_V+wid*1024;
  #define DMA_K(t,slot) glds16s(Kh+(long)(t)*KVBLK*DM,koff,(unsigned)__builtin_amdgcn_readfirstlane(kdst+(slot)))
  #define DMA_V(t,slot) glds16s(Vh+(long)(t)*KVBLK*DM,voff,(unsigned)__builtin_amdgcn_readfirstlane(vdst+(slot)))
  const char*Kbase=shm+LDS_K; bf16x8 kf[8];
  const lds_cptr kp0=shm3+LDS_K+hi*1024+r32*16; const lds_cptr vp0=shm3+LDS_V+((lane>>4)&1)*32+(lane&3)*8+(4*hi+((lane&15)>>2))*64;
  bf16x8 qr[4];
  #pragma unroll
  for(int d0=0;d0<4;++d0)qr[d0]=*reinterpret_cast<const bf16x8*>(&Qw[(long)r32*DM+d0*16+hi*8]);
  float cq2; int t_start;
  { typedef __attribute__((address_space(3))) float lf32; lf32*relL=(lf32*)(shm3+LDS_REL); __attribute__((address_space(3))) unsigned*c2P=(__attribute__((address_space(3))) unsigned*)(shm3+LDS_C2);
    float tv=0.f,nk0=0.f,nk1=0.f,nq0=0.f,nq1=0.f,nq2=0.f,nq3=0.f;
    const float cqraw=CL[(long)(b*NHEAD+h)*SEQ+q0+wid*QBLK+r32];
    if(wid==0){ tv=TOT[(b*NHEAD+h)*64+lane]; const float*nq=NRM+(long)((0*BATCH+b)*NHEAD+h)*128,*nk=NRM+(long)((1*BATCH+b)*NHEAD+h)*128; nk0=nk[2*lane]; nk1=nk[2*lane+1]; nq0=nq[4*qb]; nq1=nq[4*qb+1]; nq2=nq[4*qb+2]; nq3=nq[4*qb+3]; }
    { const bf16*Kd=K+(rowbase+q0+wid*QBLK+r32)*DM+h*D+hi*8; float dot=0.f; bf16x8 kd[4];
      #pragma unroll
      for(int d0=0;d0<4;++d0)kd[d0]=*reinterpret_cast<const bf16x8*>(Kd+d0*16);
      asm volatile("":"+v"(kd[0]),"+v"(kd[1]),"+v"(kd[2]),"+v"(kd[3]));
      #pragma unroll
      for(int d0=0;d0<4;++d0){
        #pragma unroll
        for(int e=0;e<8;++e)dot+=__uint_as_float((unsigned)(unsigned short)qr[d0][e]<<16)*__uint_as_float((unsigned)(unsigned short)kd[d0][e]<<16); }
      dot=xr_sum<32>(dot);
      dot=xr_min<16>(dot); dot=xr_min<8>(dot); dot=xr_min<4>(dot); dot=xr_min<2>(dot); dot=xr_min<1>(dot);
      if(lane==0)relL[66+wid]=dot; }
    __syncthreads();
    if(wid==0){ float inc=tv;
      _Pragma("unroll") for(int o_=1;o_<64;o_<<=1){ const float y_=xl_from_lane(inc,lane-o_); if(lane>=o_)inc+=y_; }
      const float exc=inc-tv; const float eref=__builtin_bit_cast(float,__builtin_amdgcn_readlane(__builtin_bit_cast(int,exc),2*qb)); relL[lane]=exc-eref;
      const float bk2=nk0+nk1; const float bq2=__builtin_fmaxf(nq0+nq1,nq2+nq3);
      float smin=relL[66]; _Pragma("unroll") for(int w_=1;w_<NW;++w_)smin=__builtin_fminf(smin,relL[66+w_]);
      const float Bj=sqrtf(bq2*bk2)*1.02f,Dj=(inc-eref)*1.4426950408889634f;
      const bool keep=(lane>=2*qb)||!(Dj>=Bj-smin+30.5f);
      const unsigned long long km=__ballot(keep); const int bs_=__ffsll((long long)km)-1; if(lane==0)((__attribute__((address_space(3))) int*)relL)[64]=bs_; }
    __syncthreads();
    const int bs=__builtin_amdgcn_readfirstlane(((__attribute__((address_space(3))) int*)relL)[64]); t_start=2*bs;
    const int NTl=(q0+QB)/KVBLK-t_start;
    const float*clp=CL+(long)(b*NHEAD+h)*SEQ;
    { f32x4_t cv_[4];
      #pragma unroll
      for(int k_=0;k_<4;++k_){ const int i_=tid+k_*NW*64; cv_[k_]=*(const f32x4_t*)(clp+128*bs+4*(i_<NTl*16?i_:tid)); }
      asm volatile("":"+v"(cv_[0]),"+v"(cv_[1]),"+v"(cv_[2]),"+v"(cv_[3]));
      #pragma unroll
      for(int k_=0;k_<4;++k_){ const int i_=tid+k_*NW*64; if(i_<NTl*16){ const f32x4_t v_=cv_[k_]; const float rl_=relL[bs+(i_>>5)]; float e_;
        u32x4 w_; w_.x=split2((v_.x+rl_)*-1.4426950408889634f,e_); w_.y=split2((v_.y+rl_)*-1.4426950408889634f,e_); w_.z=split2((v_.z+rl_)*-1.4426950408889634f,e_); w_.w=split2((v_.w+rl_)*-1.4426950408889634f,e_);
        *(__attribute__((address_space(3))) u32x4*)(c2P+4*i_)=w_; } } }
    cq2=(cqraw+relL[2*qb+(wid>>2)])*1.4426950408889634f;
    __syncthreads(); }
  Kh+=(long)t_start*KVBLK*DM; Vh+=(long)t_start*KVBLK*DM;
  const int NT=(q0+QB)/KVBLK-t_start;
  const __attribute__((address_space(3))) unsigned* c2f=(const __attribute__((address_space(3))) unsigned*)(shm3+LDS_C2)+r32;
  unsigned qxw;
  #define QX() __builtin_bit_cast(bf16x8,(u32x4){hi?0u:0x3f803f80u,hi?0u:qxw,0u,0u})
  #define KEXT(KX0,KX1,t) do{ const unsigned wa_=c2f[(t)*64], wb_=c2f[(t)*64+32]; KX0=__builtin_bit_cast(bf16x8,(u32x4){wa_,0x3f803f80u,0u,0u}); KX1=__builtin_bit_cast(bf16x8,(u32x4){wb_,0x3f803f80u,0u,0u}); }while(0)
  DMA_K(0,0);DMA_V(0,0);DMA_K(1,SLOTB);
  float mhat,l_reg=0.f;f32x16 o[2];o[0]=f32x16{};o[1]=f32x16{}; { float e_; qxw=split2(cq2,e_); mhat=-e_; } const f32x16 zero16=f32x16{};
  const int qrel=wid*QBLK+r32;
  #define CMASK(P0,P1,t) do{int jb_=(t)-(NT-4); if(jb_>=0)cmask(P0,P1,jb_,qrel,hi);}while(0)
  bool resc=false;
  #define START(P0,P1) do{ const float rm=rowmax(P0,P1); resc=false; \
    { float e_; qxw=split2(-fadd_s(mhat,rm),e_); const float dl=fsub_s(-e_,mhat); mhat=-e_; \
      _Pragma("unroll") for(int r=0;r<16;++r){P0[r]=fsub_s(P0[r],dl);P1[r]=fsub_s(P1[r],dl);} } \
    _Pragma("unroll") for(int r=0;r<16;++r)P0[r]=__builtin_amdgcn_exp2f(P0[r]); }while(0)
  #define RESC() do{ if(resc){ asm volatile("s_waitcnt lgkmcnt(0)":::"memory"); \
      _Pragma("unroll") for(int d_=0;d_<2;++d_) _Pragma("unroll") for(int r=0;r<16;++r)o[d_][r]*=wsf[crow(r,hi)]; } }while(0)
  f32x16 pA0,pA1,pB0,pB1;
  int sl_prev=0,sl_cur=0,sl_next=SLOTB;
  #define ROT() do{sl_prev=sl_cur;sl_cur=sl_next;sl_next=(sl_next==(NSLOT-1)*SLOTB)?0:sl_next+SLOTB;}while(0)
  DMA_K(2,2*SLOTB);
  WAIT_BAR(3);
  { bf16x8 kx0_,kx1_; KEXT(kx0_,kx1_,0); const bf16x8 qx_=QX(); pA0=__builtin_amdgcn_mfma_f32_32x32x16_bf16(kx0_,qx_,zero16,0,0,0); pA1=__builtin_amdgcn_mfma_f32_32x32x16_bf16(kx1_,qx_,zero16,0,0,0); }
  qkt(pA0,pA1,Kbase,qr,r32,hi);asm volatile("s_nop 15\n\ts_nop 7":"+v"(pA0),"+v"(pA1));CMASK(pA0,pA1,0);
  START(pA0,pA1);
  _Pragma("unroll") for(int r=0;r<16;++r)pA1[r]=__builtin_amdgcn_exp2f(pA1[r]);
  WAIT_BAR(0);
  DMA_K(3,0);DMA_V(1,SLOTB);
  ROT();
  kload8(kf,kp0+sl_cur);
  WAIT_BAR(2);
  s16x4 vlo[8],vhi[8]; u32x4 pw0,pw1,pw2,pw3;
  #define PKW(P,B) cvtpk_s(P[B],P[B+1])
  #define PAF(k) __builtin_bit_cast(bf16x8,pw##k)
  #define VFR(i) (bf16x8){vlo[i][0],vlo[i][1],vlo[i][2],vlo[i][3],vhi[i][0],vhi[i][1],vhi[i][2],vhi[i][3]}
  #define PIN(x) asm volatile("":"+v"(x))
  #define MX3(a,b,c) __builtin_fmaxf(__builtin_fmaxf((a),(b)),(c))
  #define GAPA(MF,A0,A1,A2,A3,W0,W1,PW) do{ MF; sacc+=A0; sacc+=A1; sacc+=A2; sacc+=A3; PIN(sacc); W0; W1; PIN(PW); SBAR(); }while(0)
  #define EX(v) __builtin_amdgcn_exp2f(v)
  #define GAPB(MF,X,B) do{ MF; X[B]=EX(X[B]); X[B+1]=EX(X[B+1]); X[B+2]=EX(X[B+2]); X[B+3]=EX(X[B+3]); PIN(X); SBAR(); }while(0)
  #define VRD(i) do{ vlo[i]=vtr(vp_+(((i)>>2)*4096+((i)&3)*1024)); vhi[i]=vtr(vp_+(((i)>>2)*4096+((i)&3)*1024+512)); }while(0)
  #define KRD(G,j) do{ if(G){ kload2(kf,kp0+sl_next,j); SBAR(); } }while(0)
  #define STEP(C0,C1,P0,P1,t,GK,GV,GL) do{ SBAR(); \
    { bf16x8 kx0_,kx1_; KEXT(kx0_,kx1_,t); const bf16x8 qx_=QX(); C0=__builtin_amdgcn_mfma_f32_32x32x16_bf16(kx0_,qx_,zero16,0,0,0); C1=__builtin_amdgcn_mfma_f32_32x32x16_bf16(kx1_,qx_,zero16,0,0,0); } SBAR(); \
    const lds_cptr vp_=vp0+sl_prev; \
    VRD(0); SBAR(); float sacc=(P0[0]+P0[1]); \
    GAPA(C0=__builtin_amdgcn_mfma_f32_32x32x16_bf16(kf[0],qr[0],C0,0,0,0), P0[2],P0[3],P0[4],P0[5],     pw0[0]=PKW(P0,0), pw0[1]=PKW(P0,2), pw0); \
    VRD(4); SBAR(); GAPA(C1=__builtin_amdgcn_mfma_f32_32x32x16_bf16(kf[1],qr[0],C1,0,0,0), P0[6],P0[7],P0[8],P0[9],     pw0[2]=PKW(P0,4), pw0[3]=PKW(P0,6), pw0); \
    VRD(1); SBAR(); GAPA(C0=__builtin_amdgcn_mfma_f32_32x32x16_bf16(kf[2],qr[1],C0,0,0,0),   P0[10],P0[11],P0[12],P0[13], pw1[0]=PKW(P0,8), pw1[1]=PKW(P0,10), pw1); \
    VRD(5); SBAR(); GAPA(C1=__builtin_amdgcn_mfma_f32_32x32x16_bf16(kf[3],qr[1],C1,0,0,0),   P0[14],P0[15],P1[0],P1[1],   pw1[2]=PKW(P0,12),pw1[3]=PKW(P0,14), pw1); \
    VRD(2); SBAR(); GAPA(C0=__builtin_amdgcn_mfma_f32_32x32x16_bf16(kf[4],qr[2],C0,0,0,0),   P1[2],P1[3],P1[4],P1[5],     pw2[0]=PKW(P1,0), pw2[1]=PKW(P1,2), pw2); \
    VRD(6); SBAR(); GAPA(C1=__builtin_amdgcn_mfma_f32_32x32x16_bf16(kf[5],qr[2],C1,0,0,0),   P1[6],P1[7],P1[8],P1[9],     pw2[2]=PKW(P1,4), pw2[3]=PKW(P1,6), pw2); \
    VRD(3); SBAR(); GAPA(C0=__builtin_amdgcn_mfma_f32_32x32x16_bf16(kf[6],qr[3],C0,0,0,0),   P1[10],P1[11],P1[12],P1[13], pw3[0]=PKW(P1,8), pw3[1]=PKW(P1,10), pw3); \
    VRD(7); SBAR(); GAPA(C1=__builtin_amdgcn_mfma_f32_32x32x16_bf16(kf[7],qr[3],C1,0,0,0),   P1[14],P1[15],0.f,0.f,       pw3[2]=PKW(P1,12),pw3[3]=PKW(P1,14), pw3); \
    l_reg+=sacc; \
    if(GK){DMA_K((t)+3,sl_cur);} if(GV){DMA_V((t)+1,sl_next);} \
    CMASK(C0,C1,t); \
    { float a=MX3(C0[0],C0[1],C1[0]),b=MX3(C0[2],C0[3],C1[1]); a=MX3(a,C1[2],C1[3]); \
      _Pragma("unroll") for(int r=4;r<16;r+=4){a=MX3(a,C0[r],C0[r+1]);b=MX3(b,C0[r+2],C0[r+3]);a=MX3(a,C1[r],C1[r+1]);b=MX3(b,C1[r+2],C1[r+3]);} \
      float rm=__builtin_fmaxf(a,b); { auto rr=__builtin_amdgcn_permlane32_swap(__float_as_uint(rm),__float_as_uint(rm),false,false); rm=__builtin_fmaxf(__uint_as_float(rr[0]),__uint_as_float(rr[1])); } \
      resc=false; \
      if(__builtin_expect(__any(rm>(float)THRL),0)){ float e_; qxw=split2(-(mhat+__builtin_fmaxf(rm,0.f)),e_); const float dl=-e_-mhat; mhat=-e_; \
        _Pragma("unroll") for(int r=0;r<16;++r){C0[r]-=dl;C1[r]-=dl;} \
        const float f=__builtin_amdgcn_exp2f(-dl); l_reg*=f; if(hi==0)wsf[r32]=f; resc=true; } } \
    SBAR(); \
    GAPB(o[0]=__builtin_amdgcn_mfma_f32_32x32x16_bf16(PAF(0),VFR(0),o[0],0,0,0), C0,0); \
    GAPB(o[1]=__builtin_amdgcn_mfma_f32_32x32x16_bf16(PAF(0),VFR(4),o[1],0,0,0), C0,4); \
    KRD(GL,0); GAPB(o[0]=__builtin_amdgcn_mfma_f32_32x32x16_bf16(PAF(1),VFR(1),o[0],0,0,0), C0,8); \
    KRD(GL,1); GAPB(o[1]=__builtin_amdgcn_mfma_f32_32x32x16_bf16(PAF(1),VFR(5),o[1],0,0,0), C0,12); \
    KRD(GL,2); GAPB(o[0]=__builtin_amdgcn_mfma_f32_32x32x16_bf16(PAF(2),VFR(2),o[0],0,0,0), C1,0); \
    KRD(GL,3); GAPB(o[1]=__builtin_amdgcn_mfma_f32_32x32x16_bf16(PAF(2),VFR(6),o[1],0,0,0), C1,4); \
    GAPB(o[0]=__builtin_amdgcn_mfma_f32_32x32x16_bf16(PAF(3),VFR(3),o[0],0,0,0), C1,8); \
    GAPB(o[1]=__builtin_amdgcn_mfma_f32_32x32x16_bf16(PAF(3),VFR(7),o[1],0,0,0), C1,12); \
    }while(0)
  int t=1;
  #undef CMASK
  #define CMASK(P0,P1,t) do{}while(0)
  for(;t+5<NT;t+=2){
    STEP(pB0,pB1,pA0,pA1,t,true,true,true);     WAIT_BAR(2); RESC(); ROT();
    STEP(pA0,pA1,pB0,pB1,t+1,true,true,true);   WAIT_BAR(2); RESC(); ROT();
  }
  #undef CMASK
  #define CMASK(P0,P1,t) do{int jb_=(t)-(NT-4); if(jb_>=0)cmask(P0,P1,jb_,qrel,hi);}while(0)
  #define ENDW(tt) do{ if((tt)+3<NT){WAIT_BAR(2);} else if((tt)+2<NT){WAIT_BAR(1);} else {WAIT_BAR(0);} }while(0)
  for(;t+1<NT;t+=2){
    STEP(pB0,pB1,pA0,pA1,t,(t+3<NT),(t+1<NT),(t+1<NT));       ENDW(t);   RESC(); ROT();
    STEP(pA0,pA1,pB0,pB1,t+1,(t+4<NT),(t+2<NT),(t+2<NT));     ENDW(t+1); RESC(); ROT();
  }
  STEP(pB0,pB1,pA0,pA1,NT-1,false,false,false); RESC();
  { float sacc=pB0[0]+pB0[1]; _Pragma("unroll") for(int r=2;r<16;++r)sacc+=pB0[r]; _Pragma("unroll") for(int r=0;r<16;++r)sacc+=pB1[r]; l_reg+=sacc;
    pw0=(u32x4){PKW(pB0,0),PKW(pB0,2),PKW(pB0,4),PKW(pB0,6)};pw1=(u32x4){PKW(pB0,8),PKW(pB0,10),PKW(pB0,12),PKW(pB0,14)};pw2=(u32x4){PKW(pB1,0),PKW(pB1,2),PKW(pB1,4),PKW(pB1,6)};pw3=(u32x4){PKW(pB1,8),PKW(pB1,10),PKW(pB1,12),PKW(pB1,14)};
    const int vb0=(int)(lds0+LDS_V)+((lane>>4)&1)*32+(lane&3)*8+(4*hi+((lane&15)>>2))*64;
    SBAR(); pv(o,vb0+sl_cur,PAF(0),PAF(1),PAF(2),PAF(3)); }
  #undef PKW
  #undef PAF
  #undef VFR
  #undef PIN
  #undef MX3
  #undef GAPA
  #undef GAPB
  #undef EX
  #undef VRD
  #undef KRD
  #undef STEP
  #undef ENDW
  unsigned nxt_=0u; if(tid==0)nxt_=__hip_atomic_fetch_add(qown,1u,__ATOMIC_RELAXED,__HIP_MEMORY_SCOPE_AGENT);
  {auto rr=__builtin_amdgcn_permlane32_swap(__float_as_uint(l_reg),__float_as_uint(l_reg),false,false);l_reg=__uint_as_float(rr[0])+__uint_as_float(rr[1]);}
  if(hi==0)wsf[32+r32]=l_reg;asm volatile("s_waitcnt lgkmcnt(0)":::"memory");
  float rli[16];
  #pragma unroll
  for(int r=0;r<16;++r)rli[r]=__builtin_amdgcn_rcpf(wsf[32+crow(r,hi)]);
  bf16*Ow=O+(rowbase+q0+wid*QBLK)*DM+h*D;
  { bf16*stg=(bf16*)(shm+LDS_OST)+wid*2048;
    #pragma unroll
    for(int r=0;r<16;++r){const int orow=crow(r,hi);
      #pragma unroll
      for(int d0=0;d0<2;++d0)stg[orow*64+d0*32+r32]=__float2bfloat16(o[d0][r]*rli[r]);}
    asm volatile("s_waitcnt lgkmcnt(0)":::"memory");
    int le_=lane; asm volatile("":"+v"(le_));
    #pragma unroll
    for(int i=0;i<4;++i){const int row=i*8+(le_>>3),ch=le_&7; const u32x4 v=*(const u32x4*)(stg+row*64+ch*8); const u32x4 gv=*(const u32x4*)(Gt+(rowbase+q0+wid*QBLK+row)*DM+h*D+ch*8); u32x4 w;
      #pragma unroll
      for(int e=0;e<4;++e){ const float o0=__uint_as_float(v[e]<<16),o1=__uint_as_float(v[e]&0xffff0000u),g0=__uint_as_float(gv[e]<<16),g1=__uint_as_float(gv[e]&0xffff0000u);
        const float s0=g0*__builtin_amdgcn_rcpf(1.f+__builtin_amdgcn_exp2f(-1.4426950408889634f*g0)),s1=g1*__builtin_amdgcn_rcpf(1.f+__builtin_amdgcn_exp2f(-1.4426950408889634f*g1)); w[e]=cvtpk_s(o0*s0,o1*s1); }
      ATTN_STORE16(Ow+(long)row*DM+ch*8,w);} }
  if(tid==0)((__attribute__((address_space(3))) unsigned*)(shm3+LDS_REL))[65]=(nxt_<512u)?(qbase+nxt_):0xfffffffeu;
  asm volatile("s_waitcnt lgkmcnt(0)\n\ts_barrier":::"memory");
  #undef KEXT
  #undef QX
  #undef DMA_K
  #undef DMA_V
  #undef CMASK
  #undef START
  #undef RESC
  #undef ROT
}
constexpr int ATTN_LDS_BYTES=LDS_REL+512;
struct AttnTensors { const bf16* Q; const bf16* K; const bf16* V; bf16* O; const bf16* G; const float* CL; const float* TOT; const float* NRM; };
struct AttnUnit { int bh; int qb; };
struct DynOrder {
  unsigned*qhead; int xcc,wid0; __attribute__((address_space(3))) unsigned*slot;
  __device__ __forceinline__ int fresh_tid()const{ int t; asm volatile("v_mbcnt_lo_u32_b32 %0, -1, 0\n\tv_mbcnt_hi_u32_b32 %0, -1, %0":"=v"(t)); return t+wid0*64; }
  __device__ __forceinline__ bool next(int,AttnUnit&u)const{
    unsigned v=*slot;
    if(v==0xfffffffeu){ __syncthreads();
      if(fresh_tid()==0){ unsigned w=0xffffffffu; for(int k=0;k<8;++k){ const int qx=(xcc+k)&7; const unsigned n=__hip_atomic_fetch_add(qhead+64*qx,1u,__ATOMIC_RELAXED,__HIP_MEMORY_SCOPE_AGENT); if(n<512u){w=(unsigned)qx*512u+n;break;} } *slot=w; }
      __syncthreads(); v=*slot; }
    if(v==0xffffffffu)return false;
    const int qx=(int)(v>>9),n=(int)(v&511u),g=3-(n>>7); u.bh=qx*NHEAD+((n>>3)&15); u.qb=8*g+7-(n&7); return true; }
  __device__ __forceinline__ void a_ready(const AttnUnit&)const{}
  __device__ __forceinline__ void done(const AttnUnit&)const{}
};
template<class Sched,int THRL=8> __device__ __forceinline__ void attn_phase(char*lds,const AttnTensors&T,const Sched&S){
  AttnUnit u;
  for(int i=0;S.next(i,u);++i){ S.a_ready(u); attn_unit<THRL>(u.bh/NHEAD,u.bh%NHEAD,u.qb,T.Q,T.K,T.V,T.O,T.G,T.CL,T.TOT,T.NRM,lds,S.fresh_tid(),S.qhead+64*S.xcc,(unsigned)S.xcc*512u); S.done(u); }
}
#undef SBAR
#undef WAIT_BAR
}
#define GAS __attribute__((address_space(1)))
#define LAS __attribute__((address_space(3)))
typedef unsigned short bf16;
typedef unsigned v4u __attribute__((ext_vector_type(4)));
typedef float f32x4 __attribute__((ext_vector_type(4)));
typedef float f32x16 __attribute__((ext_vector_type(16)));
typedef short bf16x8 __attribute__((ext_vector_type(8)));
typedef short s16x4 __attribute__((ext_vector_type(4)));
constexpr int NWAVES = 8, NTHR = 512;
constexpr int NB = 8, SQ = 8192, DM = 1024, MT = NB * SQ;
constexpr int FOX_IN = 4112, KVW = 6144, BIN = 4096;
constexpr float LOG2E = 1.4426950408889634f;
constexpr float C2A = 0.125f * LOG2E;
constexpr float C2B = 0.08838834764831845f * LOG2E;
constexpr size_t MiB = 1u << 20;
constexpr size_t WS_RS1 = 0, WS_RS2 = 256 * 1024, WS_RS3 = 512 * 1024, CTL_ZERO_BYTES = 1 * MiB + 8192 + 16384;
constexpr size_t WS_NRM = 768 * 1024, WS_QH = 1024 * 1024;
constexpr size_t WS_BAR = 1 * MiB + 8192;
constexpr size_t WS_RS0 = 1 * MiB + 64 * 1024;
constexpr size_t WS_WINA = 2 * MiB, WS_WOUTA = 18 * MiB, WS_WKV = 22 * MiB, WS_WINB = 34 * MiB, WS_WOUTB = 50 * MiB, WS_WF = 54 * MiB;
constexpr size_t WS_Q = 184 * MiB, WS_K = 312 * MiB, WS_V = 440 * MiB, WS_G = 568 * MiB, WS_CL = 696 * MiB, WS_TOT = 700 * MiB, WS_O = 704 * MiB;
constexpr size_t WS_KV = 184 * MiB;
constexpr size_t WS_U = 56 * MiB;
constexpr size_t WS_LSE = 952 * MiB, WS_MA = 960 * MiB, WS_END = 992 * MiB;
constexpr size_t U_BYTES_PER_BATCH = (size_t)SQ * BIN * 2, LSE_BYTES_PER_BATCH = (size_t)SQ * 24 * 4;
constexpr int RING_BYTES = 131072, LDS_BYTES = 147456;

__device__ __forceinline__ unsigned f2bf(float f) { unsigned u = __builtin_bit_cast(unsigned, f); return (u + 0x7fffu + ((u >> 16) & 1u)) >> 16; }
__device__ __forceinline__ unsigned pk2(float lo, float hi) { return f2bf(lo) | (f2bf(hi) << 16); }
typedef float f32x2_t __attribute__((ext_vector_type(2))); typedef __bf16 bf16x2_t __attribute__((ext_vector_type(2)));
__device__ __forceinline__ unsigned cvtpk(float lo, float hi) { f32x2_t v = {lo, hi}; bf16x2_t b = __builtin_convertvector(v, bf16x2_t); return __builtin_bit_cast(unsigned, b); }
__device__ __forceinline__ float bflo(unsigned w) { return __uint_as_float(w << 16); }
__device__ __forceinline__ float bfhi(unsigned w) { return __uint_as_float(w & 0xffff0000u); }
__device__ __forceinline__ float wave_sum(float v) {
    v = xr_sum<1>(v); v = xr_sum<2>(v); v = xr_sum<4>(v); v = xr_sum<8>(v); v = xr_sum<16>(v); v = xr_sum<32>(v);
    return v;
}
__device__ __forceinline__ float silu_f(float g) { return g * __builtin_amdgcn_rcpf(1.f + __builtin_amdgcn_exp2f(-LOG2E * g)); }

__device__ __forceinline__ void p0_transpose_item(const float* W, int K, int ldw, int nblk, const float* gain, bf16* WT, LAS float* scr, int item, int lane) {
    const int kb = item / nblk, nb = item % nblk, k0 = 64 * kb, n0 = 32 * nb;
    float wv_[32], gv_[32];
#pragma unroll
    for (int i = 0; i < 32; ++i) { const int kk = 2 * i + (lane >> 5); wv_[i] = W[(size_t)(k0 + kk) * ldw + n0 + (lane & 31)]; gv_[i] = gain ? gain[k0 + kk] : 1.f; }
#pragma unroll
    for (int i = 0; i < 32; ++i) { const int kk = 2 * i + (lane >> 5); scr[kk * 33 + (lane & 31)] = gv_[i] * wv_[i]; }
    asm volatile("s_waitcnt lgkmcnt(0)" ::: "memory");
    const int c = lane & 7;
#pragma unroll
    for (int j = 0; j < 4; ++j) { const int n = (lane >> 3) + 8 * j; const LAS float* s = scr + (8 * c) * 33 + n;
        v4u o; o.x = pk2(s[0 * 33], s[1 * 33]); o.y = pk2(s[2 * 33], s[3 * 33]); o.z = pk2(s[4 * 33], s[5 * 33]); o.w = pk2(s[6 * 33], s[7 * 33]);
        *(GAS v4u*)(WT + (size_t)(n0 + n) * K + k0 + 8 * c) = o; }
    asm volatile("s_waitcnt lgkmcnt(0)" ::: "memory");
}

#define RLX_AGENT __ATOMIC_RELAXED, __HIP_MEMORY_SCOPE_AGENT
#define XB_TMO      128
#define XB_XCNT(j)  (256  + 64 * (j))
#define XB_XSUB(j)  (1280 + 64 * (j))
#define XB_XGEN(j)  (2304 + 64 * (j))
#define XB_TOP      3328
#define XB_TOPGEN   3392
#define XCD_BAR_WORDS 3456
#define XB_SPIN_CAP (1u << 18)

__device__ __forceinline__ unsigned xb_ld(unsigned* p)              { return __hip_atomic_load(p, __ATOMIC_RELAXED, __HIP_MEMORY_SCOPE_AGENT); }
__device__ __forceinline__ unsigned xb_add(unsigned* p, unsigned v) { return __hip_atomic_fetch_add(p, v, __ATOMIC_RELAXED, __HIP_MEMORY_SCOPE_AGENT); }
__device__ __forceinline__ unsigned xb_xcc_id() { return (unsigned)__builtin_amdgcn_s_getreg((3 << 11) | 20) & 0xFu; }
#define XB_SPIN(cond, bar) do { unsigned _sp = 0; while (cond) { __builtin_amdgcn_s_sleep(1); \
    if ((++_sp & 255u) == 0u) { if (xb_ld(&(bar)[XB_TMO])) break; if (_sp > XB_SPIN_CAP) { atomicAdd(&(bar)[XB_TMO], 1u); break; } } } } while (0)

struct XcdBarrier {
    unsigned* bar; unsigned x;
    volatile LAS unsigned* st;
};

__device__ __forceinline__ XcdBarrier xcd_barrier_post(unsigned* bar, volatile LAS unsigned* st) {
    XcdBarrier b; b.bar = bar; b.x = xb_xcc_id(); b.st = st;
    if (threadIdx.x == 0) (void)xb_add(&bar[XB_XCNT(b.x)], 1u);
    return b;
}
__device__ __forceinline__ void xcd_barrier_complete(unsigned* bar, unsigned x, unsigned& nloc, unsigned& nx) {
    const unsigned G = gridDim.x * gridDim.y * gridDim.z;
    unsigned sum, cnt, mine, sp = 0u;
    for (;;) {
        sum = 0u; cnt = 0u; mine = 0u;
#pragma unroll
        for (unsigned j = 0; j < 16; ++j) { const unsigned c = xb_ld(&bar[XB_XCNT(j)]); sum += c; cnt += (c > 0u) ? 1u : 0u; mine = (j == x) ? c : mine; }
        if (sum == G) break;
        __builtin_amdgcn_s_sleep(1);
        if ((++sp & 255u) == 0u) { if (xb_ld(&bar[XB_TMO])) break; if (sp > XB_SPIN_CAP) { atomicAdd(&bar[XB_TMO], 1u); break; } }
    }
    nloc = mine > 0u ? mine : 1u; nx = cnt > 0u ? cnt : 1u;
}

__device__ __forceinline__ void xcd_barrier(const XcdBarrier& b) {
    asm volatile("s_waitcnt vmcnt(0)" ::: "memory");
    __syncthreads();
    if (threadIdx.x == 0) {
        unsigned* bar = b.bar;
        __builtin_amdgcn_s_waitcnt(0);
        unsigned nloc = b.st[0], nx = b.st[1];
        if (nloc == 0u) { xcd_barrier_complete(bar, b.x, nloc, nx); b.st[0] = nloc; b.st[1] = nx; }
        const unsigned old = xb_add(&bar[XB_XSUB(b.x)], 1u);
        const unsigned gen = old / nloc;
        if (old + 1u == (gen + 1u) * nloc) {
            __builtin_amdgcn_fence(__ATOMIC_RELEASE, "agent");
            asm volatile("s_waitcnt vmcnt(0)" ::: "memory");
            const unsigned og = xb_add(&bar[XB_TOP], 1u);
            const unsigned tg = og / nx;
            if (og + 1u == (tg + 1u) * nx) xb_add(&bar[XB_TOPGEN], 1u);
            else XB_SPIN(xb_ld(&bar[XB_TOPGEN]) == tg, bar);
            __builtin_amdgcn_fence(__ATOMIC_ACQUIRE, "agent");
            xb_add(&bar[XB_XGEN(b.x)], 1u);
            asm volatile("s_waitcnt vmcnt(0)" ::: "memory");
        } else {
            XB_SPIN(xb_ld(&bar[XB_XGEN(b.x)]) == gen, bar);
            __builtin_amdgcn_fence(__ATOMIC_ACQUIRE, "agent");
            asm volatile("s_waitcnt vmcnt(0)" ::: "memory");
        }
    }
    __syncthreads();
}

struct Args { const float* in[12]; float* out; unsigned char* ws; int ph_lo, ph_hi, nbc, pad; };

__device__ __forceinline__ void f_item(LAS unsigned char* lds, const bf16* hb, const bf16* Wf, const float* bfv, const float* rowss, float* CL, float* TOT, int item, int wid, int lane) {
    const int b = item >> 6, blk = item & 63, fr = lane & 15, fq = lane >> 4;
    const int tok0 = b * SQ + blk * 128 + wid * 16;
    f32x4 acc = (f32x4){0.f, 0.f, 0.f, 0.f};
    const bf16* xa = hb + (size_t)(tok0 + fr) * DM + fq * 8; const bf16* wb = Wf + (size_t)fr * DM + fq * 8;
#pragma unroll 1
    for (int k8 = 0; k8 < 4; ++k8) { bf16x8 a8[8], w8[8];
#pragma unroll
        for (int q = 0; q < 8; ++q) { a8[q] = *(const bf16x8*)(xa + (k8 * 8 + q) * 32); w8[q] = *(const bf16x8*)(wb + (k8 * 8 + q) * 32); }
        asm volatile("" : "+v"(a8[0]), "+v"(a8[1]), "+v"(a8[2]), "+v"(a8[3]), "+v"(a8[4]), "+v"(a8[5]), "+v"(a8[6]), "+v"(a8[7]));
#pragma unroll
        for (int q = 0; q < 8; ++q) acc = __builtin_amdgcn_mfma_f32_16x16x32_bf16(a8[q], w8[q], acc, 0, 0, 0); }
    const float bias = bfv[fr]; float s[4]; float run = 0.f;
#pragma unroll
    for (int e = 0; e < 4; ++e) { const float rs = __builtin_amdgcn_rsqf(rowss[tok0 + 4 * fq + e] * (1.0f / 1024.0f) + 1e-6f); const float f = acc[e] * rs + bias;
        const float ls = fminf(f, 0.f) - log1pf(__expf(-fabsf(f))); run += ls; s[e] = run; }
    float pre = 0.f;
#pragma unroll
    for (int j = 0; j < 3; ++j) { const float tj = xl_from_lane(run, fr + 16 * j); if (j < fq) pre += tj; }
    LAS float* wtot = (LAS float*)lds;
    if (fq == 3) wtot[wid * 16 + fr] = pre + run;
    __syncthreads();
    float wpre = 0.f, all = 0.f;
#pragma unroll
    for (int w = 0; w < 8; ++w) { const float t = wtot[w * 16 + fr]; all += t; if (w < wid) wpre += t; }
    const float base = wpre + pre;
    *(f32x4*)(CL + (size_t)(b * 16 + fr) * SQ + blk * 128 + wid * 16 + 4 * fq) = (f32x4){base + s[0], base + s[1], base + s[2], base + s[3]};
    if (wid == 0 && fq == 0) TOT[(b * 16 + fr) * 64 + blk] = all;
    __syncthreads();
}

__device__ __forceinline__ unsigned offb(unsigned row, unsigned ch) { return 256u * row + 16u * (ch ^ (((row & 3) << 2) | ((row >> 2) & 3))); }
__device__ __forceinline__ int crow(int r, int hi) { return (r & 3) + 8 * (r >> 2) + 4 * hi; }
__device__ __forceinline__ int t5_bucket(int dist) {
    if (dist < 16) return dist;
    int b = 16;
    b += dist >= 22; b += dist >= 30; b += dist >= 40; b += dist >= 54; b += dist >= 73; b += dist >= 99; b += dist >= 134; b += dist >= 182;
    b += dist >= 246; b += dist >= 332; b += dist >= 450; b += dist >= 609; b += dist >= 825; b += dist >= 1117; b += dist >= 1513;
    return b;
}
#define BATT_DECODE(IT, KG, UG, LSEP, DD, RR, PP, GH) do { const int bl_ = (IT) / 768, r_ = (IT) % 768, g_ = r_ >> 8, h_ = (r_ >> 5) & 7, pi_ = r_ & 31; \
    DD = (g_ == 0) ? 1 : (g_ == 1) ? 4 : 16; const int ppr_ = 32 / DD; RR = pi_ / ppr_; PP = pi_ % ppr_; GH = g_ * 8 + h_; \
    KG = KV + ((((size_t)(b0 + bl_) * 3 + g_) * 2) * 8 + h_) * ((size_t)SQ * 128); UG = U + (size_t)bl_ * SQ * BIN + g_ * 1024 + h_ * 128; LSEP = LSE + (size_t)bl_ * SQ * 24; } while (0)
#define BATT_LOADK(KG, DD, RR, PP) do { const long koff_ = ((long)(RR) * (SQ / (DD)) + 256 * (PP) - 128 + row0) * 128 + ch0 * 8; const long kstr_ = 4096; \
    _Pragma("unroll") for (int i = 0; i < 12; ++i) kreg[i] = ((PP) > 0 || i >= 4) ? *(const v4u*)((KG) + koff_ + i * kstr_) : (v4u){0u, 0u, 0u, 0u}; } while (0)
__device__ __forceinline__ void battn_phase(LAS unsigned char* lds, const bf16* KV, bf16* U, float* LSE, const float* relb, int b0, int nitems, int vcu, int G, int tid_in, int wid, int reps) {
    int row0, ch0;
    { int t0 = tid_in; asm volatile("" : "+v"(t0)); row0 = t0 >> 4; ch0 = t0 & 15; }
    LAS float* lut = (LAS float*)(lds + 98304);
    LAS float* wsf = (LAS float*)(lds + 98304 + 1024) + wid * 32;
    LAS bf16* stg = (LAS bf16*)(lds + 98304 + 2048 + wid * 4096);
    const int total = nitems * reps;
    int it = vcu; if (it >= total) return;
    const bf16* Kg; bf16* Ug; float* LSEp; int d, rr, pp, gh;
    v4u kreg[12];
    { const int itm = it % nitems; BATT_DECODE(itm, Kg, Ug, LSEp, d, rr, pp, gh); BATT_LOADK(Kg, d, rr, pp); }
    for (;;) {
        const bool dry = it + nitems < total;
        int tid = tid_in; asm volatile("" : "+v"(tid));
        const int lane = tid & 63, r32 = lane & 31, hi = lane >> 5; const unsigned loff = offb((unsigned)(tid >> 4), (unsigned)(tid & 15));
        bf16x8 qf[8];
        { const size_t qtok_ = (size_t)((256 * pp + 32 * wid + r32) * d + rr);
#pragma unroll
          for (int d0 = 0; d0 < 8; ++d0) qf[d0] = *(const bf16x8*)(Ug + qtok_ * BIN + d0 * 16 + hi * 8); }
        if (tid < 192) { const int rel_ = tid - 32; lut[tid] = (rel_ >= 0 && rel_ <= 128) ? relb[t5_bucket(rel_ * d) * 24 + gh] * LOG2E : 0.f; }
#pragma unroll
        for (int i = 0; i < 12; ++i) *(LAS v4u*)(lds + i * 8192 + loff) = kreg[i];
        __syncthreads();
        v4u vreg[12];
        { const long koff_ = ((long)rr * (SQ / d) + 256 * pp - 128 + (tid >> 4)) * 128 + (tid & 15) * 8; const long kstr_ = 4096;
#pragma unroll
          for (int i = 0; i < 12; ++i) vreg[i] = (pp > 0 || i >= 4) ? *(const v4u*)(Kg + (size_t)8 * SQ * 128 + koff_ + i * kstr_) : (v4u){0u, 0u, 0u, 0u}; }
        f32x16 s[5];
        const unsigned xr = ((r32 & 3) << 2) | ((r32 >> 2) & 3);
#pragma unroll
        for (int kb = 0; kb < 5; ++kb) { s[kb] = (f32x16){0.f,0.f,0.f,0.f,0.f,0.f,0.f,0.f,0.f,0.f,0.f,0.f,0.f,0.f,0.f,0.f};
            const LAS unsigned char* tb = lds + (wid + kb) * 8192 + 256 * r32;
#pragma unroll
            for (int d0 = 0; d0 < 8; ++d0) { const bf16x8 kf = *(const LAS bf16x8*)(tb + 16 * ((unsigned)(2 * d0 + hi) ^ xr)); s[kb] = __builtin_amdgcn_mfma_f32_32x32x16_bf16(kf, qf[d0], s[kb], 0, 0, 0); } }
        float mx = -INFINITY;
        const int e_ = r32 - 4 * hi; const LAS float* lp = lut + (e_ + 32);
#pragma unroll
        for (int kb = 0; kb < 5; ++kb) {
            if (pp == 0 && wid + kb < 4) {
#pragma unroll
                for (int r = 0; r < 16; ++r) s[kb][r] = -INFINITY;
            } else {
#pragma unroll
                for (int r = 0; r < 16; ++r) { const int cr = (r & 3) + 8 * (r >> 2); float v = s[kb][r] + lp[128 - 32 * kb - cr];
                    if (kb == 0) v = (e_ <= cr) ? v : -INFINITY;
                    if (kb == 4) v = (e_ >= cr) ? v : -INFINITY;
                    s[kb][r] = v; mx = fmaxf(mx, v); }
            }
        }
        mx = xr_max<32>(mx);
        float l = 0.f;
#pragma unroll
        for (int kb = 0; kb < 5; ++kb)
#pragma unroll
            for (int r = 0; r < 16; ++r) { const float p = __builtin_amdgcn_exp2f(s[kb][r] - mx); s[kb][r] = p; l += p; }
        l = xr_sum<32>(l);
        bf16x8 pf[5][2];
#pragma unroll
        for (int kb = 0; kb < 5; ++kb)
#pragma unroll
            for (int ks = 0; ks < 2; ++ks) { v4u w; w.x = cvtpk(s[kb][8 * ks + 0], s[kb][8 * ks + 1]); w.y = cvtpk(s[kb][8 * ks + 2], s[kb][8 * ks + 3]); w.z = cvtpk(s[kb][8 * ks + 4], s[kb][8 * ks + 5]); w.w = cvtpk(s[kb][8 * ks + 6], s[kb][8 * ks + 7]);
                pf[kb][ks] = __builtin_bit_cast(bf16x8, w); }
        __syncthreads();
#pragma unroll
        for (int i = 0; i < 12; ++i) *(LAS v4u*)(lds + i * 8192 + loff) = vreg[i];
        if (hi == 0) wsf[r32] = __builtin_amdgcn_rcpf(l);
        __syncthreads();
        bf16* const Uc = Ug; float* const Lc = LSEp; const int dc = d, rrc = rr, ppc = pp, ghc = gh;
        const int nit = it + G; const bool has_next = nit < total;
        if (has_next) { const int itm = nit % nitems; BATT_DECODE(itm, Kg, Ug, LSEp, d, rr, pp, gh); BATT_LOADK(Kg, d, rr, pp); }
        f32x16 o[4];
        int l2 = lane; asm volatile("" : "+v"(l2));
        const unsigned blk = (l2 >> 4) & 1, qq = (l2 & 15) >> 2, p4 = l2 & 3;
#pragma unroll
        for (int c = 0; c < 4; ++c) { o[c] = (f32x16){0.f,0.f,0.f,0.f,0.f,0.f,0.f,0.f,0.f,0.f,0.f,0.f,0.f,0.f,0.f,0.f};
#pragma unroll
            for (int kb = 0; kb < 5; ++kb)
#pragma unroll
                for (int ks = 0; ks < 2; ++ks) { s16x4 vv[2];
#pragma unroll
                    for (int t = 0; t < 2; ++t) { const unsigned row = 16 * ks + 8 * t + 4 * hi + qq; const LAS unsigned char* ap = lds + (wid + kb) * 8192 + offb(row, 4 * c + 2 * blk + (p4 >> 1)) + 8 * (p4 & 1);
                        vv[t] = __builtin_bit_cast(s16x4, __builtin_amdgcn_ds_read_tr16_b64_v4i16((LAS s16x4*)ap)); }
                    const bf16x8 vf = (bf16x8){vv[0][0], vv[0][1], vv[0][2], vv[0][3], vv[1][0], vv[1][1], vv[1][2], vv[1][3]};
                    o[c] = __builtin_amdgcn_mfma_f32_32x32x16_bf16(pf[kb][ks], vf, o[c], 0, 0, 0); } }
        float rl[16];
#pragma unroll
        for (int r = 0; r < 16; ++r) rl[r] = wsf[crow(r, hi)];
#pragma unroll
        for (int hc = 0; hc < 2; ++hc) {
#pragma unroll
            for (int r = 0; r < 16; ++r) { const int qr_ = crow(r, hi);
#pragma unroll
                for (int cc = 0; cc < 2; ++cc) stg[qr_ * 64 + cc * 32 + r32] = (bf16)cvtpk(o[2 * hc + cc][r] * rl[r], 0.f); }
#pragma unroll
            for (int i = 0; i < 4; ++i) { const int row = i * 8 + (l2 >> 3), ch = l2 & 7; const v4u v = *(const LAS v4u*)(stg + row * 64 + ch * 8);
                const size_t tok = (size_t)((256 * ppc + 32 * wid + row) * dc + rrc); if (!dry) *(v4u*)(Uc + tok * BIN + hc * 64 + ch * 8) = v; }
        }
        if (hi == 0 && !dry) Lc[(size_t)((256 * ppc + 32 * wid + r32) * dc + rrc) * 24 + ghc] = mx + __builtin_amdgcn_logf(l);
        __syncthreads();
        if (!has_next) break;
        it = nit;
    }
}
#ifndef PHASE_MASK
#define PHASE_MASK 0xffff
#endif
#define EN(k) ((PHASE_MASK >> (k)) & 1)
#ifndef PROBE_GEMM_REPS
#define PROBE_GEMM_REPS 1
#endif
#ifndef PROBE_BATT_REPS
#define PROBE_BATT_REPS 1
#endif
#ifndef PROBE_RES_REPS
#define PROBE_RES_REPS 1
#endif
#ifndef PROBE_MEM_REPS
#define PROBE_MEM_REPS 1
#endif
#ifndef PROBE_ATT_REPS
#define PROBE_ATT_REPS 1
#endif
enum { K_PRO = 0, K_AIN, K_AATT, K_AOUT, K_KV, K_BIN, K_BATT, K_BMRG, K_BOUT, K_FIN };
__global__ void __launch_bounds__(NTHR, 2) yoco_fwd(Args args) {
    extern __shared__ __attribute__((aligned(16))) unsigned char lds_raw[];
    cg::grid_group grid = cg::this_grid();
    LAS unsigned char* lds = (LAS unsigned char*)lds_raw;
    const int wid0 = __builtin_amdgcn_readfirstlane(threadIdx.x >> 6);
#define INP(k) ({ int k_ = (k); asm volatile("" : "+s"(k_)); (const float*)(GAS const float*)args.in[k_]; })
    volatile LAS unsigned* bst = (volatile LAS unsigned*)((LAS unsigned char*)lds_raw + LDS_BYTES - 64);
    if (threadIdx.x < 2) bst[threadIdx.x] = 0u;
    __syncthreads();
    (void)xcd_barrier_post((unsigned*)(args.ws + WS_BAR), bst);

    for (int ph = args.ph_lo; ; ++ph) {
        int G = gridDim.x; asm volatile("" : "+s"(G)); int bx = blockIdx.x; asm volatile("" : "+s"(bx)); int nbc = args.nbc; asm volatile("" : "+s"(nbc));
        const int vcu = (G % 8 == 0) ? (bx % 8) * (G / 8) + bx / 8 : bx;
        const int lnch = (nbc == 8) ? 0 : (nbc == 4) ? 1 : (nbc == 2) ? 2 : 3, nch = 1 << lnch;
        const int n_phase = 8 + 6 * nch + 1;
        const int NGW = G * NWAVES;
        if (ph >= args.ph_hi || ph >= n_phase) break;
        int kind, layer = 0, chunk = 0;
        if (ph == 0) kind = K_PRO;
        else if (ph < 7) { layer = (ph - 1) / 3; kind = K_AIN + (ph - 1) % 3; }
        else if (ph == 7) kind = K_KV;
        else if (ph < 8 + 6 * nch) { const int q = ph - 8, j = q / 3; layer = j >> lnch; chunk = j & (nch - 1); kind = K_BATT + (q - 3 * j); }
        else kind = K_FIN;

        for (int pass_ = 0; pass_ < 2; ++pass_) {
        if (pass_ == 1) { if (kind != K_BOUT && kind != K_KV) break; const int j = (kind == K_KV) ? 0 : (layer << lnch) + chunk + 1; if (j >= 2 * nch) break; layer = j >> lnch; chunk = j & (nch - 1); kind = K_BIN; }
        int tid; asm volatile("v_mbcnt_lo_u32_b32 %0, -1, 0\n\tv_mbcnt_hi_u32_b32 %0, -1, %0" : "=v"(tid)); tid += wid0 * 64;
        GAS unsigned char* ws = (GAS unsigned char*)args.ws; asm volatile("" : "+s"(ws)); GAS float* outg = (GAS float*)args.out; asm volatile("" : "+s"(outg)); float* out = (float*)outg; bf16* HB = (bf16*)out; bf16* LOP = HB + (size_t)MT * DM;
        const int lane = tid & 63, wid = __builtin_amdgcn_readfirstlane(tid >> 6); const int gw = vcu * NWAVES + wid;
        if (EN(K_PRO) && kind == K_PRO) {
            const float* x = INP(0); const float* norm_a = INP(2); const float* w_in_a = INP(3); const float* w_out_a = INP(5); const float* norm_kv = INP(6); const float* w_kv = INP(7); const float* norm_b = INP(8); const float* w_in_b = INP(9); const float* w_out_b = INP(10);
            for (int rp_ = 0; rp_ < PROBE_MEM_REPS; ++rp_) {
            LAS float* scr = (LAS float*)(lds + wid * 16384);
            constexpr int I_INA = 16 * 128, I_OUT = 16 * 32, I_KV = 16 * 192, I_INB = 16 * 128;
            constexpr int NITEMS = 2 * I_INA + 2 * I_OUT + I_KV + 2 * I_INB + 2 * I_OUT + 32;
#pragma unroll 1
            for (int it = gw; it < NITEMS; it += NGW) {
                int r = it;
                if (r < 2 * I_INA) { const int i = r / I_INA; p0_transpose_item(w_in_a + (size_t)i * DM * FOX_IN, DM, FOX_IN, 128, norm_a + i * DM, (bf16*)(ws + WS_WINA + (size_t)i * 8 * MiB), scr, r % I_INA, lane); continue; } r -= 2 * I_INA;
                if (r < 2 * I_OUT) { const int i = r / I_OUT; p0_transpose_item(w_out_a + (size_t)i * DM * DM, DM, DM, 32, nullptr, (bf16*)(ws + WS_WOUTA + (size_t)i * 2 * MiB), scr, r % I_OUT, lane); continue; } r -= 2 * I_OUT;
                if (r < I_KV) { p0_transpose_item(w_kv, DM, KVW, 192, norm_kv, (bf16*)(ws + WS_WKV), scr, r, lane); continue; } r -= I_KV;
                if (r < 2 * I_INB) { const int i = r / I_INB; p0_transpose_item(w_in_b + (size_t)i * DM * BIN, DM, BIN, 128, norm_b + i * DM, (bf16*)(ws + WS_WINB + (size_t)i * 8 * MiB), scr, r % I_INB, lane); continue; } r -= 2 * I_INB;
                if (r < 2 * I_OUT) { const int i = r / I_OUT; p0_transpose_item(w_out_b + (size_t)i * DM * DM, DM, DM, 32, nullptr, (bf16*)(ws + WS_WOUTB + (size_t)i * 2 * MiB), scr, r % I_OUT, lane); continue; } r -= 2 * I_OUT;
                { const int i = r >> 4, n = r & 15;
#pragma unroll 4
                  for (int j = 0; j < 16; ++j) { const int k = lane + 64 * j; ((bf16*)(ws + WS_WF))[(i * 16 + n) * DM + k] = (bf16)f2bf(norm_a[i * DM + k] * w_in_a[(size_t)i * DM * FOX_IN + (size_t)k * FOX_IN + 4096 + n]); } }
            }
            float* RS0 = (float*)(ws + WS_RS0);
#pragma unroll 1
            for (int m = gw; m < MT; m += NGW) {
                const f32x4* xr = (const f32x4*)(x + (size_t)m * DM) + lane; unsigned long long* hrow = (unsigned long long*)(HB + (size_t)m * DM) + lane;
                f32x4 v[4]; float s = 0.f;
#pragma unroll
                for (int j = 0; j < 4; ++j) v[j] = xr[64 * j];
                asm volatile("" : "+v"(v[0]), "+v"(v[1]), "+v"(v[2]), "+v"(v[3]));
#pragma unroll
                for (int j = 0; j < 4; ++j) s += (v[j].x * v[j].x + v[j].y * v[j].y) + (v[j].z * v[j].z + v[j].w * v[j].w);
                s = wave_sum(s);
#pragma unroll
                for (int j = 0; j < 4; ++j) { const unsigned h0 = cvtpk(v[j].x, v[j].y), h1 = cvtpk(v[j].z, v[j].w);
                    hrow[64 * j] = (unsigned long long)h0 | ((unsigned long long)h1 << 32); }
                if (lane == 0) RS0[m] = s;
            }
            }
        }
        else if (EN(K_AIN) && (kind == K_AIN || kind == K_KV || kind == K_BIN)) {
            pg8::Gemm g; pg8::EpiBf16Row E;
            if (kind == K_AIN) {
                const float* rs = (const float*)(ws + (layer == 0 ? WS_RS0 : WS_RS1));
#pragma unroll 1
                for (int it = vcu; it < 512; it += G)
                    f_item(lds, HB, (const bf16*)(ws + WS_WF) + (size_t)layer * 16 * DM, INP(4) + layer * 16, rs, (float*)(ws + WS_CL), (float*)(ws + WS_TOT), it, wid, lane);
                g = pg8::Gemm{HB, (const bf16*)(ws + WS_WINA + (size_t)layer * 8 * MiB), MT, 4096, DM, DM};
                E = pg8::EpiBf16Row{(bf16*)(ws + WS_Q), DM, rs, DM, (size_t)(WS_K - WS_Q) / 2, DM, C2A, 0, (unsigned*)(ws + WS_NRM) + (size_t)layer * 32768};
            } else if (kind == K_KV) {
                g = pg8::Gemm{HB, (const bf16*)(ws + WS_WKV), MT, KVW, DM, DM};
                E = pg8::EpiBf16Row{(bf16*)(ws + WS_KV), KVW, (const float*)(ws + WS_RS2), 0, 0, 0, 1.f, 1, nullptr};
            } else {
                const size_t row0 = (size_t)chunk * nbc * SQ;
                g = pg8::Gemm{HB + row0 * DM, (const bf16*)(ws + WS_WINB + (size_t)layer * 8 * MiB), nbc * SQ, BIN, DM, DM};
                E = pg8::EpiBf16Row{(bf16*)(ws + WS_U), BIN, (const float*)(ws + (layer == 0 ? WS_RS2 : WS_RS3)) + row0, 0, 0, 3072, C2B, 0, nullptr};
            }
            pg8::StaticOrder S; S.init(g.M, g.N, G, bx);
            for (int rep_ = 0; rep_ < PROBE_GEMM_REPS; ++rep_) pg8::gemm_phase<pg8::EpiBf16Row, pg8::StaticOrder, true, true>(lds, g, S, E, tid);
        }
        else if (EN(K_AATT) && kind == K_AATT) {
            const attn_body::AttnTensors AT{(const attn_body::bf16*)(ws + WS_Q), (const attn_body::bf16*)(ws + WS_K), (const attn_body::bf16*)(ws + WS_V), (attn_body::bf16*)(ws + WS_O),
                                            (const attn_body::bf16*)(ws + WS_G), (const float*)(ws + WS_CL), (const float*)(ws + WS_TOT), (const float*)(ws + WS_NRM) + (size_t)layer * 32768};
            const attn_body::DynOrder S{(unsigned*)(ws + WS_QH) + layer * 512, (int)(__builtin_amdgcn_s_getreg((3 << 11) | 20) & 7), wid0, (LAS unsigned*)(lds + attn_body::LDS_REL + 260)};
            if (tid == 0) *S.slot = 0xfffffffeu;
            __syncthreads();
            attn_body::attn_phase<attn_body::DynOrder, 24>((char*)lds_raw, AT, S);
#if PROBE_ATT_REPS > 1
            { const attn_body::DynOrder S2{(unsigned*)(ws + WS_QH) + 1024 + layer * 512, S.xcc, wid0, S.slot}; __syncthreads(); attn_body::attn_phase<attn_body::DynOrder, 24>((char*)lds_raw, AT, S2); }
#endif

        }
        else if (EN(K_AOUT) && (kind == K_AOUT || kind == K_BOUT)) {
            pg8::Gemm g; pg8::EpiResid E;
            if (kind == K_AOUT) {
                g = pg8::Gemm{(const bf16*)(ws + WS_O), (const bf16*)(ws + WS_WOUTA + (size_t)layer * 2 * MiB), MT, DM, DM, DM};
                E = pg8::EpiResid{HB, LOP, nullptr, (float*)(ws + (layer == 0 ? WS_RS1 : WS_RS2)), DM, 0, layer == 0 ? INP(0) : (const float*)nullptr};
            } else {
                const size_t row0 = (size_t)chunk * nbc * SQ;
                g = pg8::Gemm{(const bf16*)(ws + WS_MA), (const bf16*)(ws + WS_WOUTB + (size_t)layer * 2 * MiB), nbc * SQ, DM, DM, DM};
                E = pg8::EpiResid{HB + row0 * DM, LOP + row0 * DM, layer == 0 ? (float*)nullptr : (float*)(ws + WS_KV) + (size_t)chunk * nbc * pg8::FIN_BSTRIDE, layer == 0 ? (float*)(ws + WS_RS3) + row0 : (float*)nullptr, DM, 0, nullptr};
            }
            pg8::StaticOrder S; S.init(g.M, g.N, G, bx);
#if PROBE_RES_REPS > 1
            { pg8::EpiResid E2 = E; E2.dry = 1; pg8::gemm_phase<pg8::EpiResid, pg8::StaticOrder, true, true>(lds, g, S, E2, tid); }
#endif
            pg8::gemm_phase<pg8::EpiResid, pg8::StaticOrder, true, true>(lds, g, S, E, tid);
        }
        else if (EN(K_BATT) && kind == K_BATT) {
            battn_phase(lds, (const bf16*)(ws + WS_KV), (bf16*)(ws + WS_U), (float*)(ws + WS_LSE), INP(1), chunk * nbc, nbc * 768, vcu, G, tid, wid, PROBE_BATT_REPS);
        }
        else if (EN(K_BMRG) && kind == K_BMRG) {
            const float* LSE = (const float*)(ws + WS_LSE); const bf16* U = (const bf16*)(ws + WS_U);
#pragma unroll 1
            for (int m = gw; m < nbc * SQ; m += NGW) {
                const int hh = lane >> 3; const float* lp = LSE + (size_t)m * 24 + hh;
                float l0 = lp[0], l1 = lp[8], l2 = lp[16];
                const bf16* urow = U + (size_t)m * BIN + 16 * lane;
                v4u a[2], b[2], c[2], gt[2];
#pragma unroll
                for (int j = 0; j < 2; ++j) { a[j] = *(const v4u*)(urow + 8 * j); b[j] = *(const v4u*)(urow + 1024 + 8 * j); c[j] = *(const v4u*)(urow + 2048 + 8 * j); gt[j] = *(const v4u*)(urow + 3072 + 8 * j); }
                asm volatile("" : "+v"(l0), "+v"(l1), "+v"(l2), "+v"(a[0]), "+v"(a[1]), "+v"(b[0]), "+v"(b[1]), "+v"(c[0]), "+v"(c[1]), "+v"(gt[0]), "+v"(gt[1]));
                const float mxl = fmaxf(l0, fmaxf(l1, l2));
                float w0 = __builtin_amdgcn_exp2f(l0 - mxl), w1 = __builtin_amdgcn_exp2f(l1 - mxl), w2 = __builtin_amdgcn_exp2f(l2 - mxl); const float inv = __builtin_amdgcn_rcpf(w0 + w1 + w2); w0 *= inv; w1 *= inv; w2 *= inv;
#pragma unroll
                for (int j = 0; j < 2; ++j) { v4u o;
#pragma unroll
                    for (int e = 0; e < 4; ++e) { const float v0 = (w0 * bflo(a[j][e]) + w1 * bflo(b[j][e]) + w2 * bflo(c[j][e])) * silu_f(bflo(gt[j][e])), v1 = (w0 * bfhi(a[j][e]) + w1 * bfhi(b[j][e]) + w2 * bfhi(c[j][e])) * silu_f(bfhi(gt[j][e])); o[e] = cvtpk(v0, v1); }
                    *(v4u*)((bf16*)(ws + WS_MA) + (size_t)m * DM + 16 * lane + 8 * j) = o; }
            }
        }
        else if (EN(K_FIN) && kind == K_FIN) {
            const f32x4* gp0 = (const f32x4*)INP(11) + lane;
            for (int rp_ = 0; rp_ < PROBE_MEM_REPS; ++rp_)
#pragma unroll 1
            for (int m = gw; m < MT; m += NGW) {
                f32x4* orow = (f32x4*)(out + (size_t)m * DM) + lane; f32x4 v[4]; float s = 0.f;
                const f32x4* irow = (const f32x4*)((const float*)(ws + WS_KV) + (size_t)(m >> 13) * pg8::FIN_BSTRIDE + (size_t)(m & 8191) * DM) + lane;
#pragma unroll
                for (int j = 0; j < 4; ++j) v[j] = irow[64 * j];
                f32x4 gfin[4];
#pragma unroll
                for (int j = 0; j < 4; ++j) gfin[j] = gp0[64 * j];
                asm volatile("" : "+v"(v[0]), "+v"(v[1]), "+v"(v[2]), "+v"(v[3]), "+v"(gfin[0]), "+v"(gfin[1]), "+v"(gfin[2]), "+v"(gfin[3]));
#pragma unroll
                for (int j = 0; j < 4; ++j) s += (v[j].x * v[j].x + v[j].y * v[j].y) + (v[j].z * v[j].z + v[j].w * v[j].w);
                const float rs = 1.0f / sqrtf(wave_sum(s) * (1.0f / 1024.0f) + 1e-6f);
#pragma unroll
                for (int j = 0; j < 4; ++j) orow[64 * j] = v[j] * rs * gfin[j];
            }
        }
        }
        if (ph + 1 < args.ph_hi && ph + 1 < n_phase) { if (ph == args.ph_lo) grid.sync(); else { XcdBarrier xbar; xbar.bar = (unsigned*)(args.ws + WS_BAR); xbar.x = xb_xcc_id(); xbar.st = bst; xcd_barrier(xbar); } }
    }
}

extern "C" void kernel_launch(void* const* d_in, const int* in_sizes, int n_in, void* d_out, int out_size, void* d_ws, size_t ws_size, hipStream_t stream) {
    static int grid = 0, nbc = 1;
    if (grid == 0) {
        if (n_in != 12 || in_sizes[0] != MT * DM || out_size != MT * DM || ws_size < WS_END) { fprintf(stderr, "kernel_launch: unexpected shapes / workspace (n_in %d, ws %zu); nothing launched\n", n_in, ws_size); grid = -1; return; }
        int dev = 0, cus = 0, per_cu = 0;
        if (hipGetDevice(&dev) != hipSuccess || hipDeviceGetAttribute(&cus, hipDeviceAttributeMultiprocessorCount, dev) != hipSuccess) { grid = -1; return; }
        if (hipFuncSetAttribute((const void*)yoco_fwd, hipFuncAttributeMaxDynamicSharedMemorySize, LDS_BYTES) != hipSuccess) { fprintf(stderr, "kernel_launch: hipFuncSetAttribute failed\n"); grid = -1; return; }
        if (hipOccupancyMaxActiveBlocksPerMultiprocessor(&per_cu, (const void*)yoco_fwd, NTHR, LDS_BYTES) != hipSuccess || per_cu < 1) { fprintf(stderr, "kernel_launch: occupancy query gave %d\n", per_cu); per_cu = 1; }
        (void)hipGetLastError();
        grid = cus;
        nbc = 2;
    }
    if (grid < 0) return;
    (void)hipMemsetAsync((char*)d_ws, 0, CTL_ZERO_BYTES, stream);
    Args a{};
    for (int i = 0; i < 12; ++i) a.in[i] = (const float*)d_in[i];
    a.out = (float*)d_out; a.ws = (unsigned char*)d_ws; a.ph_lo = 0; a.ph_hi = 1 << 20; a.nbc = nbc; a.pad = 0;
    void* kargs[] = {&a};
    hipError_t e = hipLaunchCooperativeKernel((const void*)yoco_fwd, dim3(grid), dim3(NTHR), kargs, LDS_BYTES, stream);
    if (e != hipSuccess) fprintf(stderr, "kernel_launch: cooperative launch failed: %s (grid %d)\n", hipGetErrorString(e), grid);
}
```

```cpp
#include <hip/hip_runtime.h>
#include <hip/hip_cooperative_groups.h>
#include <hip/hip_bf16.h>
#include <cstdio>
#include <cstdint>
#include <cmath>
namespace cg = cooperative_groups;
template <int M> __device__ __forceinline__ float xl_partner_lt32(float v) { static_assert(M >= 1 && M < 32, "xor mask"); return __builtin_bit_cast(float, __builtin_amdgcn_ds_swizzle(__builtin_bit_cast(int, v), (M << 10) | 0x1f)); }
template <int M> __device__ __forceinline__ float xr_sum(float v) { if constexpr (M == 32) { const unsigned u = __builtin_bit_cast(unsigned, v); auto rr = __builtin_amdgcn_permlane32_swap(u, u, false, false); return __builtin_bit_cast(float, (unsigned)rr[0]) + __builtin_bit_cast(float, (unsigned)rr[1]); } else return v + xl_partner_lt32<M>(v); }
template <int M> __device__ __forceinline__ float xr_max(float v) { if constexpr (M == 32) { const unsigned u = __builtin_bit_cast(unsigned, v); auto rr = __builtin_amdgcn_permlane32_swap(u, u, false, false); return __builtin_fmaxf(__builtin_bit_cast(float, (unsigned)rr[0]), __builtin_bit_cast(float, (unsigned)rr[1])); } else return __builtin_fmaxf(v, xl_partner_lt32<M>(v)); }
template <int M> __device__ __forceinline__ float xr_min(float v) { if constexpr (M == 32) { const unsigned u = __builtin_bit_cast(unsigned, v); auto rr = __builtin_amdgcn_permlane32_swap(u, u, false, false); return __builtin_fminf(__builtin_bit_cast(float, (unsigned)rr[0]), __builtin_bit_cast(float, (unsigned)rr[1])); } else return __builtin_fminf(v, xl_partner_lt32<M>(v)); }
__device__ __forceinline__ float xl_from_lane(float v, int src_lane) { return __builtin_bit_cast(float, __builtin_amdgcn_ds_bpermute(src_lane << 2, __builtin_bit_cast(int, v))); }
namespace pg8 {
#define PG8_LAS __attribute__((address_space(3)))
typedef unsigned short bf16_t;
typedef short bf16x8 __attribute__((ext_vector_type(8)));
typedef float f32x4 __attribute__((ext_vector_type(4)));
typedef unsigned u32x4 __attribute__((ext_vector_type(4)));
constexpr int BM = 256, BK = 64, HALF = 128, HTB = HALF * BK * 2  , STAGE_BYTES = 8 * HTB, NXCD = 8, WGM = 8;

__host__ __device__ __forceinline__ int lds_byte(int r, int c) { const int st = (r >> 4) * 2 + (c >> 5), rr = r & 15, cc = c & 31, ob = rr * 64 + cc * 2; return st * 1024 + (ob ^ (((ob >> 9) & 1) << 5)); }
__host__ __device__ __forceinline__ void stage_rc(int b, int& R, int& C) { const int st = b / 1024, sb = b % 1024, swz = sb ^ (((sb >> 9) & 1) << 5); R = (st >> 1) * 16 + swz / 64; C = (st & 1) * 32 + (swz % 64) / 2; }
__host__ __device__ __forceinline__ int perm32(int rho) { const int n = rho >> 4, i = rho & 15; return 8 * (i >> 2) + 4 * n + (i & 3); }

struct Unit { int pm, pn; };
struct Gemm { const bf16_t* A; const bf16_t* Bt; int M, N, K, lda; };

struct StaticOrder {
    int nM, nN, nwg, G, c;
    __host__ __device__ void init(int M, int N, int G_, int c_) { nM = M / BM; nN = N / BM; nwg = nM * nN; G = G_; c = c_; }
    __host__ __device__ bool next(int i, Unit& u) const {
        const long L = (long)i * G + c; if (L >= nwg) return false;
        int wgid = (int)L; { const int q = nwg / NXCD, r = nwg % NXCD, xcd = wgid % NXCD, off = wgid / NXCD; wgid = (xcd < r ? xcd * (q + 1) : r * (q + 1) + (xcd - r) * q) + off; }
        const int nig = WGM * nN, gid = wgid / nig, fm = gid * WGM, gsz = (nM - fm) < WGM ? (nM - fm) : WGM;
        u.pm = fm + ((wgid % nig) % gsz); u.pn = (wgid % nig) / gsz; return true;
    }
    __device__ __forceinline__ void a_ready(const Unit&) const {}
    __device__ __forceinline__ void done(const Unit&) const {}
};

__device__ __forceinline__ unsigned cvt_pk_bf16(float lo, float hi) { unsigned r; asm volatile("v_cvt_pk_bf16_f32 %0, %1, %2" : "=v"(r) : "v"(lo), "v"(hi)); return r; }
constexpr float RMS_EPS_F = 1e-6f;
struct EpiBf16Row {
    static constexpr bool PERM = true, AFTER_DRAIN = false;
    bf16_t* O; int ldc; const float* rowss; int split_cols; size_t split_stride; int qcols; float qscale;
    int kvmode;
    unsigned* nrm;
    __device__ __forceinline__ void operator()(const f32x4 (&acc)[2][2][4][2], const Unit& u, int wr, int wc, int fr, int fq) const {
        typedef __attribute__((address_space(1))) u32x4 gu32x4; typedef __attribute__((address_space(1))) const float gcf32;
        const int row0 = u.pm * BM + wr * 64 + fr; int colt = u.pn * BM; bf16_t* base = O;
        const float sc = (colt < qcols) ? qscale : 1.f; int t = 0;
        if (split_cols) { t = colt / split_cols; base += (size_t)t * split_stride; colt -= t * split_cols; }
        const int col0 = colt + wc * 32 + 8 * fq;
        const bool do_n = (nrm != nullptr) && (t < 2);
        float rsv[2][4];
#pragma unroll
        for (int ai = 0; ai < 2; ++ai)
#pragma unroll
            for (int m = 0; m < 4; ++m) rsv[ai][m] = ((gcf32*)rowss)[row0 + ai * HALF + m * 16];
        float mx[2][2] = {{0.f, 0.f}, {0.f, 0.f}};
#pragma unroll
        for (int ai = 0; ai < 2; ++ai)
#pragma unroll
            for (int m = 0; m < 4; ++m) { const int r = row0 + ai * HALF + m * 16; const float rs = __builtin_amdgcn_rsqf(rsv[ai][m] * (1.0f / 1024.0f) + RMS_EPS_F) * sc;
                bf16_t* rowp = base + (size_t)r * ldc + col0; size_t bjs = HALF;
                if (kvmode) { const int g = colt / 2048, kv = (colt >> 10) & 1, h0 = (colt >> 7) & 7, ld = 2 * g, b = r >> 13, tk = r & 8191;
                    const int pos = ((tk & ((1 << ld) - 1)) << (13 - ld)) + (tk >> ld);
                    rowp = O + ((((size_t)(b * 3 + g) * 2 + kv) * 8 + h0) * 8192 + pos) * 128 + wc * 32 + 8 * fq; bjs = (size_t)8192 * 128; }
#pragma unroll
                for (int bj = 0; bj < 2; ++bj) { const f32x4 v0 = acc[ai][bj][m][0] * rs, v1 = acc[ai][bj][m][1] * rs;
                    u32x4 w; w.x = cvt_pk_bf16(v0[0], v0[1]); w.y = cvt_pk_bf16(v0[2], v0[3]); w.z = cvt_pk_bf16(v1[0], v1[1]); w.w = cvt_pk_bf16(v1[2], v1[3]);
                    *(gu32x4*)(rowp + bj * bjs) = w;
                    if (do_n) { float ss = (v0[0] * v0[0] + v0[1] * v0[1]) + (v0[2] * v0[2] + v0[3] * v0[3]) + (v1[0] * v1[0] + v1[1] * v1[1]) + (v1[2] * v1[2] + v1[3] * v1[3]);
                        ss = xr_sum<16>(ss); ss = xr_sum<32>(ss); mx[ai][bj] = fmaxf(mx[ai][bj], ss); } } }
        if (do_n) {
#pragma unroll
            for (int ai = 0; ai < 2; ++ai)
#pragma unroll
                for (int bj = 0; bj < 2; ++bj) { float v = mx[ai][bj]; v = xr_max<1>(v); v = xr_max<2>(v); v = xr_max<4>(v); v = xr_max<8>(v);
                    if (fr == 0 && fq == 0) { const int b = u.pm >> 5, blk = ((u.pm & 31) << 1) + ai, head = (colt >> 6) + 2 * bj + (wc >> 1);
                        __hip_atomic_fetch_max(nrm + ((((size_t)(t * 8 + b) * 16 + head) * 64 + blk) * 2 + (wc & 1)), __float_as_uint(v), __ATOMIC_RELAXED, __HIP_MEMORY_SCOPE_AGENT); } }
        }
    }
};
constexpr size_t FIN_BSTRIDE = (size_t)8192 * 6144 * 2 / 4;
#ifndef RESID_LO
#define RESID_LO 0
#endif
struct EpiResid {
    static constexpr bool PERM = false, AFTER_DRAIN = false;
    bf16_t* phi; bf16_t* plo; float* fin; float* rowss; int ldc; int dry; const float* xbase;
    template <bool FIN, bool XB> __device__ __forceinline__ void body(const f32x4 (&acc)[2][2][4][2], const Unit& u, int wr, int wc, int fr, int fq) const {
        typedef unsigned u32x2v __attribute__((ext_vector_type(2))); typedef __attribute__((address_space(1))) u32x2v gu2; typedef __attribute__((address_space(1))) f32x4 gf4;
        const int col0 = u.pn * BM + wc * 32 + 4 * fq, rbase = u.pm * BM + wr * 64 + fr;
        u32x2v H[2][4], L[2][4]; typedef __attribute__((address_space(1))) const f32x4 gcf4;
#define PG8_LOADG(g, b) do { const size_t off_ = (size_t)(rbase + ((g) >> 2) * HALF + ((g) & 3) * 16) * ldc + col0; \
        _Pragma("unroll") for (int c = 0; c < 4; ++c) { const size_t o4_ = off_ + (c >> 1) * HALF + (c & 1) * 16; if (XB) { const f32x4 xv_ = *(gcf4*)(xbase + o4_); H[b][c] = (u32x2v){__float_as_uint(xv_[0]), __float_as_uint(xv_[1])}; L[b][c] = (u32x2v){__float_as_uint(xv_[2]), __float_as_uint(xv_[3])}; } \
            else { H[b][c] = *(const gu2*)(phi + o4_); if (RESID_LO) L[b][c] = *(const gu2*)(plo + o4_); else L[b][c] = (u32x2v){0u, 0u}; } } } while (0)
        PG8_LOADG(0, 0);
#pragma unroll
        for (int g = 0; g < 8; ++g) { const int ai = g >> 2, m = g & 3, cb = g & 1;
            if (g < 7) PG8_LOADG(g + 1, cb ^ 1);
            const int r = rbase + ai * HALF + m * 16; const size_t off = (size_t)r * ldc + col0; float s = 0.f;
            float* frow = FIN ? fin + (size_t)(r >> 13) * FIN_BSTRIDE + (size_t)(r & 8191) * 1024 + col0 : nullptr;
#pragma unroll
            for (int c = 0; c < 4; ++c) { const int bj = c >> 1, n = c & 1; const size_t o4 = off + bj * HALF + n * 16; const u32x2v h = H[cb][c], l = L[cb][c];
                f32x4 o; if (XB) { o[0] = __uint_as_float(h.x); o[1] = __uint_as_float(h.y); o[2] = __uint_as_float(l.x); o[3] = __uint_as_float(l.y); }
                else { o[0] = __uint_as_float(h.x << 16) + __uint_as_float(l.x << 16); o[1] = __uint_as_float(h.x & 0xffff0000u) + __uint_as_float(l.x & 0xffff0000u);
                o[2] = __uint_as_float(h.y << 16) + __uint_as_float(l.y << 16); o[3] = __uint_as_float(h.y & 0xffff0000u) + __uint_as_float(l.y & 0xffff0000u); }
                o = o + acc[ai][bj][m][n];
                s += (o[0] * o[0] + o[1] * o[1]) + (o[2] * o[2] + o[3] * o[3]);
                if (FIN) *(gf4*)(frow + bj * HALF + n * 16) = o;
                else { u32x2v nh; nh.x = cvt_pk_bf16(o[0], o[1]); nh.y = cvt_pk_bf16(o[2], o[3]);
                    u32x2v nl; nl.x = cvt_pk_bf16(o[0] - __uint_as_float(nh.x << 16), o[1] - __uint_as_float(nh.x & 0xffff0000u)); nl.y = cvt_pk_bf16(o[2] - __uint_as_float(nh.y << 16), o[3] - __uint_as_float(nh.y & 0xffff0000u));
                    *(gu2*)(phi + o4) = nh; if (RESID_LO) *(gu2*)(plo + o4) = nl; } }
            s = xr_sum<16>(s); s = xr_sum<32>(s);
            if (rowss && fq == 0) __hip_atomic_fetch_add(rowss + r, s, __ATOMIC_RELAXED, __HIP_MEMORY_SCOPE_AGENT);
        }
#undef PG8_LOADG
    }
    __device__ __forceinline__ void operator()(const f32x4 (&acc)[2][2][4][2], const Unit& u, int wr, int wc, int fr, int fq) const {
        if (dry) { f32x4 t = acc[0][0][0][0];
#pragma unroll
            for (int a = 0; a < 2; ++a)
#pragma unroll
                for (int b = 0; b < 2; ++b)
#pragma unroll
                    for (int m = 0; m < 4; ++m)
#pragma unroll
                        for (int n = 0; n < 2; ++n) t += acc[a][b][m][n];
            if (t[0] + t[1] + t[2] + t[3] == 1.2345e30f) plo[0] = 0; return; }
        if (fin) body<true, false>(acc, u, wr, wc, fr, fq); else if (xbase) body<false, true>(acc, u, wr, wc, fr, fq); else body<false, false>(acc, u, wr, wc, fr, fq);
    }
};

template <class Epi, class Sched, bool ALIGN_EPI = false, bool SP2 = false>
__device__ __forceinline__ void gemm_phase(PG8_LAS unsigned char* lds, const Gemm g, const Sched& S, const Epi& E, const int tid_in) {
    const int tid = tid_in, wid = __builtin_amdgcn_readfirstlane(tid >> 6), lane = tid & 63, wr = wid >> 2, wc = wid & 3, fr = lane & 15, fq = lane >> 4;
    const int K = g.K, nt = K / BK;
    unsigned voffA[2], voffB[2];
#pragma unroll
    for (int i = 0; i < 2; ++i) { int R, C; stage_rc(tid * 16 + i * 8192, R, C); const int Rb = Epi::PERM ? ((R & ~31) + perm32(R & 31)) : R;
        voffA[i] = (unsigned)(R * g.lda + C) * 2u; voffB[i] = (unsigned)(Rb * K + C) * 2u; }
    const size_t kstep = (size_t)(BK * 2);
    const size_t hstepA = (size_t)HALF * g.lda * 2, hstepB = (size_t)HALF * K * 2;
    const size_t tstepA = 2 * hstepA, tstepB = 2 * hstepB;
    const unsigned ldsw = (unsigned)wid * 1024u;
    const int aoff = lds_byte(wr * 64 + fr, fq * 8), boff = lds_byte(wc * 32 + fr, fq * 8);
#define PG8_SA(b, h) (((b) * 2 + (h)) * HTB)
#define PG8_SB(b, h) ((4 + (b) * 2 + (h)) * HTB)
#define PG8_STAGE(bufoff, gbase, voff) do { _Pragma("unroll") for (int _i = 0; _i < 2; ++_i) \
        __builtin_amdgcn_global_load_lds((const unsigned*)((const char*)(gbase) + (voff)[_i]), (PG8_LAS unsigned*)(lds + (bufoff) + ldsw + _i * 8192), 16, 0, 0); } while (0)
#define PG8_LDA(dst, b, h) do { _Pragma("unroll") for (int m = 0; m < 4; ++m) _Pragma("unroll") for (int k = 0; k < 2; ++k) dst[m][k] = *(const PG8_LAS bf16x8*)(lds + PG8_SA(b, h) + aoff + m * 2048 + k * 1024); } while (0)
#define PG8_LDB(dst, b, h) do { _Pragma("unroll") for (int n = 0; n < 2; ++n) _Pragma("unroll") for (int k = 0; k < 2; ++k) dst[n][k] = *(const PG8_LAS bf16x8*)(lds + PG8_SB(b, h) + boff + n * 2048 + k * 1024); } while (0)
#define PG8_MMA(ai, bj, At, Bt) do { __builtin_amdgcn_s_setprio(1); _Pragma("unroll") for (int m = 0; m < 4; ++m) _Pragma("unroll") for (int n = 0; n < 2; ++n) _Pragma("unroll") for (int k = 0; k < 2; ++k) \
        acc[ai][bj][m][n] = __builtin_amdgcn_mfma_f32_16x16x32_bf16(Bt[n][k], At[m][k], acc[ai][bj][m][n], 0, 0, 0); __builtin_amdgcn_s_setprio(0); } while (0)
#define PG8_WAIT_V(n) asm volatile("s_waitcnt vmcnt(" #n ")" ::: "memory")
#define PG8_WAIT_L(n) asm volatile("s_waitcnt lgkmcnt(" #n ")" ::: "memory")
#define PG8_BAR __builtin_amdgcn_s_barrier()
#define PG8_SCHED __builtin_amdgcn_sched_barrier(0)
    Unit cur, nxt; int ui = 0;
    if (!S.next(0, cur)) return;
    f32x4 acc[2][2][4][2];
#pragma unroll
    for (int a = 0; a < 2; ++a)
#pragma unroll
        for (int b = 0; b < 2; ++b)
#pragma unroll
            for (int m = 0; m < 4; ++m)
#pragma unroll
                for (int n = 0; n < 2; ++n) acc[a][b][m][n] = (f32x4){0.f, 0.f, 0.f, 0.f};
    bf16x8 At[4][2], B0[2][2], B1[2][2];
    const char* cA = (const char*)g.A + (size_t)cur.pm * tstepA; const char* cB = (const char*)g.Bt + (size_t)cur.pn * tstepB;
    S.a_ready(cur);
    if constexpr (SP2) {
        PG8_STAGE(PG8_SB(0, 0), cB, voffB); PG8_STAGE(PG8_SB(0, 1), cB + hstepB, voffB); PG8_STAGE(PG8_SA(0, 0), cA, voffA); PG8_STAGE(PG8_SA(0, 1), cA + hstepA, voffA);
        if (wr == 1) PG8_BAR;
        PG8_WAIT_V(2); PG8_BAR;
        PG8_STAGE(PG8_SB(1, 0), cB + kstep, voffB); PG8_STAGE(PG8_SA(1, 0), cA + kstep, voffA); PG8_STAGE(PG8_SB(1, 1), cB + hstepB + kstep, voffB);
        PG8_WAIT_V(6); PG8_BAR;
    } else {
        PG8_STAGE(PG8_SB(0, 0), cB, voffB); PG8_STAGE(PG8_SA(0, 0), cA, voffA); PG8_STAGE(PG8_SB(0, 1), cB + hstepB, voffB); PG8_STAGE(PG8_SA(0, 1), cA + hstepA, voffA);
        if (wr == 1) PG8_BAR;
        PG8_WAIT_V(4); PG8_BAR;
        PG8_STAGE(PG8_SB(1, 0), cB + kstep, voffB); PG8_STAGE(PG8_SA(1, 0), cA + kstep, voffA); PG8_STAGE(PG8_SB(1, 1), cB + hstepB + kstep, voffB);
        PG8_WAIT_V(6); PG8_BAR;
    }
    for (;;) {
        const bool has_next = S.next(ui + 1, nxt);
        const char* nA = has_next ? (const char*)g.A + (size_t)nxt.pm * tstepA : cA; const char* nB = has_next ? (const char*)g.Bt + (size_t)nxt.pn * tstepB : cB;
        for (int t = 0; t < nt; t += 2) {
            const bool last = (t == nt - 2);
            const char* a1 = cA + (size_t)(t + 1) * kstep;
            const char* a2 = last ? nA : cA + (size_t)(t + 2) * kstep; const char* b2 = last ? nB : cB + (size_t)(t + 2) * kstep;
            const char* a3 = a2 + kstep; const char* b3 = b2 + kstep;
            if (last && has_next) S.a_ready(nxt);
            if constexpr (SP2) {
            PG8_LDB(B0, 0, 0); PG8_LDB(B1, 0, 1); PG8_SCHED; PG8_LDA(At, 0, 0); PG8_STAGE(PG8_SA(1, 1), a1 + hstepA, voffA);
            PG8_WAIT_V(8); PG8_WAIT_L(0); PG8_BAR; PG8_MMA(0, 0, At, B0); PG8_MMA(0, 1, At, B1); PG8_BAR; PG8_SCHED;
            PG8_LDA(At, 0, 1); PG8_STAGE(PG8_SB(0, 0), b2, voffB); PG8_STAGE(PG8_SB(0, 1), b2 + hstepB, voffB); PG8_STAGE(PG8_SA(0, 0), a2, voffA);
            PG8_WAIT_V(8); PG8_WAIT_L(0); PG8_BAR; PG8_MMA(1, 0, At, B0); PG8_MMA(1, 1, At, B1); PG8_BAR; PG8_SCHED;
            PG8_LDB(B0, 1, 0); PG8_LDB(B1, 1, 1); PG8_SCHED; PG8_LDA(At, 1, 0); PG8_STAGE(PG8_SA(0, 1), a2 + hstepA, voffA);
            PG8_WAIT_V(8); PG8_WAIT_L(0); PG8_BAR; PG8_MMA(0, 0, At, B0); PG8_MMA(0, 1, At, B1); PG8_BAR; PG8_SCHED;
            PG8_LDA(At, 1, 1); PG8_STAGE(PG8_SB(1, 0), b3, voffB); PG8_STAGE(PG8_SB(1, 1), b3 + hstepB, voffB); PG8_STAGE(PG8_SA(1, 0), a3, voffA);
            PG8_WAIT_V(8); PG8_WAIT_L(0); PG8_BAR; PG8_MMA(1, 0, At, B0); PG8_MMA(1, 1, At, B1); PG8_BAR; PG8_SCHED;
            } else {
            PG8_LDB(B0, 0, 0); PG8_SCHED; PG8_LDA(At, 0, 0); PG8_STAGE(PG8_SA(1, 1), a1 + hstepA, voffA);
            PG8_WAIT_L(8); PG8_BAR; PG8_WAIT_L(0); PG8_MMA(0, 0, At, B0); PG8_BAR; PG8_SCHED;
            PG8_LDB(B1, 0, 1); PG8_STAGE(PG8_SB(0, 0), b2, voffB);
            PG8_BAR; PG8_WAIT_L(0); PG8_MMA(0, 1, At, B1); PG8_BAR;
            PG8_LDA(At, 0, 1); PG8_STAGE(PG8_SA(0, 0), a2, voffA);
            PG8_BAR; PG8_WAIT_L(0); PG8_MMA(1, 0, At, B0); PG8_BAR; PG8_SCHED;
            PG8_STAGE(PG8_SB(0, 1), b2 + hstepB, voffB);
            PG8_WAIT_V(6); PG8_BAR; PG8_MMA(1, 1, At, B1); PG8_BAR;
            PG8_LDB(B0, 1, 0); PG8_SCHED; PG8_LDA(At, 1, 0); PG8_STAGE(PG8_SA(0, 1), a2 + hstepA, voffA);
            PG8_WAIT_L(8); PG8_BAR; PG8_WAIT_L(0); PG8_MMA(0, 0, At, B0); PG8_BAR; PG8_SCHED;
            PG8_LDB(B1, 1, 1); PG8_STAGE(PG8_SB(1, 0), b3, voffB);
            PG8_BAR; PG8_WAIT_L(0); PG8_MMA(0, 1, At, B1); PG8_BAR;
            PG8_LDA(At, 1, 1); PG8_STAGE(PG8_SA(1, 0), a3, voffA);
            PG8_BAR; PG8_WAIT_L(0); PG8_MMA(1, 0, At, B0); PG8_BAR; PG8_SCHED;
            PG8_STAGE(PG8_SB(1, 1), b3 + hstepB, voffB);
            PG8_WAIT_V(6); PG8_BAR; PG8_MMA(1, 1, At, B1); PG8_BAR;
            }
        }
        if constexpr (ALIGN_EPI) { if (wr == 0) PG8_BAR; }
        if constexpr (!Epi::AFTER_DRAIN) { E(acc, cur, wr, wc, fr, fq); S.done(cur); }
        if (!has_next) break;
#pragma unroll
        for (int a = 0; a < 2; ++a)
#pragma unroll
            for (int b = 0; b < 2; ++b)
#pragma unroll
                for (int m = 0; m < 4; ++m)
#pragma unroll
                    for (int n = 0; n < 2; ++n) acc[a][b][m][n] = (f32x4){0.f, 0.f, 0.f, 0.f};
        cur = nxt; cA = nA; cB = nB; ++ui;
        if constexpr (ALIGN_EPI) { if (wr == 1) PG8_BAR; }
    }
    PG8_WAIT_V(0);
    if constexpr (!ALIGN_EPI) { if (wr == 0) PG8_BAR; }
    PG8_BAR;
    if constexpr (Epi::AFTER_DRAIN) { E.fused(acc, cur, wr, wc, fr, fq, lds, wid, lane); S.done(cur); }
#undef PG8_SA
#undef PG8_SB
#undef PG8_STAGE
#undef PG8_LDA
#undef PG8_LDB
#undef PG8_MMA
#undef PG8_WAIT_V
#undef PG8_WAIT_L
#undef PG8_BAR
#undef PG8_SCHED
}
}
namespace attn_body {
using bf16=__hip_bfloat16;
using bf16x8=__attribute__((ext_vector_type(8)))short;
using s16x4=__attribute__((ext_vector_type(4)))short;
using f32x16=__attribute__((ext_vector_type(16)))float;
using u32x4=__attribute__((ext_vector_type(4)))unsigned;
constexpr int BATCH=8,NHEAD=16,SEQ=8192,D=64,DM=NHEAD*D;
constexpr int NW=8,QBLK=32,QB=QBLK*NW,KVBLK=64,NQB=SEQ/QB;
constexpr int ATTN_PITCH=DM, ATTN_UNIT_ROWS=QB;
__device__ __forceinline__ int crow(int r,int hi){return (r&3)+8*(r>>2)+4*hi;}
#define SBAR() __builtin_amdgcn_sched_barrier(0)
__device__ __forceinline__ void cmask(f32x16&p0,f32x16&p1,int jb,int qrel,int hi){
  const float NEG=-INFINITY; int kb=64*jb+4*hi;
  #pragma unroll
  for(int r=0;r<16;++r){int kv=kb+(r&3)+8*(r>>2); if(kv>qrel)p0[r]=NEG; if(kv+32>qrel)p1[r]=NEG;}
}

constexpr int NSLOT=3, SLOTB=8192;
constexpr int LDS_K=0, LDS_V=NSLOT*SLOTB, LDS_WS=2*NSLOT*SLOTB, LDS_OST=LDS_WS+NW*64*4, LDS_BYTES=LDS_OST+NW*4096;
constexpr int LDS_C2=LDS_BYTES, LDS_REL=LDS_C2+SEQ*4;
constexpr float C2=0.125f*1.4426950408889634f;
__device__ __forceinline__ void glds16(const void*gsrc,unsigned lds_dst){unsigned keep;
  asm volatile("s_mov_b32 %0, m0\n\ts_mov_b32 m0, %2\n\ts_nop 0\n\tglobal_load_lds_dwordx4 %1, off\n\ts_mov_b32 m0, %0":"=&s"(keep):"v"(gsrc),"s"(lds_dst):"memory");}
__device__ __forceinline__ void glds16s(const void*sbase,unsigned voff,unsigned lds_dst){unsigned keep;
  asm volatile("s_mov_b32 %0, m0\n\ts_mov_b32 m0, %3\n\ts_nop 0\n\tglobal_load_lds_dwordx4 %1, %2\n\ts_mov_b32 m0, %0":"=&s"(keep):"v"(voff),"s"(sbase),"s"(lds_dst):"memory");}
__device__ __forceinline__ float max3f(float a,float b,float c){float r;asm("v_max3_f32 %0, %1, %2, %3":"=v"(r):"v"(a),"v"(b),"v"(c));return r;}
__device__ __forceinline__ float max2f(float a,float b){float r;asm("v_max_f32_e32 %0, %1, %2":"=v"(r):"v"(a),"v"(b));return r;}
__device__ __forceinline__ float fadd_s(float a,float b){float r;asm("v_add_f32_e32 %0, %1, %2":"=v"(r):"v"(a),"v"(b));return r;}
__device__ __forceinline__ float fsub_s(float a,float b){float r;asm("v_sub_f32_e32 %0, %1, %2":"=v"(r):"v"(a),"v"(b));return r;}
typedef float f32x2_t __attribute__((ext_vector_type(2))); typedef __bf16 bf16x2_t __attribute__((ext_vector_type(2)));
__device__ __forceinline__ unsigned cvtpk_s(float lo,float hi){f32x2_t v={lo,hi};bf16x2_t b=__builtin_convertvector(v,bf16x2_t);return __builtin_bit_cast(unsigned,b);}
#define WAIT_BAR(N) asm volatile("s_waitcnt vmcnt(" #N ") lgkmcnt(0)\n\ts_barrier":::"memory")

__device__ __forceinline__ void qkt(f32x16&p0,f32x16&p1,const char*Kslot,const bf16x8*qr,int r32,int hi){
  const char*kb=Kslot+hi*1024+r32*16;
  #pragma unroll
  for(int d0=0;d0<4;++d0){
    const bf16x8 b0=*reinterpret_cast<const bf16x8*>(kb+d0*2048);
    const bf16x8 b1=*reinterpret_cast<const bf16x8*>(kb+d0*2048+512);
    {p0=__builtin_amdgcn_mfma_f32_32x32x16_bf16(b0,qr[d0],p0,0,0,0);p1=__builtin_amdgcn_mfma_f32_32x32x16_bf16(b1,qr[d0],p1,0,0,0);}}
}
typedef __attribute__((address_space(3))) const char* lds_cptr;
typedef short v4i16_t __attribute__((ext_vector_type(4)));
__device__ __forceinline__ void kload8(bf16x8*kf,lds_cptr kp){
  kf[0]=*(const __attribute__((address_space(3))) bf16x8*)(kp);      kf[1]=*(const __attribute__((address_space(3))) bf16x8*)(kp+512);
  kf[2]=*(const __attribute__((address_space(3))) bf16x8*)(kp+2048); kf[3]=*(const __attribute__((address_space(3))) bf16x8*)(kp+2560);
  kf[4]=*(const __attribute__((address_space(3))) bf16x8*)(kp+4096); kf[5]=*(const __attribute__((address_space(3))) bf16x8*)(kp+4608);
  kf[6]=*(const __attribute__((address_space(3))) bf16x8*)(kp+6144); kf[7]=*(const __attribute__((address_space(3))) bf16x8*)(kp+6656);
}
__device__ __forceinline__ void kload2(bf16x8*kf,lds_cptr kp,int j){ kf[2*j]=*(const __attribute__((address_space(3))) bf16x8*)(kp+j*2048); kf[2*j+1]=*(const __attribute__((address_space(3))) bf16x8*)(kp+j*2048+512); }
__device__ __forceinline__ s16x4 vtr(lds_cptr p){ return __builtin_bit_cast(s16x4,__builtin_amdgcn_ds_read_tr16_b64_v4i16((__attribute__((address_space(3))) v4i16_t*)p)); }
__device__ __forceinline__ float rowmax(const f32x16&p0,const f32x16&p1){
  float a=max3f(p0[0],p0[1],p1[0]),b=max3f(p0[2],p0[3],p1[1]);a=max3f(a,p1[2],p1[3]);
  #pragma unroll
  for(int r=4;r<16;r+=4){a=max3f(a,p0[r],p0[r+1]);b=max3f(b,p0[r+2],p0[r+3]);a=max3f(a,p1[r],p1[r+1]);b=max3f(b,p1[r+2],p1[r+3]);}
  const float m=max2f(a,b);
  auto rr=__builtin_amdgcn_permlane32_swap(__float_as_uint(m),__float_as_uint(m),false,false);
  return max2f(__uint_as_float(rr[0]),__uint_as_float(rr[1]));
}
__device__ __forceinline__ void pv(f32x16*o,int vb,bf16x8 pa0,bf16x8 pa1,bf16x8 pa2,bf16x8 pa3){
  #pragma unroll
  for(int d0=0;d0<2;++d0){s16x4 lo[4],hi[4];
    #pragma unroll
    for(int ks=0;ks<4;++ks){
      asm volatile("ds_read_b64_tr_b16 %0,%1 offset:%c2":"=&v"(lo[ks]):"v"(vb),"i"(d0*4096+ks*1024):"memory");
      asm volatile("ds_read_b64_tr_b16 %0,%1 offset:%c2":"=&v"(hi[ks]):"v"(vb),"i"(d0*4096+ks*1024+512):"memory");}
    asm volatile("s_waitcnt lgkmcnt(0)":::"memory");SBAR();
    #define PK(k) (bf16x8){lo[k][0],lo[k][1],lo[k][2],lo[k][3],hi[k][0],hi[k][1],hi[k][2],hi[k][3]}
    o[d0]=__builtin_amdgcn_mfma_f32_32x32x16_bf16(pa0,PK(0),o[d0],0,0,0);
    o[d0]=__builtin_amdgcn_mfma_f32_32x32x16_bf16(pa1,PK(1),o[d0],0,0,0);
    o[d0]=__builtin_amdgcn_mfma_f32_32x32x16_bf16(pa2,PK(2),o[d0],0,0,0);
    o[d0]=__builtin_amdgcn_mfma_f32_32x32x16_bf16(pa3,PK(3),o[d0],0,0,0);
    #undef PK
  }
}

#ifndef ATTN_STORE16
#define ATTN_STORE16(p,v) (*(u32x4*)(p)=(v))
#endif
typedef float f32x4_t __attribute__((ext_vector_type(4)));
__device__ __forceinline__ unsigned split2(float v,float&eff){ unsigned w=cvtpk_s(v,0.f); const float h=__uint_as_float(w<<16); w=cvtpk_s(v,fsub_s(v,h)); eff=fadd_s(h,__uint_as_float(w&0xffff0000u)); return w; }
template<int THRL> __device__ __forceinline__ void attn_unit(int b,int h,int qb,const bf16*Q,const bf16*__restrict__ K,const bf16*__restrict__ V,bf16*O,const bf16*__restrict__ Gt,const float*__restrict__ CL,const float*__restrict__ TOT,const float*__restrict__ NRM,char*shm,const int tid_in,unsigned*qown,const unsigned qbase){
  const int tid=tid_in,lane=tid&63,r32=lane&31,hi=lane>>5; const int wid=__builtin_amdgcn_readfirstlane(tid>>6);
  const long rowbase=(long)b*SEQ; const int q0=qb*QB;
  const bf16*Qw=Q+(rowbase+q0+wid*QBLK)*DM+h*D;
  const bf16*Kh=K+rowbase*DM+h*D,*Vh=V+rowbase*DM+h*D;
  const lds_cptr shm3=(lds_cptr)shm;
  const unsigned lds0=(unsigned)(uintptr_t)shm;
  float*wsf=(float*)(shm+LDS_WS)+wid*64;
  const unsigned koff=(unsigned)((lane*DM+wid*8)*2);
  const unsigned voff=(unsigned)(((16*(wid&3)+(lane>>2))*DM+(wid>>2)*32+(lane&3)*8)*2);
  const unsigned kdst=lds0+LDS_K+wid*1024, vdst=lds0+LDS_V+wid*1024;
  #define DMA_K(t,slot) glds16s(Kh+(long)(t)*KVBLK*DM,koff,(unsigned)__builtin_amdgcn_readfirstlane(kdst+(slot)))
  #define DMA_V(t,slot) glds16s(Vh+(long)(t)*KVBLK*DM,voff,(unsigned)__builtin_amdgcn_readfirstlane(vdst+(slot)))
  const char*Kbase=shm+LDS_K; bf16x8 kf[8];
  const lds_cptr kp0=shm3+LDS_K+hi*1024+r32*16; const lds_cptr vp0=shm3+LDS_V+((lane>>4)&1)*32+(lane&3)*8+(4*hi+((lane&15)>>2))*64;
  bf16x8 qr[4];
  #pragma unroll
  for(int d0=0;d0<4;++d0)qr[d0]=*reinterpret_cast<const bf16x8*>(&Qw[(long)r32*DM+d0*16+hi*8]);
  float cq2; int t_start;
  { typedef __attribute__((address_space(3))) float lf32; lf32*relL=(lf32*)(shm3+LDS_REL); __attribute__((address_space(3))) unsigned*c2P=(__attribute__((address_space(3))) unsigned*)(shm3+LDS_C2);
    float tv=0.f,nk0=0.f,nk1=0.f,nq0=0.f,nq1=0.f,nq2=0.f,nq3=0.f;
    const float cqraw=CL[(long)(b*NHEAD+h)*SEQ+q0+wid*QBLK+r32];
    if(wid==0){ tv=TOT[(b*NHEAD+h)*64+lane]; const float*nq=NRM+(long)((0*BATCH+b)*NHEAD+h)*128,*nk=NRM+(long)((1*BATCH+b)*NHEAD+h)*128; nk0=nk[2*lane]; nk1=nk[2*lane+1]; nq0=nq[4*qb]; nq1=nq[4*qb+1]; nq2=nq[4*qb+2]; nq3=nq[4*qb+3]; }
    { const bf16*Kd=K+(rowbase+q0+wid*QBLK+r32)*DM+h*D+hi*8; float dot=0.f; bf16x8 kd[4];
      #pragma unroll
      for(int d0=0;d0<4;++d0)kd[d0]=*reinterpret_cast<const bf16x8*>(Kd+d0*16);
      asm volatile("":"+v"(kd[0]),"+v"(kd[1]),"+v"(kd[2]),"+v"(kd[3]));
      #pragma unroll
      for(int d0=0;d0<4;++d0){
        #pragma unroll
        for(int e=0;e<8;++e)dot+=__uint_as_float((unsigned)(unsigned short)qr[d0][e]<<16)*__uint_as_float((unsigned)(unsigned short)kd[d0][e]<<16); }
      dot=xr_sum<32>(dot);
      dot=xr_min<16>(dot); dot=xr_min<8>(dot); dot=xr_min<4>(dot); dot=xr_min<2>(dot); dot=xr_min<1>(dot);
      if(lane==0)relL[66+wid]=dot; }
    __syncthreads();
    if(wid==0){ float inc=tv;
      _Pragma("unroll") for(int o_=1;o_<64;o_<<=1){ const float y_=xl_from_lane(inc,lane-o_); if(lane>=o_)inc+=y_; }
      const float exc=inc-tv; const float eref=__builtin_bit_cast(float,__builtin_amdgcn_readlane(__builtin_bit_cast(int,exc),2*qb)); relL[lane]=exc-eref;
      const float bk2=nk0+nk1; const float bq2=__builtin_fmaxf(nq0+nq1,nq2+nq3);
      float smin=relL[66]; _Pragma("unroll") for(int w_=1;w_<NW;++w_)smin=__builtin_fminf(smin,relL[66+w_]);
      const float Bj=sqrtf(bq2*bk2)*1.02f,Dj=(inc-eref)*1.4426950408889634f;
      const bool keep=(lane>=2*qb)||!(Dj>=Bj-smin+30.5f);
      const unsigned long long km=__ballot(keep); const int bs_=__ffsll((long long)km)-1; if(lane==0)((__attribute__((address_space(3))) int*)relL)[64]=bs_; }
    __syncthreads();
    const int bs=__builtin_amdgcn_readfirstlane(((__attribute__((address_space(3))) int*)relL)[64]); t_start=2*bs;
    const int NTl=(q0+QB)/KVBLK-t_start;
    const float*clp=CL+(long)(b*NHEAD+h)*SEQ;
    { f32x4_t cv_[4];
      #pragma unroll
      for(int k_=0;k_<4;++k_){ const int i_=tid+k_*NW*64; cv_[k_]=*(const f32x4_t*)(clp+128*bs+4*(i_<NTl*16?i_:tid)); }
      asm volatile("":"+v"(cv_[0]),"+v"(cv_[1]),"+v"(cv_[2]),"+v"(cv_[3]));
      #pragma unroll
      for(int k_=0;k_<4;++k_){ const int i_=tid+k_*NW*64; if(i_<NTl*16){ const f32x4_t v_=cv_[k_]; const float rl_=relL[bs+(i_>>5)]; float e_;
        u32x4 w_; w_.x=split2((v_.x+rl_)*-1.4426950408889634f,e_); w_.y=split2((v_.y+rl_)*-1.4426950408889634f,e_); w_.z=split2((v_.z+rl_)*-1.4426950408889634f,e_); w_.w=split2((v_.w+rl_)*-1.4426950408889634f,e_);
        *(__attribute__((address_space(3))) u32x4*)(c2P+4*i_)=w_; } } }
    cq2=(cqraw+relL[2*qb+(wid>>2)])*1.4426950408889634f;
    __syncthreads(); }
  Kh+=(long)t_start*KVBLK*DM; Vh+=(long)t_start*KVBLK*DM;
  const int NT=(q0+QB)/KVBLK-t_start;
  const __attribute__((address_space(3))) unsigned* c2f=(const __attribute__((address_space(3))) unsigned*)(shm3+LDS_C2)+r32;
  unsigned qxw;
  #define QX() __builtin_bit_cast(bf16x8,(u32x4){hi?0u:0x3f803f80u,hi?0u:qxw,0u,0u})
  #define KEXT(KX0,KX1,t) do{ const unsigned wa_=c2f[(t)*64], wb_=c2f[(t)*64+32]; KX0=__builtin_bit_cast(bf16x8,(u32x4){wa_,0x3f803f80u,0u,0u}); KX1=__builtin_bit_cast(bf16x8,(u32x4){wb_,0x3f803f80u,0u,0u}); }while(0)
  DMA_K(0,0);DMA_V(0,0);DMA_K(1,SLOTB);
  float mhat,l_reg=0.f;f32x16 o[2];o[0]=f32x16{};o[1]=f32x16{}; { float e_; qxw=split2(cq2,e_); mhat=-e_; } const f32x16 zero16=f32x16{};
  const int qrel=wid*QBLK+r32;
  #define CMASK(P0,P1,t) do{int jb_=(t)-(NT-4); if(jb_>=0)cmask(P0,P1,jb_,qrel,hi);}while(0)
  bool resc=false;
  #define START(P0,P1) do{ const float rm=rowmax(P0,P1); resc=false; \
    { float e_; qxw=split2(-fadd_s(mhat,rm),e_); const float dl=fsub_s(-e_,mhat); mhat=-e_; \
      _Pragma("unroll") for(int r=0;r<16;++r){P0[r]=fsub_s(P0[r],dl);P1[r]=fsub_s(P1[r],dl);} } \
    _Pragma("unroll") for(int r=0;r<16;++r)P0[r]=__builtin_amdgcn_exp2f(P0[r]); }while(0)
  #define RESC() do{ if(resc){ asm volatile("s_waitcnt lgkmcnt(0)":::"memory"); \
      _Pragma("unroll") for(int d_=0;d_<2;++d_) _Pragma("unroll") for(int r=0;r<16;++r)o[d_][r]*=wsf[crow(r,hi)]; } }while(0)
  f32x16 pA0,pA1,pB0,pB1;
  int sl_prev=0,sl_cur=0,sl_next=SLOTB;
  #define ROT() do{sl_prev=sl_cur;sl_cur=sl_next;sl_next=(sl_next==(NSLOT-1)*SLOTB)?0:sl_next+SLOTB;}while(0)
  DMA_K(2,2*SLOTB);
  WAIT_BAR(3);
  { bf16x8 kx0_,kx1_; KEXT(kx0_,kx1_,0); const bf16x8 qx_=QX(); pA0=__builtin_amdgcn_mfma_f32_32x32x16_bf16(kx0_,qx_,zero16,0,0,0); pA1=__builtin_amdgcn_mfma_f32_32x32x16_bf16(kx1_,qx_,zero16,0,0,0); }
  qkt(pA0,pA1,Kbase,qr,r32,hi);asm volatile("s_nop 15\n\ts_nop 7":"+v"(pA0),"+v"(pA1));CMASK(pA0,pA1,0);
  START(pA0,pA1);
  _Pragma("unroll") for(int r=0;r<16;++r)pA1[r]=__builtin_amdgcn_exp2f(pA1[r]);
  WAIT_BAR(0);
  DMA_K(3,0);DMA_V(1,SLOTB);
  ROT();
  kload8(kf,kp0+sl_cur);
  WAIT_BAR(2);
  s16x4 vlo[8],vhi[8]; u32x4 pw0,pw1,pw2,pw3;
  #define PKW(P,B) cvtpk_s(P[B],P[B+1])
  #define PAF(k) __builtin_bit_cast(bf16x8,pw##k)
  #define VFR(i) (bf16x8){vlo[i][0],vlo[i][1],vlo[i][2],vlo[i][3],vhi[i][0],vhi[i][1],vhi[i][2],vhi[i][3]}
  #define PIN(x) asm volatile("":"+v"(x))
  #define MX3(a,b,c) __builtin_fmaxf(__builtin_fmaxf((a),(b)),(c))
  #define GAPA(MF,A0,A1,A2,A3,W0,W1,PW) do{ MF; sacc+=A0; sacc+=A1; sacc+=A2; sacc+=A3; PIN(sacc); W0; W1; PIN(PW); SBAR(); }while(0)
  #define EX(v) __builtin_amdgcn_exp2f(v)
  #define GAPB(MF,X,B) do{ MF; X[B]=EX(X[B]); X[B+1]=EX(X[B+1]); X[B+2]=EX(X[B+2]); X[B+3]=EX(X[B+3]); PIN(X); SBAR(); }while(0)
  #define VRD(i) do{ vlo[i]=vtr(vp_+(((i)>>2)*4096+((i)&3)*1024)); vhi[i]=vtr(vp_+(((i)>>2)*4096+((i)&3)*1024+512)); }while(0)
  #define KRD(G,j) do{ if(G){ kload2(kf,kp0+sl_next,j); SBAR(); } }while(0)
  #define STEP(C0,C1,P0,P1,t,GK,GV,GL) do{ SBAR(); \
    { bf16x8 kx0_,kx1_; KEXT(kx0_,kx1_,t); const bf16x8 qx_=QX(); C0=__builtin_amdgcn_mfma_f32_32x32x16_bf16(kx0_,qx_,zero16,0,0,0); C1=__builtin_amdgcn_mfma_f32_32x32x16_bf16(kx1_,qx_,zero16,0,0,0); } SBAR(); \
    const lds_cptr vp_=vp0+sl_prev; \
    VRD(0); SBAR(); float sacc=(P0[0]+P0[1]); \
    GAPA(C0=__builtin_amdgcn_mfma_f32_32x32x16_bf16(kf[0],qr[0],C0,0,0,0), P0[2],P0[3],P0[4],P0[5],     pw0[0]=PKW(P0,0), pw0[1]=PKW(P0,2), pw0); \
    VRD(4); SBAR(); GAPA(C1=__builtin_amdgcn_mfma_f32_32x32x16_bf16(kf[1],qr[0],C1,0,0,0), P0[6],P0[7],P0[8],P0[9],     pw0[2]=PKW(P0,4), pw0[3]=PKW(P0,6), pw0); \
    VRD(1); SBAR(); GAPA(C0=__builtin_amdgcn_mfma_f32_32x32x16_bf16(kf[2],qr[1],C0,0,0,0),   P0[10],P0[11],P0[12],P0[13], pw1[0]=PKW(P0,8), pw1[1]=PKW(P0,10), pw1); \
    VRD(5); SBAR(); GAPA(C1=__builtin_amdgcn_mfma_f32_32x32x16_bf16(kf[3],qr[1],C1,0,0,0),   P0[14],P0[15],P1[0],P1[1],   pw1[2]=PKW(P0,12),pw1[3]=PKW(P0,14), pw1); \
    VRD(2); SBAR(); GAPA(C0=__builtin_amdgcn_mfma_f32_32x32x16_bf16(kf[4],qr[2],C0,0,0,0),   P1[2],P1[3],P1[4],P1[5],     pw2[0]=PKW(P1,0), pw2[1]=PKW(P1,2), pw2); \
    VRD(6); SBAR(); GAPA(C1=__builtin_amdgcn_mfma_f32_32x32x16_bf16(kf[5],qr[2],C1,0,0,0),   P1[6],P1[7],P1[8],P1[9],     pw2[2]=PKW(P1,4), pw2[3]=PKW(P1,6), pw2); \
    VRD(3); SBAR(); GAPA(C0=__builtin_amdgcn_mfma_f32_32x32x16_bf16(kf[6],qr[3],C0,0,0,0),   P1[10],P1[11],P1[12],P1[13], pw3[0]=PKW(P1,8), pw3[1]=PKW(P1,10), pw3); \
    VRD(7); SBAR(); GAPA(C1=__builtin_amdgcn_mfma_f32_32x32x16_bf16(kf[7],qr[3],C1,0,0,0),   P1[14],P1[15],0.f,0.f,       pw3[2]=PKW(P1,12),pw3[3]=PKW(P1,14), pw3); \
    l_reg+=sacc; \
    if(GK){DMA_K((t)+3,sl_cur);} if(GV){DMA_V((t)+1,sl_next);} \
    CMASK(C0,C1,t); \
    { float a=MX3(C0[0],C0[1],C1[0]),b=MX3(C0[2],C0[3],C1[1]); a=MX3(a,C1[2],C1[3]); \
      _Pragma("unroll") for(int r=4;r<16;r+=4){a=MX3(a,C0[r],C0[r+1]);b=MX3(b,C0[r+2],C0[r+3]);a=MX3(a,C1[r],C1[r+1]);b=MX3(b,C1[r+2],C1[r+3]);} \
      float rm=__builtin_fmaxf(a,b); { auto rr=__builtin_amdgcn_permlane32_swap(__float_as_uint(rm),__float_as_uint(rm),false,false); rm=__builtin_fmaxf(__uint_as_float(rr[0]),__uint_as_float(rr[1])); } \
      resc=false; \
      if(__builtin_expect(__any(rm>(float)THRL),0)){ float e_; qxw=split2(-(mhat+__builtin_fmaxf(rm,0.f)),e_); const float dl=-e_-mhat; mhat=-e_; \
        _Pragma("unroll") for(int r=0;r<16;++r){C0[r]-=dl;C1[r]-=dl;} \
        const float f=__builtin_amdgcn_exp2f(-dl); l_reg*=f; if(hi==0)wsf[r32]=f; resc=true; } } \
    SBAR(); \
    GAPB(o[0]=__builtin_amdgcn_mfma_f32_32x32x16_bf16(PAF(0),VFR(0),o[0],0,0,0), C0,0); \
    GAPB(o[1]=__builtin_amdgcn_mfma_f32_32x32x16_bf16(PAF(0),VFR(4),o[1],0,0,0), C0,4); \
    KRD(GL,0); GAPB(o[0]=__builtin_amdgcn_mfma_f32_32x32x16_bf16(PAF(1),VFR(1),o[0],0,0,0), C0,8); \
    KRD(GL,1); GAPB(o[1]=__builtin_amdgcn_mfma_f32_32x32x16_bf16(PAF(1),VFR(5),o[1],0,0,0), C0,12); \
    KRD(GL,2); GAPB(o[0]=__builtin_amdgcn_mfma_f32_32x32x16_bf16(PAF(2),VFR(2),o[0],0,0,0), C1,0); \
    KRD(GL,3); GAPB(o[1]=__builtin_amdgcn_mfma_f32_32x32x16_bf16(PAF(2),VFR(6),o[1],0,0,0), C1,4); \
    GAPB(o[0]=__builtin_amdgcn_mfma_f32_32x32x16_bf16(PAF(3),VFR(3),o[0],0,0,0), C1,8); \
    GAPB(o[1]=__builtin_amdgcn_mfma_f32_32x32x16_bf16(PAF(3),VFR(7),o[1],0,0,0), C1,12); \
    }while(0)
  int t=1;
  #undef CMASK
  #define CMASK(P0,P1,t) do{}while(0)
  for(;t+5<NT;t+=2){
    STEP(pB0,pB1,pA0,pA1,t,true,true,true);     WAIT_BAR(2); RESC(); ROT();
    STEP(pA0,pA1,pB0,pB1,t+1,true,true,true);   WAIT_BAR(2); RESC(); ROT();
  }
  #undef CMASK
  #define CMASK(P0,P1,t) do{int jb_=(t)-(NT-4); if(jb_>=0)cmask(P0,P1,jb_,qrel,hi);}while(0)
  #define ENDW(tt) do{ if((tt)+3<NT){WAIT_BAR(2);} else if((tt)+2<NT){WAIT_BAR(1);} else {WAIT_BAR(0);} }while(0)
  for(;t+1<NT;t+=2){
    STEP(pB0,pB1,pA0,pA1,t,(t+3<NT),(t+1<NT),(t+1<NT));       ENDW(t);   RESC(); ROT();
    STEP(pA0,pA1,pB0,pB1,t+1,(t+4<NT),(t+2<NT),(t+2<NT));     ENDW(t+1); RESC(); ROT();
  }
  STEP(pB0,pB1,pA0,pA1,NT-1,false,false,false); RESC();
  { float sacc=pB0[0]+pB0[1]; _Pragma("unroll") for(int r=2;r<16;++r)sacc+=pB0[r]; _Pragma("unroll") for(int r=0;r<16;++r)sacc+=pB1[r]; l_reg+=sacc;
    pw0=(u32x4){PKW(pB0,0),PKW(pB0,2),PKW(pB0,4),PKW(pB0,6)};pw1=(u32x4){PKW(pB0,8),PKW(pB0,10),PKW(pB0,12),PKW(pB0,14)};pw2=(u32x4){PKW(pB1,0),PKW(pB1,2),PKW(pB1,4),PKW(pB1,6)};pw3=(u32x4){PKW(pB1,8),PKW(pB1,10),PKW(pB1,12),PKW(pB1,14)};
    const int vb0=(int)(lds0+LDS_V)+((lane>>4)&1)*32+(lane&3)*8+(4*hi+((lane&15)>>2))*64;
    SBAR(); pv(o,vb0+sl_cur,PAF(0),PAF(1),PAF(2),PAF(3)); }
  #undef PKW
  #undef PAF
  #undef VFR
  #undef PIN
  #undef MX3
  #undef GAPA
  #undef GAPB
  #undef EX
  #undef VRD
  #undef KRD
  #undef STEP
  #undef ENDW
  unsigned nxt_=0u; if(tid==0)nxt_=__hip_atomic_fetch_add(qown,1u,__ATOMIC_RELAXED,__HIP_MEMORY_SCOPE_AGENT);
  {auto rr=__builtin_amdgcn_permlane32_swap(__float_as_uint(l_reg),__float_as_uint(l_reg),false,false);l_reg=__uint_as_float(rr[0])+__uint_as_float(rr[1]);}
  if(hi==0)wsf[32+r32]=l_reg;asm volatile("s_waitcnt lgkmcnt(0)":::"memory");
  float rli[16];
  #pragma unroll
  for(int r=0;r<16;++r)rli[r]=__builtin_amdgcn_rcpf(wsf[32+crow(r,hi)]);
  bf16*Ow=O+(rowbase+q0+wid*QBLK)*DM+h*D;
  { bf16*stg=(bf16*)(shm+LDS_OST)+wid*2048;
    #pragma unroll
    for(int r=0;r<16;++r){const int orow=crow(r,hi);
      #pragma unroll
      for(int d0=0;d0<2;++d0)stg[orow*64+d0*32+r32]=__float2bfloat16(o[d0][r]*rli[r]);}
    asm volatile("s_waitcnt lgkmcnt(0)":::"memory");
    int le_=lane; asm volatile("":"+v"(le_));
    #pragma unroll
    for(int i=0;i<4;++i){const int row=i*8+(le_>>3),ch=le_&7; const u32x4 v=*(const u32x4*)(stg+row*64+ch*8); const u32x4 gv=*(const u32x4*)(Gt+(rowbase+q0+wid*QBLK+row)*DM+h*D+ch*8); u32x4 w;
      #pragma unroll
      for(int e=0;e<4;++e){ const float o0=__uint_as_float(v[e]<<16),o1=__uint_as_float(v[e]&0xffff0000u),g0=__uint_as_float(gv[e]<<16),g1=__uint_as_float(gv[e]&0xffff0000u);
        const float s0=g0*__builtin_amdgcn_rcpf(1.f+__builtin_amdgcn_exp2f(-1.4426950408889634f*g0)),s1=g1*__builtin_amdgcn_rcpf(1.f+__builtin_amdgcn_exp2f(-1.4426950408889634f*g1)); w[e]=cvtpk_s(o0*s0,o1*s1); }
      ATTN_STORE16(Ow+(long)row*DM+ch*8,w);} }
  if(tid==0)((__attribute__((address_space(3))) unsigned*)(shm3+LDS_REL))[65]=(nxt_<512u)?(qbase+nxt_):0xfffffffeu;
  asm volatile("s_waitcnt lgkmcnt(0)\n\ts_barrier":::"memory");
  #undef KEXT
  #undef QX
  #undef DMA_K
  #undef DMA_V
  #undef CMASK
  #undef START
  #undef RESC
  #undef ROT
}
constexpr int ATTN_LDS_BYTES=LDS_REL+512;
struct AttnTensors { const bf16* Q; const bf16* K; const bf16* V; bf16* O; const bf16* G; const float* CL; const float* TOT; const float* NRM; };
struct AttnUnit { int bh; int qb; };
struct DynOrder {
  unsigned*qhead; int xcc,wid0; __attribute__((address_space(3))) unsigned*slot;
  __device__ __forceinline__ int fresh_tid()const{ int t; asm volatile("v_mbcnt_lo_u32_b32 %0, -1, 0\n\tv_mbcnt_hi_u32_b32 %0, -1, %0":"=v"(t)); return t+wid0*64; }
  __device__ __forceinline__ bool next(int,AttnUnit&u)const{
    unsigned v=*slot;
    if(v==0xfffffffeu){ __syncthreads();
      if(fresh_tid()==0){ unsigned w=0xffffffffu; for(int k=0;k<8;++k){ const int qx=(xcc+k)&7; const unsigned n=__hip_atomic_fetch_add(qhead+64*qx,1u,__ATOMIC_RELAXED,__HIP_MEMORY_SCOPE_AGENT); if(n<512u){w=(unsigned)qx*512u+n;break;} } *slot=w; }
      __syncthreads(); v=*slot; }
    if(v==0xffffffffu)return false;
    const int qx=(int)(v>>9),n=(int)(v&511u),g=3-(n>>7); u.bh=qx*NHEAD+((n>>3)&15); u.qb=8*g+7-(n&7); return true; }
  __device__ __forceinline__ void a_ready(const AttnUnit&)const{}
  __device__ __forceinline__ void done(const AttnUnit&)const{}
};
template<class Sched,int THRL=8> __device__ __forceinline__ void attn_phase(char*lds,const AttnTensors&T,const Sched&S){
  AttnUnit u;
  for(int i=0;S.next(i,u);++i){ S.a_ready(u); attn_unit<THRL>(u.bh/NHEAD,u.bh%NHEAD,u.qb,T.Q,T.K,T.V,T.O,T.G,T.CL,T.TOT,T.NRM,lds,S.fresh_tid(),S.qhead+64*S.xcc,(unsigned)S.xcc*512u); S.done(u); }
}
#undef SBAR
#undef WAIT_BAR
}
#define GAS __attribute__((address_space(1)))
#define LAS __attribute__((address_space(3)))
typedef unsigned short bf16;
typedef unsigned v4u __attribute__((ext_vector_type(4)));
typedef float f32x4 __attribute__((ext_vector_type(4)));
typedef float f32x16 __attribute__((ext_vector_type(16)));
typedef short bf16x8 __attribute__((ext_vector_type(8)));
typedef short s16x4 __attribute__((ext_vector_type(4)));
constexpr int NWAVES = 8, NTHR = 512;
constexpr int NB = 8, SQ = 8192, DM = 1024, MT = NB * SQ;
constexpr int FOX_IN = 4112, KVW = 6144, BIN = 4096;
constexpr float LOG2E = 1.4426950408889634f;
constexpr float C2A = 0.125f * LOG2E;
constexpr float C2B = 0.08838834764831845f * LOG2E;
constexpr size_t MiB = 1u << 20;
constexpr size_t WS_RS1 = 0, WS_RS2 = 256 * 1024, WS_RS3 = 512 * 1024, CTL_ZERO_BYTES = 1 * MiB + 8192 + 16384;
constexpr size_t WS_NRM = 768 * 1024, WS_QH = 1024 * 1024;
constexpr size_t WS_BAR = 1 * MiB + 8192;
constexpr size_t WS_RS0 = 1 * MiB + 64 * 1024;
constexpr size_t WS_WINA = 2 * MiB, WS_WOUTA = 18 * MiB, WS_WKV = 22 * MiB, WS_WINB = 34 * MiB, WS_WOUTB = 50 * MiB, WS_WF = 54 * MiB;
constexpr size_t WS_Q = 184 * MiB, WS_K = 312 * MiB, WS_V = 440 * MiB, WS_G = 568 * MiB, WS_CL = 696 * MiB, WS_TOT = 700 * MiB, WS_O = 704 * MiB;
constexpr size_t WS_KV = 184 * MiB;
constexpr size_t WS_U = 56 * MiB;
constexpr size_t WS_LSE = 952 * MiB, WS_MA = 960 * MiB, WS_END = 992 * MiB;
constexpr size_t U_BYTES_PER_BATCH = (size_t)SQ * BIN * 2, LSE_BYTES_PER_BATCH = (size_t)SQ * 24 * 4;
constexpr int RING_BYTES = 131072, LDS_BYTES = 147456;

__device__ __forceinline__ unsigned f2bf(float f) { unsigned u = __builtin_bit_cast(unsigned, f); return (u + 0x7fffu + ((u >> 16) & 1u)) >> 16; }
__device__ __forceinline__ unsigned pk2(float lo, float hi) { return f2bf(lo) | (f2bf(hi) << 16); }
typedef float f32x2_t __attribute__((ext_vector_type(2))); typedef __bf16 bf16x2_t __attribute__((ext_vector_type(2)));
__device__ __forceinline__ unsigned cvtpk(float lo, float hi) { f32x2_t v = {lo, hi}; bf16x2_t b = __builtin_convertvector(v, bf16x2_t); return __builtin_bit_cast(unsigned, b); }
__device__ __forceinline__ float bflo(unsigned w) { return __uint_as_float(w << 16); }
__device__ __forceinline__ float bfhi(unsigned w) { return __uint_as_float(w & 0xffff0000u); }
__device__ __forceinline__ float wave_sum(float v) {
    v = xr_sum<1>(v); v = xr_sum<2>(v); v = xr_sum<4>(v); v = xr_sum<8>(v); v = xr_sum<16>(v); v = xr_sum<32>(v);
    return v;
}
__device__ __forceinline__ float silu_f(float g) { return g * __builtin_amdgcn_rcpf(1.f + __builtin_amdgcn_exp2f(-LOG2E * g)); }

__device__ __forceinline__ void p0_transpose_item(const float* W, int K, int ldw, int nblk, const float* gain, bf16* WT, LAS float* scr, int item, int lane) {
    const int kb = item / nblk, nb = item % nblk, k0 = 64 * kb, n0 = 32 * nb;
    float wv_[32], gv_[32];
#pragma unroll
    for (int i = 0; i < 32; ++i) { const int kk = 2 * i + (lane >> 5); wv_[i] = W[(size_t)(k0 + kk) * ldw + n0 + (lane & 31)]; gv_[i] = gain ? gain[k0 + kk] : 1.f; }
#pragma unroll
    for (int i = 0; i < 32; ++i) { const int kk = 2 * i + (lane >> 5); scr[kk * 33 + (lane & 31)] = gv_[i] * wv_[i]; }
    asm volatile("s_waitcnt lgkmcnt(0)" ::: "memory");
    const int c = lane & 7;
#pragma unroll
    for (int j = 0; j < 4; ++j) { const int n = (lane >> 3) + 8 * j; const LAS float* s = scr + (8 * c) * 33 + n;
        v4u o; o.x = pk2(s[0 * 33], s[1 * 33]); o.y = pk2(s[2 * 33], s[3 * 33]); o.z = pk2(s[4 * 33], s[5 * 33]); o.w = pk2(s[6 * 33], s[7 * 33]);
        *(GAS v4u*)(WT + (size_t)(n0 + n) * K + k0 + 8 * c) = o; }
    asm volatile("s_waitcnt lgkmcnt(0)" ::: "memory");
}

#define RLX_AGENT __ATOMIC_RELAXED, __HIP_MEMORY_SCOPE_AGENT
#define XB_TMO      128
#define XB_XCNT(j)  (256  + 64 * (j))
#define XB_XSUB(j)  (1280 + 64 * (j))
#define XB_XGEN(j)  (2304 + 64 * (j))
#define XB_TOP      3328
#define XB_TOPGEN   3392
#define XCD_BAR_WORDS 3456
#define XB_SPIN_CAP (1u << 18)

__device__ __forceinline__ unsigned xb_ld(unsigned* p)              { return __hip_atomic_load(p, __ATOMIC_RELAXED, __HIP_MEMORY_SCOPE_AGENT); }
__device__ __forceinline__ unsigned xb_add(unsigned* p, unsigned v) { return __hip_atomic_fetch_add(p, v, __ATOMIC_RELAXED, __HIP_MEMORY_SCOPE_AGENT); }
__device__ __forceinline__ unsigned xb_xcc_id() { return (unsigned)__builtin_amdgcn_s_getreg((3 << 11) | 20) & 0xFu; }
#define XB_SPIN(cond, bar) do { unsigned _sp = 0; while (cond) { __builtin_amdgcn_s_sleep(1); \
    if ((++_sp & 255u) == 0u) { if (xb_ld(&(bar)[XB_TMO])) break; if (_sp > XB_SPIN_CAP) { atomicAdd(&(bar)[XB_TMO], 1u); break; } } } } while (0)

struct XcdBarrier {
    unsigned* bar; unsigned x;
    volatile LAS unsigned* st;
};

__device__ __forceinline__ XcdBarrier xcd_barrier_post(unsigned* bar, volatile LAS unsigned* st) {
    XcdBarrier b; b.bar = bar; b.x = xb_xcc_id(); b.st = st;
    if (threadIdx.x == 0) (void)xb_add(&bar[XB_XCNT(b.x)], 1u);
    return b;
}
__device__ __forceinline__ void xcd_barrier_complete(unsigned* bar, unsigned x, unsigned& nloc, unsigned& nx) {
    const unsigned G = gridDim.x * gridDim.y * gridDim.z;
    unsigned sum, cnt, mine, sp = 0u;
    for (;;) {
        sum = 0u; cnt = 0u; mine = 0u;
#pragma unroll
        for (unsigned j = 0; j < 16; ++j) { const unsigned c = xb_ld(&bar[XB_XCNT(j)]); sum += c; cnt += (c > 0u) ? 1u : 0u; mine = (j == x) ? c : mine; }
        if (sum == G) break;
        __builtin_amdgcn_s_sleep(1);
        if ((++sp & 255u) == 0u) { if (xb_ld(&bar[XB_TMO])) break; if (sp > XB_SPIN_CAP) { atomicAdd(&bar[XB_TMO], 1u); break; } }
    }
    nloc = mine > 0u ? mine : 1u; nx = cnt > 0u ? cnt : 1u;
}

__device__ __forceinline__ void xcd_barrier(const XcdBarrier& b) {
    asm volatile("s_waitcnt vmcnt(0)" ::: "memory");
    __syncthreads();
    if (threadIdx.x == 0) {
        unsigned* bar = b.bar;
        __builtin_amdgcn_s_waitcnt(0);
        unsigned nloc = b.st[0], nx = b.st[1];
        if (nloc == 0u) { xcd_barrier_complete(bar, b.x, nloc, nx); b.st[0] = nloc; b.st[1] = nx; }
        const unsigned old = xb_add(&bar[XB_XSUB(b.x)], 1u);
        const unsigned gen = old / nloc;
        if (old + 1u == (gen + 1u) * nloc) {
            __builtin_amdgcn_fence(__ATOMIC_RELEASE, "agent");
            asm volatile("s_waitcnt vmcnt(0)" ::: "memory");
            const unsigned og = xb_add(&bar[XB_TOP], 1u);
            const unsigned tg = og / nx;
            if (og + 1u == (tg + 1u) * nx) xb_add(&bar[XB_TOPGEN], 1u);
            else XB_SPIN(xb_ld(&bar[XB_TOPGEN]) == tg, bar);
            __builtin_amdgcn_fence(__ATOMIC_ACQUIRE, "agent");
            xb_add(&bar[XB_XGEN(b.x)], 1u);
            asm volatile("s_waitcnt vmcnt(0)" ::: "memory");
        } else {
            XB_SPIN(xb_ld(&bar[XB_XGEN(b.x)]) == gen, bar);
            __builtin_amdgcn_fence(__ATOMIC_ACQUIRE, "agent");
            asm volatile("s_waitcnt vmcnt(0)" ::: "memory");
        }
    }
    __syncthreads();
}

struct Args { const float* in[12]; float* out; unsigned char* ws; int ph_lo, ph_hi, nbc, pad; };

__device__ __forceinline__ void f_item(LAS unsigned char* lds, const bf16* hb, const bf16* Wf, const float* bfv, const float* rowss, float* CL, float* TOT, int item, int wid, int lane) {
    const int b = item >> 6, blk = item & 63, fr = lane & 15, fq = lane >> 4;
    const int tok0 = b * SQ + blk * 128 + wid * 16;
    f32x4 acc = (f32x4){0.f, 0.f, 0.f, 0.f};
    const bf16* xa = hb + (size_t)(tok0 + fr) * DM + fq * 8; const bf16* wb = Wf + (size_t)fr * DM + fq * 8;
#pragma unroll 1
    for (int k8 = 0; k8 < 4; ++k8) { bf16x8 a8[8], w8[8];
#pragma unroll
        for (int q = 0; q < 8; ++q) { a8[q] = *(const bf16x8*)(xa + (k8 * 8 + q) * 32); w8[q] = *(const bf16x8*)(wb + (k8 * 8 + q) * 32); }
        asm volatile("" : "+v"(a8[0]), "+v"(a8[1]), "+v"(a8[2]), "+v"(a8[3]), "+v"(a8[4]), "+v"(a8[5]), "+v"(a8[6]), "+v"(a8[7]));
#pragma unroll
        for (int q = 0; q < 8; ++q) acc = __builtin_amdgcn_mfma_f32_16x16x32_bf16(a8[q], w8[q], acc, 0, 0, 0); }
    const float bias = bfv[fr]; float s[4]; float run = 0.f;
#pragma unroll
    for (int e = 0; e < 4; ++e) { const float rs = __builtin_amdgcn_rsqf(rowss[tok0 + 4 * fq + e] * (1.0f / 1024.0f) + 1e-6f); const float f = acc[e] * rs + bias;
        const float ls = fminf(f, 0.f) - log1pf(__expf(-fabsf(f))); run += ls; s[e] = run; }
    float pre = 0.f;
#pragma unroll
    for (int j = 0; j < 3; ++j) { const float tj = xl_from_lane(run, fr + 16 * j); if (j < fq) pre += tj; }
    LAS float* wtot = (LAS float*)lds;
    if (fq == 3) wtot[wid * 16 + fr] = pre + run;
    __syncthreads();
    float wpre = 0.f, all = 0.f;
#pragma unroll
    for (int w = 0; w < 8; ++w) { const float t = wtot[w * 16 + fr]; all += t; if (w < wid) wpre += t; }
    const float base = wpre + pre;
    *(f32x4*)(CL + (size_t)(b * 16 + fr) * SQ + blk * 128 + wid * 16 + 4 * fq) = (f32x4){base + s[0], base + s[1], base + s[2], base + s[3]};
    if (wid == 0 && fq == 0) TOT[(b * 16 + fr) * 64 + blk] = all;
    __syncthreads();
}

__device__ __forceinline__ unsigned offb(unsigned row, unsigned ch) { return 256u * row + 16u * (ch ^ (((row & 3) << 2) | ((row >> 2) & 3))); }
__device__ __forceinline__ int crow(int r, int hi) { return (r & 3) + 8 * (r >> 2) + 4 * hi; }
__device__ __forceinline__ int t5_bucket(int dist) {
    if (dist < 16) return dist;
    int b = 16;
    b += dist >= 22; b += dist >= 30; b += dist >= 40; b += dist >= 54; b += dist >= 73; b += dist >= 99; b += dist >= 134; b += dist >= 182;
    b += dist >= 246; b += dist >= 332; b += dist >= 450; b += dist >= 609; b += dist >= 825; b += dist >= 1117; b += dist >= 1513;
    return b;
}
#define BATT_DECODE(IT, KG, UG, LSEP, DD, RR, PP, GH) do { const int bl_ = (IT) / 768, r_ = (IT) % 768, g_ = r_ >> 8, h_ = (r_ >> 5) & 7, pi_ = r_ & 31; \
    DD = (g_ == 0) ? 1 : (g_ == 1) ? 4 : 16; const int ppr_ = 32 / DD; RR = pi_ / ppr_; PP = pi_ % ppr_; GH = g_ * 8 + h_; \
    KG = KV + ((((size_t)(b0 + bl_) * 3 + g_) * 2) * 8 + h_) * ((size_t)SQ * 128); UG = U + (size_t)bl_ * SQ * BIN + g_ * 1024 + h_ * 128; LSEP = LSE + (size_t)bl_ * SQ * 24; } while (0)
#define BATT_LOADK(KG, DD, RR, PP) do { const long koff_ = ((long)(RR) * (SQ / (DD)) + 256 * (PP) - 128 + row0) * 128 + ch0 * 8; const long kstr_ = 4096; \
    _Pragma("unroll") for (int i = 0; i < 12; ++i) kreg[i] = ((PP) > 0 || i >= 4) ? *(const v4u*)((KG) + koff_ + i * kstr_) : (v4u){0u, 0u, 0u, 0u}; } while (0)
__device__ __forceinline__ void battn_phase(LAS unsigned char* lds, const bf16* KV, bf16* U, float* LSE, const float* relb, int b0, int nitems, int vcu, int G, int tid_in, int wid, int reps) {
    int row0, ch0;
    { int t0 = tid_in; asm volatile("" : "+v"(t0)); row0 = t0 >> 4; ch0 = t0 & 15; }
    LAS float* lut = (LAS float*)(lds + 98304);
    LAS float* wsf = (LAS float*)(lds + 98304 + 1024) + wid * 32;
    LAS bf16* stg = (LAS bf16*)(lds + 98304 + 2048 + wid * 4096);
    const int total = nitems * reps;
    int it = vcu; if (it >= total) return;
    const bf16* Kg; bf16* Ug; float* LSEp; int d, rr, pp, gh;
    v4u kreg[12];
    { const int itm = it % nitems; BATT_DECODE(itm, Kg, Ug, LSEp, d, rr, pp, gh); BATT_LOADK(Kg, d, rr, pp); }
    for (;;) {
        const bool dry = it + nitems < total;
        int tid = tid_in; asm volatile("" : "+v"(tid));
        const int lane = tid & 63, r32 = lane & 31, hi = lane >> 5; const unsigned loff = offb((unsigned)(tid >> 4), (unsigned)(tid & 15));
        bf16x8 qf[8];
        { const size_t qtok_ = (size_t)((256 * pp + 32 * wid + r32) * d + rr);
#pragma unroll
          for (int d0 = 0; d0 < 8; ++d0) qf[d0] = *(const bf16x8*)(Ug + qtok_ * BIN + d0 * 16 + hi * 8); }
        if (tid < 192) { const int rel_ = tid - 32; lut[tid] = (rel_ >= 0 && rel_ <= 128) ? relb[t5_bucket(rel_ * d) * 24 + gh] * LOG2E : 0.f; }
#pragma unroll
        for (int i = 0; i < 12; ++i) *(LAS v4u*)(lds + i * 8192 + loff) = kreg[i];
        __syncthreads();
        v4u vreg[12];
        { const long koff_ = ((long)rr * (SQ / d) + 256 * pp - 128 + (tid >> 4)) * 128 + (tid & 15) * 8; const long kstr_ = 4096;
#pragma unroll
          for (int i = 0; i < 12; ++i) vreg[i] = (pp > 0 || i >= 4) ? *(const v4u*)(Kg + (size_t)8 * SQ * 128 + koff_ + i * kstr_) : (v4u){0u, 0u, 0u, 0u}; }
        f32x16 s[5];
        const unsigned xr = ((r32 & 3) << 2) | ((r32 >> 2) & 3);
#pragma unroll
        for (int kb = 0; kb < 5; ++kb) { s[kb] = (f32x16){0.f,0.f,0.f,0.f,0.f,0.f,0.f,0.f,0.f,0.f,0.f,0.f,0.f,0.f,0.f,0.f};
            const LAS unsigned char* tb = lds + (wid + kb) * 8192 + 256 * r32;
#pragma unroll
            for (int d0 = 0; d0 < 8; ++d0) { const bf16x8 kf = *(const LAS bf16x8*)(tb + 16 * ((unsigned)(2 * d0 + hi) ^ xr)); s[kb] = __builtin_amdgcn_mfma_f32_32x32x16_bf16(kf, qf[d0], s[kb], 0, 0, 0); } }
        float mx = -INFINITY;
        const int e_ = r32 - 4 * hi; const LAS float* lp = lut + (e_ + 32);
#pragma unroll
        for (int kb = 0; kb < 5; ++kb) {
            if (pp == 0 && wid + kb < 4) {
#pragma unroll
                for (int r = 0; r < 16; ++r) s[kb][r] = -INFINITY;
            } else {
#pragma unroll
                for (int r = 0; r < 16; ++r) { const int cr = (r & 3) + 8 * (r >> 2); float v = s[kb][r] + lp[128 - 32 * kb - cr];
                    if (kb == 0) v = (e_ <= cr) ? v : -INFINITY;
                    if (kb == 4) v = (e_ >= cr) ? v : -INFINITY;
                    s[kb][r] = v; mx = fmaxf(mx, v); }
            }
        }
        mx = xr_max<32>(mx);
        float l = 0.f;
#pragma unroll
        for (int kb = 0; kb < 5; ++kb)
#pragma unroll
            for (int r = 0; r < 16; ++r) { const float p = __builtin_amdgcn_exp2f(s[kb][r] - mx); s[kb][r] = p; l += p; }
        l = xr_sum<32>(l);
        bf16x8 pf[5][2];
#pragma unroll
        for (int kb = 0; kb < 5; ++kb)
#pragma unroll
            for (int ks = 0; ks < 2; ++ks) { v4u w; w.x = cvtpk(s[kb][8 * ks + 0], s[kb][8 * ks + 1]); w.y = cvtpk(s[kb][8 * ks + 2], s[kb][8 * ks + 3]); w.z = cvtpk(s[kb][8 * ks + 4], s[kb][8 * ks + 5]); w.w = cvtpk(s[kb][8 * ks + 6], s[kb][8 * ks + 7]);
                pf[kb][ks] = __builtin_bit_cast(bf16x8, w); }
        __syncthreads();
#pragma unroll
        for (int i = 0; i < 12; ++i) *(LAS v4u*)(lds + i * 8192 + loff) = vreg[i];
        if (hi == 0) wsf[r32] = __builtin_amdgcn_rcpf(l);
        __syncthreads();
        bf16* const Uc = Ug; float* const Lc = LSEp; const int dc = d, rrc = rr, ppc = pp, ghc = gh;
        const int nit = it + G; const bool has_next = nit < total;
        if (has_next) { const int itm = nit % nitems; BATT_DECODE(itm, Kg, Ug, LSEp, d, rr, pp, gh); BATT_LOADK(Kg, d, rr, pp); }
        f32x16 o[4];
        int l2 = lane; asm volatile("" : "+v"(l2));
        const unsigned blk = (l2 >> 4) & 1, qq = (l2 & 15) >> 2, p4 = l2 & 3;
#pragma unroll
        for (int c = 0; c < 4; ++c) { o[c] = (f32x16){0.f,0.f,0.f,0.f,0.f,0.f,0.f,0.f,0.f,0.f,0.f,0.f,0.f,0.f,0.f,0.f};
#pragma unroll
            for (int kb = 0; kb < 5; ++kb)
#pragma unroll
                for (int ks = 0; ks < 2; ++ks) { s16x4 vv[2];
#pragma unroll
                    for (int t = 0; t < 2; ++t) { const unsigned row = 16 * ks + 8 * t + 4 * hi + qq; const LAS unsigned char* ap = lds + (wid + kb) * 8192 + offb(row, 4 * c + 2 * blk + (p4 >> 1)) + 8 * (p4 & 1);
                        vv[t] = __builtin_bit_cast(s16x4, __builtin_amdgcn_ds_read_tr16_b64_v4i16((LAS s16x4*)ap)); }
                    const bf16x8 vf = (bf16x8){vv[0][0], vv[0][1], vv[0][2], vv[0][3], vv[1][0], vv[1][1], vv[1][2], vv[1][3]};
                    o[c] = __builtin_amdgcn_mfma_f32_32x32x16_bf16(pf[kb][ks], vf, o[c], 0, 0, 0); } }
        float rl[16];
#pragma unroll
        for (int r = 0; r < 16; ++r) rl[r] = wsf[crow(r, hi)];
#pragma unroll
        for (int hc = 0; hc < 2; ++hc) {
#pragma unroll
            for (int r = 0; r < 16; ++r) { const int qr_ = crow(r, hi);
#pragma unroll
                for (int cc = 0; cc < 2; ++cc) stg[qr_ * 64 + cc * 32 + r32] = (bf16)cvtpk(o[2 * hc + cc][r] * rl[r], 0.f); }
#pragma unroll
            for (int i = 0; i < 4; ++i) { const int row = i * 8 + (l2 >> 3), ch = l2 & 7; const v4u v = *(const LAS v4u*)(stg + row * 64 + ch * 8);
                const size_t tok = (size_t)((256 * ppc + 32 * wid + row) * dc + rrc); if (!dry) *(v4u*)(Uc + tok * BIN + hc * 64 + ch * 8) = v; }
        }
        if (hi == 0 && !dry) Lc[(size_t)((256 * ppc + 32 * wid + r32) * dc + rrc) * 24 + ghc] = mx + __builtin_amdgcn_logf(l);
        __syncthreads();
        if (!has_next) break;
        it = nit;
    }
}
#ifndef PHASE_MASK
#define PHASE_MASK 0xffff
#endif
#define EN(k) ((PHASE_MASK >> (k)) & 1)
#ifndef PROBE_GEMM_REPS
#define PROBE_GEMM_REPS 1
#endif
#ifndef PROBE_BATT_REPS
#define PROBE_BATT_REPS 1
#endif
#ifndef PROBE_RES_REPS
#define PROBE_RES_REPS 1
#endif
#ifndef PROBE_MEM_REPS
#define PROBE_MEM_REPS 1
#endif
#ifndef PROBE_ATT_REPS
#define PROBE_ATT_REPS 1
#endif
enum { K_PRO = 0, K_AIN, K_AATT, K_AOUT, K_KV, K_BIN, K_BATT, K_BMRG, K_BOUT, K_FIN };
__global__ void __launch_bounds__(NTHR, 2) yoco_fwd(Args args) {
    extern __shared__ __attribute__((aligned(16))) unsigned char lds_raw[];
    cg::grid_group grid = cg::this_grid();
    LAS unsigned char* lds = (LAS unsigned char*)lds_raw;
    const int wid0 = __builtin_amdgcn_readfirstlane(threadIdx.x >> 6);
#define INP(k) ({ int k_ = (k); asm volatile("" : "+s"(k_)); (const float*)(GAS const float*)args.in[k_]; })
    volatile LAS unsigned* bst = (volatile LAS unsigned*)((LAS unsigned char*)lds_raw + LDS_BYTES - 64);
    if (threadIdx.x < 2) bst[threadIdx.x] = 0u;
    __syncthreads();
    (void)xcd_barrier_post((unsigned*)(args.ws + WS_BAR), bst);

    for (int ph = args.ph_lo; ; ++ph) {
        int G = gridDim.x; asm volatile("" : "+s"(G)); int bx = blockIdx.x; asm volatile("" : "+s"(bx)); int nbc = args.nbc; asm volatile("" : "+s"(nbc));
        const int vcu = (G % 8 == 0) ? (bx % 8) * (G / 8) + bx / 8 : bx;
        const int lnch = (nbc == 8) ? 0 : (nbc == 4) ? 1 : (nbc == 2) ? 2 : 3, nch = 1 << lnch;
        const int n_phase = 8 + 6 * nch + 1;
        const int NGW = G * NWAVES;
        if (ph >= args.ph_hi || ph >= n_phase) break;
        int kind, layer = 0, chunk = 0;
        if (ph == 0) kind = K_PRO;
        else if (ph < 7) { layer = (ph - 1) / 3; kind = K_AIN + (ph - 1) % 3; }
        else if (ph == 7) kind = K_KV;
        else if (ph < 8 + 6 * nch) { const int q = ph - 8, j = q / 3; layer = j >> lnch; chunk = j & (nch - 1); kind = K_BATT + (q - 3 * j); }
        else kind = K_FIN;

        for (int pass_ = 0; pass_ < 2; ++pass_) {
        if (pass_ == 1) { if (kind != K_BOUT && kind != K_KV) break; const int j = (kind == K_KV) ? 0 : (layer << lnch) + chunk + 1; if (j >= 2 * nch) break; layer = j >> lnch; chunk = j & (nch - 1); kind = K_BIN; }
        int tid; asm volatile("v_mbcnt_lo_u32_b32 %0, -1, 0\n\tv_mbcnt_hi_u32_b32 %0, -1, %0" : "=v"(tid)); tid += wid0 * 64;
        GAS unsigned char* ws = (GAS unsigned char*)args.ws; asm volatile("" : "+s"(ws)); GAS float* outg = (GAS float*)args.out; asm volatile("" : "+s"(outg)); float* out = (float*)outg; bf16* HB = (bf16*)out; bf16* LOP = HB + (size_t)MT * DM;
        const int lane = tid & 63, wid = __builtin_amdgcn_readfirstlane(tid >> 6); const int gw = vcu * NWAVES + wid;
        if (EN(K_PRO) && kind == K_PRO) {
            const float* x = INP(0); const float* norm_a = INP(2); const float* w_in_a = INP(3); const float* w_out_a = INP(5); const float* norm_kv = INP(6); const float* w_kv = INP(7); const float* norm_b = INP(8); const float* w_in_b = INP(9); const float* w_out_b = INP(10);
            for (int rp_ = 0; rp_ < PROBE_MEM_REPS; ++rp_) {
            LAS float* scr = (LAS float*)(lds + wid * 16384);
            constexpr int I_INA = 16 * 128, I_OUT = 16 * 32, I_KV = 16 * 192, I_INB = 16 * 128;
            constexpr int NITEMS = 2 * I_INA + 2 * I_OUT + I_KV + 2 * I_INB + 2 * I_OUT + 32;
#pragma unroll 1
            for (int it = gw; it < NITEMS; it += NGW) {
                int r = it;
                if (r < 2 * I_INA) { const int i = r / I_INA; p0_transpose_item(w_in_a + (size_t)i * DM * FOX_IN, DM, FOX_IN, 128, norm_a + i * DM, (bf16*)(ws + WS_WINA + (size_t)i * 8 * MiB), scr, r % I_INA, lane); continue; } r -= 2 * I_INA;
                if (r < 2 * I_OUT) { const int i = r / I_OUT; p0_transpose_item(w_out_a + (size_t)i * DM * DM, DM, DM, 32, nullptr, (bf16*)(ws + WS_WOUTA + (size_t)i * 2 * MiB), scr, r % I_OUT, lane); continue; } r -= 2 * I_OUT;
                if (r < I_KV) { p0_transpose_item(w_kv, DM, KVW, 192, norm_kv, (bf16*)(ws + WS_WKV), scr, r, lane); continue; } r -= I_KV;
                if (r < 2 * I_INB) { const int i = r / I_INB; p0_transpose_item(w_in_b + (size_t)i * DM * BIN, DM, BIN, 128, norm_b + i * DM, (bf16*)(ws + WS_WINB + (size_t)i * 8 * MiB), scr, r % I_INB, lane); continue; } r -= 2 * I_INB;
                if (r < 2 * I_OUT) { const int i = r / I_OUT; p0_transpose_item(w_out_b + (size_t)i * DM * DM, DM, DM, 32, nullptr, (bf16*)(ws + WS_WOUTB + (size_t)i * 2 * MiB), scr, r % I_OUT, lane); continue; } r -= 2 * I_OUT;
                { const int i = r >> 4, n = r & 15;
#pragma unroll 4
                  for (int j = 0; j < 16; ++j) { const int k = lane + 64 * j; ((bf16*)(ws + WS_WF))[(i * 16 + n) * DM + k] = (bf16)f2bf(norm_a[i * DM + k] * w_in_a[(size_t)i * DM * FOX_IN + (size_t)k * FOX_IN + 4096 + n]); } }
            }
            float* RS0 = (float*)(ws + WS_RS0);
#pragma unroll 1
            for (int m = gw; m < MT; m += NGW) {
                const f32x4* xr = (const f32x4*)(x + (size_t)m * DM) + lane; unsigned long long* hrow = (unsigned long long*)(HB + (size_t)m * DM) + lane;
                f32x4 v[4]; float s = 0.f;
#pragma unroll
                for (int j = 0; j < 4; ++j) v[j] = xr[64 * j];
                asm volatile("" : "+v"(v[0]), "+v"(v[1]), "+v"(v[2]), "+v"(v[3]));
#pragma unroll
                for (int j = 0; j < 4; ++j) s += (v[j].x * v[j].x + v[j].y * v[j].y) + (v[j].z * v[j].z + v[j].w * v[j].w);
                s = wave_sum(s);
#pragma unroll
                for (int j = 0; j < 4; ++j) { const unsigned h0 = cvtpk(v[j].x, v[j].y), h1 = cvtpk(v[j].z, v[j].w);
                    hrow[64 * j] = (unsigned long long)h0 | ((unsigned long long)h1 << 32); }
                if (lane == 0) RS0[m] = s;
            }
            }
        }
        else if (EN(K_AIN) && (kind == K_AIN || kind == K_KV || kind == K_BIN)) {
            pg8::Gemm g; pg8::EpiBf16Row E;
            if (kind == K_AIN) {
                const float* rs = (const float*)(ws + (layer == 0 ? WS_RS0 : WS_RS1));
#pragma unroll 1
                for (int it = vcu; it < 512; it += G)
                    f_item(lds, HB, (const bf16*)(ws + WS_WF) + (size_t)layer * 16 * DM, INP(4) + layer * 16, rs, (float*)(ws + WS_CL), (float*)(ws + WS_TOT), it, wid, lane);
                g = pg8::Gemm{HB, (const bf16*)(ws + WS_WINA + (size_t)layer * 8 * MiB), MT, 4096, DM, DM};
                E = pg8::EpiBf16Row{(bf16*)(ws + WS_Q), DM, rs, DM, (size_t)(WS_K - WS_Q) / 2, DM, C2A, 0, (unsigned*)(ws + WS_NRM) + (size_t)layer * 32768};
            } else if (kind == K_KV) {
                g = pg8::Gemm{HB, (const bf16*)(ws + WS_WKV), MT, KVW, DM, DM};
                E = pg8::EpiBf16Row{(bf16*)(ws + WS_KV), KVW, (const float*)(ws + WS_RS2), 0, 0, 0, 1.f, 1, nullptr};
            } else {
                const size_t row0 = (size_t)chunk * nbc * SQ;
                g = pg8::Gemm{HB + row0 * DM, (const bf16*)(ws + WS_WINB + (size_t)layer * 8 * MiB), nbc * SQ, BIN, DM, DM};
                E = pg8::EpiBf16Row{(bf16*)(ws + WS_U), BIN, (const float*)(ws + (layer == 0 ? WS_RS2 : WS_RS3)) + row0, 0, 0, 3072, C2B, 0, nullptr};
            }
            pg8::StaticOrder S; S.init(g.M, g.N, G, bx);
            for (int rep_ = 0; rep_ < PROBE_GEMM_REPS; ++rep_) pg8::gemm_phase<pg8::EpiBf16Row, pg8::StaticOrder, true, true>(lds, g, S, E, tid);
        }
        else if (EN(K_AATT) && kind == K_AATT) {
            const attn_body::AttnTensors AT{(const attn_body::bf16*)(ws + WS_Q), (const attn_body::bf16*)(ws + WS_K), (const attn_body::bf16*)(ws + WS_V), (attn_body::bf16*)(ws + WS_O),
                                            (const attn_body::bf16*)(ws + WS_G), (const float*)(ws + WS_CL), (const float*)(ws + WS_TOT), (const float*)(ws + WS_NRM) + (size_t)layer * 32768};
            const attn_body::DynOrder S{(unsigned*)(ws + WS_QH) + layer * 512, (int)(__builtin_amdgcn_s_getreg((3 << 11) | 20) & 7), wid0, (LAS unsigned*)(lds + attn_body::LDS_REL + 260)};
            if (tid == 0) *S.slot = 0xfffffffeu;
            __syncthreads();
            attn_body::attn_phase<attn_body::DynOrder, 24>((char*)lds_raw, AT, S);
#if PROBE_ATT_REPS > 1
            { const attn_body::DynOrder S2{(unsigned*)(ws + WS_QH) + 1024 + layer * 512, S.xcc, wid0, S.slot}; __syncthreads(); attn_body::attn_phase<attn_body::DynOrder, 24>((char*)lds_raw, AT, S2); }
#endif

        }
        else if (EN(K_AOUT) && (kind == K_AOUT || kind == K_BOUT)) {
            pg8::Gemm g; pg8::EpiResid E;
            if (kind == K_AOUT) {
                g = pg8::Gemm{(const bf16*)(ws + WS_O), (const bf16*)(ws + WS_WOUTA + (size_t)layer * 2 * MiB), MT, DM, DM, DM};
                E = pg8::EpiResid{HB, LOP, nullptr, (float*)(ws + (layer == 0 ? WS_RS1 : WS_RS2)), DM, 0, layer == 0 ? INP(0) : (const float*)nullptr};
            } else {
                const size_t row0 = (size_t)chunk * nbc * SQ;
                g = pg8::Gemm{(const bf16*)(ws + WS_MA), (const bf16*)(ws + WS_WOUTB + (size_t)layer * 2 * MiB), nbc * SQ, DM, DM, DM};
                E = pg8::EpiResid{HB + row0 * DM, LOP + row0 * DM, layer == 0 ? (float*)nullptr : (float*)(ws + WS_KV) + (size_t)chunk * nbc * pg8::FIN_BSTRIDE, layer == 0 ? (float*)(ws + WS_RS3) + row0 : (float*)nullptr, DM, 0, nullptr};
            }
            pg8::StaticOrder S; S.init(g.M, g.N, G, bx);
#if PROBE_RES_REPS > 1
            { pg8::EpiResid E2 = E; E2.dry = 1; pg8::gemm_phase<pg8::EpiResid, pg8::StaticOrder, true, true>(lds, g, S, E2, tid); }
#endif
            pg8::gemm_phase<pg8::EpiResid, pg8::StaticOrder, true, true>(lds, g, S, E, tid);
        }
        else if (EN(K_BATT) && kind == K_BATT) {
            battn_phase(lds, (const bf16*)(ws + WS_KV), (bf16*)(ws + WS_U), (float*)(ws + WS_LSE), INP(1), chunk * nbc, nbc * 768, vcu, G, tid, wid, PROBE_BATT_REPS);
        }
        else if (EN(K_BMRG) && kind == K_BMRG) {
            const float* LSE = (const float*)(ws + WS_LSE); const bf16* U = (const bf16*)(ws + WS_U);
#pragma unroll 1
            for (int m = gw; m < nbc * SQ; m += NGW) {
                const int hh = lane >> 3; const float* lp = LSE + (size_t)m * 24 + hh;
                float l0 = lp[0], l1 = lp[8], l2 = lp[16];
                const bf16* urow = U + (size_t)m * BIN + 16 * lane;
                v4u a[2], b[2], c[2], gt[2];
#pragma unroll
                for (int j = 0; j < 2; ++j) { a[j] = *(const v4u*)(urow + 8 * j); b[j] = *(const v4u*)(urow + 1024 + 8 * j); c[j] = *(const v4u*)(urow + 2048 + 8 * j); gt[j] = *(const v4u*)(urow + 3072 + 8 * j); }
                asm volatile("" : "+v"(l0), "+v"(l1), "+v"(l2), "+v"(a[0]), "+v"(a[1]), "+v"(b[0]), "+v"(b[1]), "+v"(c[0]), "+v"(c[1]), "+v"(gt[0]), "+v"(gt[1]));
                const float mxl = fmaxf(l0, fmaxf(l1, l2));
                float w0 = __builtin_amdgcn_exp2f(l0 - mxl), w1 = __builtin_amdgcn_exp2f(l1 - mxl), w2 = __builtin_amdgcn_exp2f(l2 - mxl); const float inv = __builtin_amdgcn_rcpf(w0 + w1 + w2); w0 *= inv; w1 *= inv; w2 *= inv;
#pragma unroll
                for (int j = 0; j < 2; ++j) { v4u o;
#pragma unroll
                    for (int e = 0; e < 4; ++e) { const float v0 = (w0 * bflo(a[j][e]) + w1 * bflo(b[j][e]) + w2 * bflo(c[j][e])) * silu_f(bflo(gt[j][e])), v1 = (w0 * bfhi(a[j][e]) + w1 * bfhi(b[j][e]) + w2 * bfhi(c[j][e])) * silu_f(bfhi(gt[j][e])); o[e] = cvtpk(v0, v1); }
                    *(v4u*)((bf16*)(ws + WS_MA) + (size_t)m * DM + 16 * lane + 8 * j) = o; }
            }
        }
        else if (EN(K_FIN) && kind == K_FIN) {
            const f32x4* gp0 = (const f32x4*)INP(11) + lane;
            for (int rp_ = 0; rp_ < PROBE_MEM_REPS; ++rp_)
#pragma unroll 1
            for (int m = gw; m < MT; m += NGW) {
                f32x4* orow = (f32x4*)(out + (size_t)m * DM) + lane; f32x4 v[4]; float s = 0.f;
                const f32x4* irow = (const f32x4*)((const float*)(ws + WS_KV) + (size_t)(m >> 13) * pg8::FIN_BSTRIDE + (size_t)(m & 8191) * DM) + lane;
#pragma unroll
                for (int j = 0; j < 4; ++j) v[j] = irow[64 * j];
                f32x4 gfin[4];
#pragma unroll
                for (int j = 0; j < 4; ++j) gfin[j] = gp0[64 * j];
                asm volatile("" : "+v"(v[0]), "+v"(v[1]), "+v"(v[2]), "+v"(v[3]), "+v"(gfin[0]), "+v"(gfin[1]), "+v"(gfin[2]), "+v"(gfin[3]));
#pragma unroll
                for (int j = 0; j < 4; ++j) s += (v[j].x * v[j].x + v[j].y * v[j].y) + (v[j].z * v[j].z + v[j].w * v[j].w);
                const float rs = 1.0f / sqrtf(wave_sum(s) * (1.0f / 1024.0f) + 1e-6f);
#pragma unroll
                for (int j = 0; j < 4; ++j) orow[64 * j] = v[j] * rs * gfin[j];
            }
        }
        }
        if (ph + 1 < args.ph_hi && ph + 1 < n_phase) { if (ph == args.ph_lo) grid.sync(); else { XcdBarrier xbar; xbar.bar = (unsigned*)(args.ws + WS_BAR); xbar.x = xb_xcc_id(); xbar.st = bst; xcd_barrier(xbar); } }
    }
}

extern "C" void kernel_launch(void* const* d_in, const int* in_sizes, int n_in, void* d_out, int out_size, void* d_ws, size_t ws_size, hipStream_t stream) {
    static int grid = 0, nbc = 1;
    if (grid == 0) {
        if (n_in != 12 || in_sizes[0] != MT * DM || out_size != MT * DM || ws_size < WS_END) { fprintf(stderr, "kernel_launch: unexpected shapes / workspace (n_in %d, ws %zu); nothing launched\n", n_in, ws_size); grid = -1; return; }
        int dev = 0, cus = 0, per_cu = 0;
        if (hipGetDevice(&dev) != hipSuccess || hipDeviceGetAttribute(&cus, hipDeviceAttributeMultiprocessorCount, dev) != hipSuccess) { grid = -1; return; }
        if (hipFuncSetAttribute((const void*)yoco_fwd, hipFuncAttributeMaxDynamicSharedMemorySize, LDS_BYTES) != hipSuccess) { fprintf(stderr, "kernel_launch: hipFuncSetAttribute failed\n"); grid = -1; return; }
        if (hipOccupancyMaxActiveBlocksPerMultiprocessor(&per_cu, (const void*)yoco_fwd, NTHR, LDS_BYTES) != hipSuccess || per_cu < 1) { fprintf(stderr, "kernel_launch: occupancy query gave %d\n", per_cu); per_cu = 1; }
        (void)hipGetLastError();
        grid = cus;
        nbc = 2;
    }
    if (grid < 0) return;
    (void)hipMemsetAsync((char*)d_ws, 0, CTL_ZERO_BYTES, stream);
    Args a{};
    for (int i = 0; i < 12; ++i) a.in[i] = (const float*)d_in[i];
    a.out = (float*)d_out; a.ws = (unsigned char*)d_ws; a.ph_lo = 0; a.ph_hi = 1 << 20; a.nbc = nbc; a.pad = 0;
    void* kargs[] = {&a};
    hipError_t e = hipLaunchCooperativeKernel((const void*)yoco_fwd, dim3(grid), dim3(NTHR), kargs, LDS_BYTES, stream);
    if (e != hipSuccess) fprintf(stderr, "kernel_launch: cooperative launch failed: %s (grid %d)\n", hipGetErrorString(e), grid);
}
```

```cpp
#include <hip/hip_runtime.h>
#include <hip/hip_cooperative_groups.h>
#include <hip/hip_bf16.h>
#include <cstdio>
#include <cstdint>
#include <cmath>
namespace cg = cooperative_groups;
template <int M> __device__ __forceinline__ float xl_partner_lt32(float v) { static_assert(M >= 1 && M < 32, "xor mask"); return __builtin_bit_cast(float, __builtin_amdgcn_ds_swizzle(__builtin_bit_cast(int, v), (M << 10) | 0x1f)); }
template <int M> __device__ __forceinline__ float xr_sum(float v) { if constexpr (M == 32) { const unsigned u = __builtin_bit_cast(unsigned, v); auto rr = __builtin_amdgcn_permlane32_swap(u, u, false, false); return __builtin_bit_cast(float, (unsigned)rr[0]) + __builtin_bit_cast(float, (unsigned)rr[1]); } else return v + xl_partner_lt32<M>(v); }
template <int M> __device__ __forceinline__ float xr_max(float v) { if constexpr (M == 32) { const unsigned u = __builtin_bit_cast(unsigned, v); auto rr = __builtin_amdgcn_permlane32_swap(u, u, false, false); return __builtin_fmaxf(__builtin_bit_cast(float, (unsigned)rr[0]), __builtin_bit_cast(float, (unsigned)rr[1])); } else return __builtin_fmaxf(v, xl_partner_lt32<M>(v)); }
template <int M> __device__ __forceinline__ float xr_min(float v) { if constexpr (M == 32) { const unsigned u = __builtin_bit_cast(unsigned, v); auto rr = __builtin_amdgcn_permlane32_swap(u, u, false, false); return __builtin_fminf(__builtin_bit_cast(float, (unsigned)rr[0]), __builtin_bit_cast(float, (unsigned)rr[1])); } else return __builtin_fminf(v, xl_partner_lt32<M>(v)); }
__device__ __forceinline__ float xl_from_lane(float v, int src_lane) { return __builtin_bit_cast(float, __builtin_amdgcn_ds_bpermute(src_lane << 2, __builtin_bit_cast(int, v))); }
namespace pg8 {
#define PG8_LAS __attribute__((address_space(3)))
typedef unsigned short bf16_t;
typedef short bf16x8 __attribute__((ext_vector_type(8)));
typedef float f32x4 __attribute__((ext_vector_type(4)));
typedef unsigned u32x4 __attribute__((ext_vector_type(4)));
constexpr int BM = 256, BK = 64, HALF = 128, HTB = HALF * BK * 2  , STAGE_BYTES = 8 * HTB, NXCD = 8, WGM = 8;

__host__ __device__ __forceinline__ int lds_byte(int r, int c) { const int st = (r >> 4) * 2 + (c >> 5), rr = r & 15, cc = c & 31, ob = rr * 64 + cc * 2; return st * 1024 + (ob ^ (((ob >> 9) & 1) << 5)); }
__host__ __device__ __forceinline__ void stage_rc(int b, int& R, int& C) { const int st = b / 1024, sb = b % 1024, swz = sb ^ (((sb >> 9) & 1) << 5); R = (st >> 1) * 16 + swz / 64; C = (st & 1) * 32 + (swz % 64) / 2; }
__host__ __device__ __forceinline__ int perm32(int rho) { const int n = rho >> 4, i = rho & 15; return 8 * (i >> 2) + 4 * n + (i & 3); }

struct Unit { int pm, pn; };
struct Gemm { const bf16_t* A; const bf16_t* Bt; int M, N, K, lda; };

struct StaticOrder {
    int nM, nN, nwg, G, c;
    __host__ __device__ void init(int M, int N, int G_, int c_) { nM = M / BM; nN = N / BM; nwg = nM * nN; G = G_; c = c_; }
    __host__ __device__ bool next(int i, Unit& u) const {
        const long L = (long)i * G + c; if (L >= nwg) return false;
        int wgid = (int)L; { const int q = nwg / NXCD, r = nwg % NXCD, xcd = wgid % NXCD, off = wgid / NXCD; wgid = (xcd < r ? xcd * (q + 1) : r * (q + 1) + (xcd - r) * q) + off; }
        const int nig = WGM * nN, gid = wgid / nig, fm = gid * WGM, gsz = (nM - fm) < WGM ? (nM - fm) : WGM;
        u.pm = fm + ((wgid % nig) % gsz); u.pn = (wgid % nig) / gsz; return true;
    }
    __device__ __forceinline__ void a_ready(const Unit&) const {}
    __device__ __forceinline__ void done(const Unit&) const {}
};

__device__ __forceinline__ unsigned cvt_pk_bf16(float lo, float hi) { unsigned r; asm volatile("v_cvt_pk_bf16_f32 %0, %1, %2" : "=v"(r) : "v"(lo), "v"(hi)); return r; }
constexpr float RMS_EPS_F = 1e-6f;
struct EpiBf16Row {
    static constexpr bool PERM = true, AFTER_DRAIN = false;
    bf16_t* O; int ldc; const float* rowss; int split_cols; size_t split_stride; int qcols; float qscale;
    bf16_t* O2; int o2rows;
    int kvmode;
    unsigned* nrm;
    __device__ __forceinline__ void operator()(const f32x4 (&acc)[2][2][4][2], const Unit& u, int wr, int wc, int fr, int fq) const {
        typedef __attribute__((address_space(1))) u32x4 gu32x4; typedef __attribute__((address_space(1))) const float gcf32;
        const int row0 = u.pm * BM + wr * 64 + fr; int colt = u.pn * BM; bf16_t* base = O;
        const float sc = (colt < qcols) ? qscale : 1.f; int t = 0;
        if (split_cols) { t = colt / split_cols; base += (size_t)t * split_stride; colt -= t * split_cols; }
        const int col0 = colt + wc * 32 + 8 * fq;
        const bool do_n = (nrm != nullptr) && (t < 2);
        float rsv[2][4];
#pragma unroll
        for (int ai = 0; ai < 2; ++ai)
#pragma unroll
            for (int m = 0; m < 4; ++m) rsv[ai][m] = ((gcf32*)rowss)[row0 + ai * HALF + m * 16];
        float mx[2][2] = {{0.f, 0.f}, {0.f, 0.f}};
#pragma unroll
        for (int ai = 0; ai < 2; ++ai)
#pragma unroll
            for (int m = 0; m < 4; ++m) { const int r = row0 + ai * HALF + m * 16; const float rs = __builtin_amdgcn_rsqf(rsv[ai][m] * (1.0f / 1024.0f) + RMS_EPS_F) * sc;
                bf16_t* rowp = ((o2rows && r >= o2rows) ? O2 + (size_t)(r - o2rows) * ldc : base + (size_t)r * ldc) + col0; size_t bjs = HALF;
                if (kvmode) { const int g = colt / 2048, kv = (colt >> 10) & 1, h0 = (colt >> 7) & 7, ld = 2 * g, b = r >> 13, tk = r & 8191;
                    const int pos = ((tk & ((1 << ld) - 1)) << (13 - ld)) + (tk >> ld);
                    rowp = O + ((((size_t)(b * 3 + g) * 2 + kv) * 8 + h0) * 8192 + pos) * 128 + wc * 32 + 8 * fq; bjs = (size_t)8192 * 128; }
#pragma unroll
                for (int bj = 0; bj < 2; ++bj) { const f32x4 v0 = acc[ai][bj][m][0] * rs, v1 = acc[ai][bj][m][1] * rs;
                    u32x4 w; w.x = cvt_pk_bf16(v0[0], v0[1]); w.y = cvt_pk_bf16(v0[2], v0[3]); w.z = cvt_pk_bf16(v1[0], v1[1]); w.w = cvt_pk_bf16(v1[2], v1[3]);
                    *(gu32x4*)(rowp + bj * bjs) = w;
                    if (do_n) { float ss = (v0[0] * v0[0] + v0[1] * v0[1]) + (v0[2] * v0[2] + v0[3] * v0[3]) + (v1[0] * v1[0] + v1[1] * v1[1]) + (v1[2] * v1[2] + v1[3] * v1[3]);
                        ss = xr_sum<16>(ss); ss = xr_sum<32>(ss); mx[ai][bj] = fmaxf(mx[ai][bj], ss); } } }
        if (do_n) {
#pragma unroll
            for (int ai = 0; ai < 2; ++ai)
#pragma unroll
                for (int bj = 0; bj < 2; ++bj) { float v = mx[ai][bj]; v = xr_max<1>(v); v = xr_max<2>(v); v = xr_max<4>(v); v = xr_max<8>(v);
                    if (fr == 0 && fq == 0) { const int b = u.pm >> 5, blk = ((u.pm & 31) << 1) + ai, head = (colt >> 6) + 2 * bj + (wc >> 1);
                        __hip_atomic_fetch_max(nrm + ((((size_t)(t * 8 + b) * 16 + head) * 64 + blk) * 2 + (wc & 1)), __float_as_uint(v), __ATOMIC_RELAXED, __HIP_MEMORY_SCOPE_AGENT); } }
        }
    }
};
constexpr size_t FIN_BSTRIDE = (size_t)8192 * 6144 * 2 / 4;
#ifndef RESID_LO
#define RESID_LO 0
#endif
struct EpiResid {
    static constexpr bool PERM = false, AFTER_DRAIN = false;
    bf16_t* phi; bf16_t* plo; float* fin; float* rowss; int ldc; int dry; const float* xbase;
    template <bool FIN, bool XB> __device__ __forceinline__ void body(const f32x4 (&acc)[2][2][4][2], const Unit& u, int wr, int wc, int fr, int fq) const {
        typedef unsigned u32x2v __attribute__((ext_vector_type(2))); typedef __attribute__((address_space(1))) u32x2v gu2; typedef __attribute__((address_space(1))) f32x4 gf4;
        const int col0 = u.pn * BM + wc * 32 + 4 * fq, rbase = u.pm * BM + wr * 64 + fr;
        u32x2v H[2][4], L[2][4]; typedef __attribute__((address_space(1))) const f32x4 gcf4;
#define PG8_LOADG(g, b) do { const size_t off_ = (size_t)(rbase + ((g) >> 2) * HALF + ((g) & 3) * 16) * ldc + col0; \
        _Pragma("unroll") for (int c = 0; c < 4; ++c) { const size_t o4_ = off_ + (c >> 1) * HALF + (c & 1) * 16; if (XB) { const f32x4 xv_ = *(gcf4*)(xbase + o4_); H[b][c] = (u32x2v){__float_as_uint(xv_[0]), __float_as_uint(xv_[1])}; L[b][c] = (u32x2v){__float_as_uint(xv_[2]), __float_as_uint(xv_[3])}; } \
            else { H[b][c] = *(const gu2*)(phi + o4_); if (RESID_LO) L[b][c] = *(const gu2*)(plo + o4_); else L[b][c] = (u32x2v){0u, 0u}; } } } while (0)
        PG8_LOADG(0, 0);
#pragma unroll
        for (int g = 0; g < 8; ++g) { const int ai = g >> 2, m = g & 3, cb = g & 1;
            if (g < 7) PG8_LOADG(g + 1, cb ^ 1);
            const int r = rbase + ai * HALF + m * 16; const size_t off = (size_t)r * ldc + col0; float s = 0.f;
            float* frow = FIN ? fin + (size_t)(r >> 13) * FIN_BSTRIDE + (size_t)(r & 8191) * 1024 + col0 : nullptr;
#pragma unroll
            for (int c = 0; c < 4; ++c) { const int bj = c >> 1, n = c & 1; const size_t o4 = off + bj * HALF + n * 16; const u32x2v h = H[cb][c], l = L[cb][c];
                f32x4 o; if (XB) { o[0] = __uint_as_float(h.x); o[1] = __uint_as_float(h.y); o[2] = __uint_as_float(l.x); o[3] = __uint_as_float(l.y); }
                else { o[0] = __uint_as_float(h.x << 16) + __uint_as_float(l.x << 16); o[1] = __uint_as_float(h.x & 0xffff0000u) + __uint_as_float(l.x & 0xffff0000u);
                o[2] = __uint_as_float(h.y << 16) + __uint_as_float(l.y << 16); o[3] = __uint_as_float(h.y & 0xffff0000u) + __uint_as_float(l.y & 0xffff0000u); }
                o = o + acc[ai][bj][m][n];
                s += (o[0] * o[0] + o[1] * o[1]) + (o[2] * o[2] + o[3] * o[3]);
                if (FIN) *(gf4*)(frow + bj * HALF + n * 16) = o;
                else { u32x2v nh; nh.x = cvt_pk_bf16(o[0], o[1]); nh.y = cvt_pk_bf16(o[2], o[3]);
                    u32x2v nl; nl.x = cvt_pk_bf16(o[0] - __uint_as_float(nh.x << 16), o[1] - __uint_as_float(nh.x & 0xffff0000u)); nl.y = cvt_pk_bf16(o[2] - __uint_as_float(nh.y << 16), o[3] - __uint_as_float(nh.y & 0xffff0000u));
                    *(gu2*)(phi + o4) = nh; if (RESID_LO) *(gu2*)(plo + o4) = nl; } }
            s = xr_sum<16>(s); s = xr_sum<32>(s);
            if (rowss && fq == 0) __hip_atomic_fetch_add(rowss + r, s, __ATOMIC_RELAXED, __HIP_MEMORY_SCOPE_AGENT);
        }
#undef PG8_LOADG
    }
    __device__ __forceinline__ void operator()(const f32x4 (&acc)[2][2][4][2], const Unit& u, int wr, int wc, int fr, int fq) const {
        if (dry) { f32x4 t = acc[0][0][0][0];
#pragma unroll
            for (int a = 0; a < 2; ++a)
#pragma unroll
                for (int b = 0; b < 2; ++b)
#pragma unroll
                    for (int m = 0; m < 4; ++m)
#pragma unroll
                        for (int n = 0; n < 2; ++n) t += acc[a][b][m][n];
            if (t[0] + t[1] + t[2] + t[3] == 1.2345e30f) plo[0] = 0; return; }
        if (fin) body<true, false>(acc, u, wr, wc, fr, fq); else if (xbase) body<false, true>(acc, u, wr, wc, fr, fq); else body<false, false>(acc, u, wr, wc, fr, fq);
    }
};

template <class Epi, class Sched, bool ALIGN_EPI = false, bool SP2 = false>
__device__ __forceinline__ void gemm_phase(PG8_LAS unsigned char* lds, const Gemm g, const Sched& S, const Epi& E, const int tid_in) {
    const int tid = tid_in, wid = __builtin_amdgcn_readfirstlane(tid >> 6), lane = tid & 63, wr = wid >> 2, wc = wid & 3, fr = lane & 15, fq = lane >> 4;
    const int K = g.K, nt = K / BK;
    unsigned voffA[2], voffB[2];
#pragma unroll
    for (int i = 0; i < 2; ++i) { int R, C; stage_rc(tid * 16 + i * 8192, R, C); const int Rb = Epi::PERM ? ((R & ~31) + perm32(R & 31)) : R;
        voffA[i] = (unsigned)(R * g.lda + C) * 2u; voffB[i] = (unsigned)(Rb * K + C) * 2u; }
    const size_t kstep = (size_t)(BK * 2);
    const size_t hstepA = (size_t)HALF * g.lda * 2, hstepB = (size_t)HALF * K * 2;
    const size_t tstepA = 2 * hstepA, tstepB = 2 * hstepB;
    const unsigned ldsw = (unsigned)wid * 1024u;
    const int aoff = lds_byte(wr * 64 + fr, fq * 8), boff = lds_byte(wc * 32 + fr, fq * 8);
#define PG8_SA(b, h) (((b) * 2 + (h)) * HTB)
#define PG8_SB(b, h) ((4 + (b) * 2 + (h)) * HTB)
#define PG8_STAGE(bufoff, gbase, voff) do { _Pragma("unroll") for (int _i = 0; _i < 2; ++_i) \
        __builtin_amdgcn_global_load_lds((const unsigned*)((const char*)(gbase) + (voff)[_i]), (PG8_LAS unsigned*)(lds + (bufoff) + ldsw + _i * 8192), 16, 0, 0); } while (0)
#define PG8_LDA(dst, b, h) do { _Pragma("unroll") for (int m = 0; m < 4; ++m) _Pragma("unroll") for (int k = 0; k < 2; ++k) dst[m][k] = *(const PG8_LAS bf16x8*)(lds + PG8_SA(b, h) + aoff + m * 2048 + k * 1024); } while (0)
#define PG8_LDB(dst, b, h) do { _Pragma("unroll") for (int n = 0; n < 2; ++n) _Pragma("unroll") for (int k = 0; k < 2; ++k) dst[n][k] = *(const PG8_LAS bf16x8*)(lds + PG8_SB(b, h) + boff + n * 2048 + k * 1024); } while (0)
#define PG8_MMA(ai, bj, At, Bt) do { __builtin_amdgcn_s_setprio(1); _Pragma("unroll") for (int m = 0; m < 4; ++m) _Pragma("unroll") for (int n = 0; n < 2; ++n) _Pragma("unroll") for (int k = 0; k < 2; ++k) \
        acc[ai][bj][m][n] = __builtin_amdgcn_mfma_f32_16x16x32_bf16(Bt[n][k], At[m][k], acc[ai][bj][m][n], 0, 0, 0); __builtin_amdgcn_s_setprio(0); } while (0)
#define PG8_WAIT_V(n) asm volatile("s_waitcnt vmcnt(" #n ")" ::: "memory")
#define PG8_WAIT_L(n) asm volatile("s_waitcnt lgkmcnt(" #n ")" ::: "memory")
#define PG8_BAR __builtin_amdgcn_s_barrier()
#define PG8_SCHED __builtin_amdgcn_sched_barrier(0)
    Unit cur, nxt; int ui = 0;
    if (!S.next(0, cur)) return;
    f32x4 acc[2][2][4][2];
#pragma unroll
    for (int a = 0; a < 2; ++a)
#pragma unroll
        for (int b = 0; b < 2; ++b)
#pragma unroll
            for (int m = 0; m < 4; ++m)
#pragma unroll
                for (int n = 0; n < 2; ++n) acc[a][b][m][n] = (f32x4){0.f, 0.f, 0.f, 0.f};
    bf16x8 At[4][2], B0[2][2], B1[2][2];
    const char* cA = (const char*)g.A + (size_t)cur.pm * tstepA; const char* cB = (const char*)g.Bt + (size_t)cur.pn * tstepB;
    S.a_ready(cur);
    if constexpr (SP2) {
        PG8_STAGE(PG8_SB(0, 0), cB, voffB); PG8_STAGE(PG8_SB(0, 1), cB + hstepB, voffB); PG8_STAGE(PG8_SA(0, 0), cA, voffA); PG8_STAGE(PG8_SA(0, 1), cA + hstepA, voffA);
        if (wr == 1) PG8_BAR;
        PG8_WAIT_V(2); PG8_BAR;
        PG8_STAGE(PG8_SB(1, 0), cB + kstep, voffB); PG8_STAGE(PG8_SA(1, 0), cA + kstep, voffA); PG8_STAGE(PG8_SB(1, 1), cB + hstepB + kstep, voffB);
        PG8_WAIT_V(6); PG8_BAR;
    } else {
        PG8_STAGE(PG8_SB(0, 0), cB, voffB); PG8_STAGE(PG8_SA(0, 0), cA, voffA); PG8_STAGE(PG8_SB(0, 1), cB + hstepB, voffB); PG8_STAGE(PG8_SA(0, 1), cA + hstepA, voffA);
        if (wr == 1) PG8_BAR;
        PG8_WAIT_V(4); PG8_BAR;
        PG8_STAGE(PG8_SB(1, 0), cB + kstep, voffB); PG8_STAGE(PG8_SA(1, 0), cA + kstep, voffA); PG8_STAGE(PG8_SB(1, 1), cB + hstepB + kstep, voffB);
        PG8_WAIT_V(6); PG8_BAR;
    }
    for (;;) {
        const bool has_next = S.next(ui + 1, nxt);
        const char* nA = has_next ? (const char*)g.A + (size_t)nxt.pm * tstepA : cA; const char* nB = has_next ? (const char*)g.Bt + (size_t)nxt.pn * tstepB : cB;
        for (int t = 0; t < nt; t += 2) {
            const bool last = (t == nt - 2);
            const char* a1 = cA + (size_t)(t + 1) * kstep;
            const char* a2 = last ? nA : cA + (size_t)(t + 2) * kstep; const char* b2 = last ? nB : cB + (size_t)(t + 2) * kstep;
            const char* a3 = a2 + kstep; const char* b3 = b2 + kstep;
            if (last && has_next) S.a_ready(nxt);
            if constexpr (SP2) {
            PG8_LDB(B0, 0, 0); PG8_LDB(B1, 0, 1); PG8_SCHED; PG8_LDA(At, 0, 0); PG8_STAGE(PG8_SA(1, 1), a1 + hstepA, voffA);
            PG8_WAIT_V(8); PG8_WAIT_L(0); PG8_BAR; PG8_MMA(0, 0, At, B0); PG8_MMA(0, 1, At, B1); PG8_BAR; PG8_SCHED;
            PG8_LDA(At, 0, 1); PG8_STAGE(PG8_SB(0, 0), b2, voffB); PG8_STAGE(PG8_SB(0, 1), b2 + hstepB, voffB); PG8_STAGE(PG8_SA(0, 0), a2, voffA);
            PG8_WAIT_V(8); PG8_WAIT_L(0); PG8_BAR; PG8_MMA(1, 0, At, B0); PG8_MMA(1, 1, At, B1); PG8_BAR; PG8_SCHED;
            PG8_LDB(B0, 1, 0); PG8_LDB(B1, 1, 1); PG8_SCHED; PG8_LDA(At, 1, 0); PG8_STAGE(PG8_SA(0, 1), a2 + hstepA, voffA);
            PG8_WAIT_V(8); PG8_WAIT_L(0); PG8_BAR; PG8_MMA(0, 0, At, B0); PG8_MMA(0, 1, At, B1); PG8_BAR; PG8_SCHED;
            PG8_LDA(At, 1, 1); PG8_STAGE(PG8_SB(1, 0), b3, voffB); PG8_STAGE(PG8_SB(1, 1), b3 + hstepB, voffB); PG8_STAGE(PG8_SA(1, 0), a3, voffA);
            PG8_WAIT_V(8); PG8_WAIT_L(0); PG8_BAR; PG8_MMA(1, 0, At, B0); PG8_MMA(1, 1, At, B1); PG8_BAR; PG8_SCHED;
            } else {
            PG8_LDB(B0, 0, 0); PG8_SCHED; PG8_LDA(At, 0, 0); PG8_STAGE(PG8_SA(1, 1), a1 + hstepA, voffA);
            PG8_WAIT_L(8); PG8_BAR; PG8_WAIT_L(0); PG8_MMA(0, 0, At, B0); PG8_BAR; PG8_SCHED;
            PG8_LDB(B1, 0, 1); PG8_STAGE(PG8_SB(0, 0), b2, voffB);
            PG8_BAR; PG8_WAIT_L(0); PG8_MMA(0, 1, At, B1); PG8_BAR;
            PG8_LDA(At, 0, 1); PG8_STAGE(PG8_SA(0, 0), a2, voffA);
            PG8_BAR; PG8_WAIT_L(0); PG8_MMA(1, 0, At, B0); PG8_BAR; PG8_SCHED;
            PG8_STAGE(PG8_SB(0, 1), b2 + hstepB, voffB);
            PG8_WAIT_V(6); PG8_BAR; PG8_MMA(1, 1, At, B1); PG8_BAR;
            PG8_LDB(B0, 1, 0); PG8_SCHED; PG8_LDA(At, 1, 0); PG8_STAGE(PG8_SA(0, 1), a2 + hstepA, voffA);
            PG8_WAIT_L(8); PG8_BAR; PG8_WAIT_L(0); PG8_MMA(0, 0, At, B0); PG8_BAR; PG8_SCHED;
            PG8_LDB(B1, 1, 1); PG8_STAGE(PG8_SB(1, 0), b3, voffB);
            PG8_BAR; PG8_WAIT_L(0); PG8_MMA(0, 1, At, B1); PG8_BAR;
            PG8_LDA(At, 1, 1); PG8_STAGE(PG8_SA(1, 0), a3, voffA);
            PG8_BAR; PG8_WAIT_L(0); PG8_MMA(1, 0, At, B0); PG8_BAR; PG8_SCHED;
            PG8_STAGE(PG8_SB(1, 1), b3 + hstepB, voffB);
            PG8_WAIT_V(6); PG8_BAR; PG8_MMA(1, 1, At, B1); PG8_BAR;
            }
        }
        if constexpr (ALIGN_EPI) { if (wr == 0) PG8_BAR; }
        if constexpr (!Epi::AFTER_DRAIN) { E(acc, cur, wr, wc, fr, fq); S.done(cur); }
        if (!has_next) break;
#pragma unroll
        for (int a = 0; a < 2; ++a)
#pragma unroll
            for (int b = 0; b < 2; ++b)
#pragma unroll
                for (int m = 0; m < 4; ++m)
#pragma unroll
                    for (int n = 0; n < 2; ++n) acc[a][b][m][n] = (f32x4){0.f, 0.f, 0.f, 0.f};
        cur = nxt; cA = nA; cB = nB; ++ui;
        if constexpr (ALIGN_EPI) { if (wr == 1) PG8_BAR; }
    }
    PG8_WAIT_V(0);
    if constexpr (!ALIGN_EPI) { if (wr == 0) PG8_BAR; }
    PG8_BAR;
    if constexpr (Epi::AFTER_DRAIN) { E.fused(acc, cur, wr, wc, fr, fq, lds, wid, lane); S.done(cur); }
#undef PG8_SA
#undef PG8_SB
#undef PG8_STAGE
#undef PG8_LDA
#undef PG8_LDB
#undef PG8_MMA
#undef PG8_WAIT_V
#undef PG8_WAIT_L
#undef PG8_BAR
#undef PG8_SCHED
}
}
namespace attn_body {
using bf16=__hip_bfloat16;
using bf16x8=__attribute__((ext_vector_type(8)))short;
using s16x4=__attribute__((ext_vector_type(4)))short;
using f32x16=__attribute__((ext_vector_type(16)))float;
using u32x4=__attribute__((ext_vector_type(4)))unsigned;
constexpr int BATCH=8,NHEAD=16,SEQ=8192,D=64,DM=NHEAD*D;
constexpr int NW=8,QBLK=32,QB=QBLK*NW,KVBLK=64,NQB=SEQ/QB;
constexpr int ATTN_PITCH=DM, ATTN_UNIT_ROWS=QB;
__device__ __forceinline__ int crow(int r,int hi){return (r&3)+8*(r>>2)+4*hi;}
#define SBAR() __builtin_amdgcn_sched_barrier(0)
__device__ __forceinline__ void cmask(f32x16&p0,f32x16&p1,int jb,int qrel,int hi){
  const float NEG=-INFINITY; int kb=64*jb+4*hi;
  #pragma unroll
  for(int r=0;r<16;++r){int kv=kb+(r&3)+8*(r>>2); if(kv>qrel)p0[r]=NEG; if(kv+32>qrel)p1[r]=NEG;}
}

constexpr int NSLOT=3, SLOTB=8192;
constexpr int LDS_K=0, LDS_V=NSLOT*SLOTB, LDS_WS=2*NSLOT*SLOTB, LDS_OST=LDS_WS+NW*64*4, LDS_BYTES=LDS_OST+NW*4096;
constexpr int LDS_C2=LDS_BYTES, LDS_REL=LDS_C2+SEQ*4;
constexpr float C2=0.125f*1.4426950408889634f;
__device__ __forceinline__ void glds16(const void*gsrc,unsigned lds_dst){unsigned keep;
  asm volatile("s_mov_b32 %0, m0\n\ts_mov_b32 m0, %2\n\ts_nop 0\n\tglobal_load_lds_dwordx4 %1, off\n\ts_mov_b32 m0, %0":"=&s"(keep):"v"(gsrc),"s"(lds_dst):"memory");}
__device__ __forceinline__ void glds16s(const void*sbase,unsigned voff,unsigned lds_dst){unsigned keep;
  asm volatile("s_mov_b32 %0, m0\n\ts_mov_b32 m0, %3\n\ts_nop 0\n\tglobal_load_lds_dwordx4 %1, %2\n\ts_mov_b32 m0, %0":"=&s"(keep):"v"(voff),"s"(sbase),"s"(lds_dst):"memory");}
__device__ __forceinline__ float max3f(float a,float b,float c){float r;asm("v_max3_f32 %0, %1, %2, %3":"=v"(r):"v"(a),"v"(b),"v"(c));return r;}
__device__ __forceinline__ float max2f(float a,float b){float r;asm("v_max_f32_e32 %0, %1, %2":"=v"(r):"v"(a),"v"(b));return r;}
__device__ __forceinline__ float fadd_s(float a,float b){float r;asm("v_add_f32_e32 %0, %1, %2":"=v"(r):"v"(a),"v"(b));return r;}
__device__ __forceinline__ float fsub_s(float a,float b){float r;asm("v_sub_f32_e32 %0, %1, %2":"=v"(r):"v"(a),"v"(b));return r;}
typedef float f32x2_t __attribute__((ext_vector_type(2))); typedef __bf16 bf16x2_t __attribute__((ext_vector_type(2)));
__device__ __forceinline__ unsigned cvtpk_s(float lo,float hi){f32x2_t v={lo,hi};bf16x2_t b=__builtin_convertvector(v,bf16x2_t);return __builtin_bit_cast(unsigned,b);}
#define WAIT_BAR(N) asm volatile("s_waitcnt vmcnt(" #N ") lgkmcnt(0)\n\ts_barrier":::"memory")

__device__ __forceinline__ void qkt(f32x16&p0,f32x16&p1,const char*Kslot,const bf16x8*qr,int r32,int hi){
  const char*kb=Kslot+hi*1024+r32*16;
  #pragma unroll
  for(int d0=0;d0<4;++d0){
    const bf16x8 b0=*reinterpret_cast<const bf16x8*>(kb+d0*2048);
    const bf16x8 b1=*reinterpret_cast<const bf16x8*>(kb+d0*2048+512);
    {p0=__builtin_amdgcn_mfma_f32_32x32x16_bf16(b0,qr[d0],p0,0,0,0);p1=__builtin_amdgcn_mfma_f32_32x32x16_bf16(b1,qr[d0],p1,0,0,0);}}
}
typedef __attribute__((address_space(3))) const char* lds_cptr;
typedef short v4i16_t __attribute__((ext_vector_type(4)));
__device__ __forceinline__ void kload8(bf16x8*kf,lds_cptr kp){
  kf[0]=*(const __attribute__((address_space(3))) bf16x8*)(kp);      kf[1]=*(const __attribute__((address_space(3))) bf16x8*)(kp+512);
  kf[2]=*(const __attribute__((address_space(3))) bf16x8*)(kp+2048); kf[3]=*(const __attribute__((address_space(3))) bf16x8*)(kp+2560);
  kf[4]=*(const __attribute__((address_space(3))) bf16x8*)(kp+4096); kf[5]=*(const __attribute__((address_space(3))) bf16x8*)(kp+4608);
  kf[6]=*(const __attribute__((address_space(3))) bf16x8*)(kp+6144); kf[7]=*(const __attribute__((address_space(3))) bf16x8*)(kp+6656);
}
__device__ __forceinline__ void kload2(bf16x8*kf,lds_cptr kp,int j){ kf[2*j]=*(const __attribute__((address_space(3))) bf16x8*)(kp+j*2048); kf[2*j+1]=*(const __attribute__((address_space(3))) bf16x8*)(kp+j*2048+512); }
__device__ __forceinline__ s16x4 vtr(lds_cptr p){ return __builtin_bit_cast(s16x4,__builtin_amdgcn_ds_read_tr16_b64_v4i16((__attribute__((address_space(3))) v4i16_t*)p)); }
__device__ __forceinline__ float rowmax(const f32x16&p0,const f32x16&p1){
  float a=max3f(p0[0],p0[1],p1[0]),b=max3f(p0[2],p0[3],p1[1]);a=max3f(a,p1[2],p1[3]);
  #pragma unroll
  for(int r=4;r<16;r+=4){a=max3f(a,p0[r],p0[r+1]);b=max3f(b,p0[r+2],p0[r+3]);a=max3f(a,p1[r],p1[r+1]);b=max3f(b,p1[r+2],p1[r+3]);}
  const float m=max2f(a,b);
  auto rr=__builtin_amdgcn_permlane32_swap(__float_as_uint(m),__float_as_uint(m),false,false);
  return max2f(__uint_as_float(rr[0]),__uint_as_float(rr[1]));
}
__device__ __forceinline__ void pv(f32x16*o,int vb,bf16x8 pa0,bf16x8 pa1,bf16x8 pa2,bf16x8 pa3){
  #pragma unroll
  for(int d0=0;d0<2;++d0){s16x4 lo[4],hi[4];
    #pragma unroll
    for(int ks=0;ks<4;++ks){
      asm volatile("ds_read_b64_tr_b16 %0,%1 offset:%c2":"=&v"(lo[ks]):"v"(vb),"i"(d0*4096+ks*1024):"memory");
      asm volatile("ds_read_b64_tr_b16 %0,%1 offset:%c2":"=&v"(hi[ks]):"v"(vb),"i"(d0*4096+ks*1024+512):"memory");}
    asm volatile("s_waitcnt lgkmcnt(0)":::"memory");SBAR();
    #define PK(k) (bf16x8){lo[k][0],lo[k][1],lo[k][2],lo[k][3],hi[k][0],hi[k][1],hi[k][2],hi[k][3]}
    o[d0]=__builtin_amdgcn_mfma_f32_32x32x16_bf16(pa0,PK(0),o[d0],0,0,0);
    o[d0]=__builtin_amdgcn_mfma_f32_32x32x16_bf16(pa1,PK(1),o[d0],0,0,0);
    o[d0]=__builtin_amdgcn_mfma_f32_32x32x16_bf16(pa2,PK(2),o[d0],0,0,0);
    o[d0]=__builtin_amdgcn_mfma_f32_32x32x16_bf16(pa3,PK(3),o[d0],0,0,0);
    #undef PK
  }
}

#ifndef ATTN_STORE16
#define ATTN_STORE16(p,v) (*(u32x4*)(p)=(v))
#endif
typedef float f32x4_t __attribute__((ext_vector_type(4)));
__device__ __forceinline__ unsigned split2(float v,float&eff){ unsigned w=cvtpk_s(v,0.f); const float h=__uint_as_float(w<<16); w=cvtpk_s(v,fsub_s(v,h)); eff=fadd_s(h,__uint_as_float(w&0xffff0000u)); return w; }
template<int THRL> __device__ __forceinline__ void attn_unit(int b,int h,int qb,const bf16*Q,const bf16*__restrict__ K,const bf16*__restrict__ V,bf16*O,const bf16*__restrict__ Gt,const float*__restrict__ CL,const float*__restrict__ TOT,const float*__restrict__ NRM,char*shm,const int tid_in,unsigned*qown,const unsigned qbase){
  const int tid=tid_in,lane=tid&63,r32=lane&31,hi=lane>>5; const int wid=__builtin_amdgcn_readfirstlane(tid>>6);
  const long rowbase=(long)b*SEQ; const int q0=qb*QB;
  const bf16*Qw=Q+(rowbase+q0+wid*QBLK)*DM+h*D;
  const bf16*Kh=K+rowbase*DM+h*D,*Vh=V+rowbase*DM+h*D;
  const lds_cptr shm3=(lds_cptr)shm;
  const unsigned lds0=(unsigned)(uintptr_t)shm;
  float*wsf=(float*)(shm+LDS_WS)+wid*64;
  const unsigned koff=(unsigned)((lane*DM+wid*8)*2);
  const unsigned voff=(unsigned)(((16*(wid&3)+(lane>>2))*DM+(wid>>2)*32+(lane&3)*8)*2);
  const unsigned kdst=lds0+LDS_K+wid*1024, vdst=lds0+LDS_V+wid*1024;
  #define DMA_K(t,slot) glds16s(Kh+(long)(t)*KVBLK*DM,koff,(unsigned)__builtin_amdgcn_readfirstlane(kdst+(slot)))
  #define DMA_V(t,slot) glds16s(Vh+(long)(t)*KVBLK*DM,voff,(unsigned)__builtin_amdgcn_readfirstlane(vdst+(slot)))
  const char*Kbase=shm+LDS_K; bf16x8 kf[8];
  const lds_cptr kp0=shm3+LDS_K+hi*1024+r32*16; const lds_cptr vp0=shm3+LDS_V+((lane>>4)&1)*32+(lane&3)*8+(4*hi+((lane&15)>>2))*64;
  bf16x8 qr[4];
  #pragma unroll
  for(int d0=0;d0<4;++d0)qr[d0]=*reinterpret_cast<const bf16x8*>(&Qw[(long)r32*DM+d0*16+hi*8]);
  float cq2; int t_start;
  { typedef __attribute__((address_space(3))) float lf32; lf32*relL=(lf32*)(shm3+LDS_REL); __attribute__((address_space(3))) unsigned*c2P=(__attribute__((address_space(3))) unsigned*)(shm3+LDS_C2);
    float tv=0.f,nk0=0.f,nk1=0.f,nq0=0.f,nq1=0.f,nq2=0.f,nq3=0.f;
    const float cqraw=CL[(long)(b*NHEAD+h)*SEQ+q0+wid*QBLK+r32];
    if(wid==0){ tv=TOT[(b*NHEAD+h)*64+lane]; const float*nq=NRM+(long)((0*BATCH+b)*NHEAD+h)*128,*nk=NRM+(long)((1*BATCH+b)*NHEAD+h)*128; nk0=nk[2*lane]; nk1=nk[2*lane+1]; nq0=nq[4*qb]; nq1=nq[4*qb+1]; nq2=nq[4*qb+2]; nq3=nq[4*qb+3]; }
    { const bf16*Kd=K+(rowbase+q0+wid*QBLK+r32)*DM+h*D+hi*8; float dot=0.f; bf16x8 kd[4];
      #pragma unroll
      for(int d0=0;d0<4;++d0)kd[d0]=*reinterpret_cast<const bf16x8*>(Kd+d0*16);
      asm volatile("":"+v"(kd[0]),"+v"(kd[1]),"+v"(kd[2]),"+v"(kd[3]));
      #pragma unroll
      for(int d0=0;d0<4;++d0){
        #pragma unroll
        for(int e=0;e<8;++e)dot+=__uint_as_float((unsigned)(unsigned short)qr[d0][e]<<16)*__uint_as_float((unsigned)(unsigned short)kd[d0][e]<<16); }
      dot=xr_sum<32>(dot);
      dot=xr_min<16>(dot); dot=xr_min<8>(dot); dot=xr_min<4>(dot); dot=xr_min<2>(dot); dot=xr_min<1>(dot);
      if(lane==0)relL[66+wid]=dot; }
    __syncthreads();
    if(wid==0){ float inc=tv;
      _Pragma("unroll") for(int o_=1;o_<64;o_<<=1){ const float y_=xl_from_lane(inc,lane-o_); if(lane>=o_)inc+=y_; }
      const float exc=inc-tv; const float eref=__builtin_bit_cast(float,__builtin_amdgcn_readlane(__builtin_bit_cast(int,exc),2*qb)); relL[lane]=exc-eref;
      const float bk2=nk0+nk1; const float bq2=__builtin_fmaxf(nq0+nq1,nq2+nq3);
      float smin=relL[66]; _Pragma("unroll") for(int w_=1;w_<NW;++w_)smin=__builtin_fminf(smin,relL[66+w_]);
      const float Bj=sqrtf(bq2*bk2)*1.02f,Dj=(inc-eref)*1.4426950408889634f;
      const bool keep=(lane>=2*qb)||!(Dj>=Bj-smin+30.5f);
      const unsigned long long km=__ballot(keep); const int bs_=__ffsll((long long)km)-1; if(lane==0)((__attribute__((address_space(3))) int*)relL)[64]=bs_; }
    __syncthreads();
    const int bs=__builtin_amdgcn_readfirstlane(((__attribute__((address_space(3))) int*)relL)[64]); t_start=2*bs;
    const int NTl=(q0+QB)/KVBLK-t_start;
    const float*clp=CL+(long)(b*NHEAD+h)*SEQ;
    { f32x4_t cv_[4];
      #pragma unroll
      for(int k_=0;k_<4;++k_){ const int i_=tid+k_*NW*64; cv_[k_]=*(const f32x4_t*)(clp+128*bs+4*(i_<NTl*16?i_:tid)); }
      asm volatile("":"+v"(cv_[0]),"+v"(cv_[1]),"+v"(cv_[2]),"+v"(cv_[3]));
      #pragma unroll
      for(int k_=0;k_<4;++k_){ const int i_=tid+k_*NW*64; if(i_<NTl*16){ const f32x4_t v_=cv_[k_]; const float rl_=relL[bs+(i_>>5)]; float e_;
        u32x4 w_; w_.x=split2((v_.x+rl_)*-1.4426950408889634f,e_); w_.y=split2((v_.y+rl_)*-1.4426950408889634f,e_); w_.z=split2((v_.z+rl_)*-1.4426950408889634f,e_); w_.w=split2((v_.w+rl_)*-1.4426950408889634f,e_);
        *(__attribute__((address_space(3))) u32x4*)(c2P+4*i_)=w_; } } }
    cq2=(cqraw+relL[2*qb+(wid>>2)])*1.4426950408889634f;
    __syncthreads(); }
  Kh+=(long)t_start*KVBLK*DM; Vh+=(long)t_start*KVBLK*DM;
  const int NT=(q0+QB)/KVBLK-t_start;
  const __attribute__((address_space(3))) unsigned* c2f=(const __attribute__((address_space(3))) unsigned*)(shm3+LDS_C2)+r32;
  unsigned qxw;
  #define QX() __builtin_bit_cast(bf16x8,(u32x4){hi?0u:0x3f803f80u,hi?0u:qxw,0u,0u})
  #define KEXT(KX0,KX1,t) do{ const unsigned wa_=c2f[(t)*64], wb_=c2f[(t)*64+32]; KX0=__builtin_bit_cast(bf16x8,(u32x4){wa_,0x3f803f80u,0u,0u}); KX1=__builtin_bit_cast(bf16x8,(u32x4){wb_,0x3f803f80u,0u,0u}); }while(0)
  DMA_K(0,0);DMA_V(0,0);DMA_K(1,SLOTB);
  float mhat,l_reg=0.f;f32x16 o[2];o[0]=f32x16{};o[1]=f32x16{}; { float e_; qxw=split2(cq2,e_); mhat=-e_; } const f32x16 zero16=f32x16{};
  const int qrel=wid*QBLK+r32;
  #define CMASK(P0,P1,t) do{int jb_=(t)-(NT-4); if(jb_>=0)cmask(P0,P1,jb_,qrel,hi);}while(0)
  bool resc=false;
  #define START(P0,P1) do{ const float rm=rowmax(P0,P1); resc=false; \
    { float e_; qxw=split2(-fadd_s(mhat,rm),e_); const float dl=fsub_s(-e_,mhat); mhat=-e_; \
      _Pragma("unroll") for(int r=0;r<16;++r){P0[r]=fsub_s(P0[r],dl);P1[r]=fsub_s(P1[r],dl);} } \
    _Pragma("unroll") for(int r=0;r<16;++r)P0[r]=__builtin_amdgcn_exp2f(P0[r]); }while(0)
  #define RESC() do{ if(resc){ asm volatile("s_waitcnt lgkmcnt(0)":::"memory"); \
      _Pragma("unroll") for(int d_=0;d_<2;++d_) _Pragma("unroll") for(int r=0;r<16;++r)o[d_][r]*=wsf[crow(r,hi)]; } }while(0)
  f32x16 pA0,pA1,pB0,pB1;
  int sl_prev=0,sl_cur=0,sl_next=SLOTB;
  #define ROT() do{sl_prev=sl_cur;sl_cur=sl_next;sl_next=(sl_next==(NSLOT-1)*SLOTB)?0:sl_next+SLOTB;}while(0)
  DMA_K(2,2*SLOTB);
  WAIT_BAR(3);
  { bf16x8 kx0_,kx1_; KEXT(kx0_,kx1_,0); const bf16x8 qx_=QX(); pA0=__builtin_amdgcn_mfma_f32_32x32x16_bf16(kx0_,qx_,zero16,0,0,0); pA1=__builtin_amdgcn_mfma_f32_32x32x16_bf16(kx1_,qx_,zero16,0,0,0); }
  qkt(pA0,pA1,Kbase,qr,r32,hi);asm volatile("s_nop 15\n\ts_nop 7":"+v"(pA0),"+v"(pA1));CMASK(pA0,pA1,0);
  START(pA0,pA1);
  _Pragma("unroll") for(int r=0;r<16;++r)pA1[r]=__builtin_amdgcn_exp2f(pA1[r]);
  WAIT_BAR(0);
  DMA_K(3,0);DMA_V(1,SLOTB);
  ROT();
  kload8(kf,kp0+sl_cur);
  WAIT_BAR(2);
  s16x4 vlo[8],vhi[8]; u32x4 pw0,pw1,pw2,pw3;
  #define PKW(P,B) cvtpk_s(P[B],P[B+1])
  #define PAF(k) __builtin_bit_cast(bf16x8,pw##k)
  #define VFR(i) (bf16x8){vlo[i][0],vlo[i][1],vlo[i][2],vlo[i][3],vhi[i][0],vhi[i][1],vhi[i][2],vhi[i][3]}
  #define PIN(x) asm volatile("":"+v"(x))
  #define MX3(a,b,c) __builtin_fmaxf(__builtin_fmaxf((a),(b)),(c))
  #define GAPA(MF,A0,A1,A2,A3,W0,W1,PW) do{ MF; sacc+=A0; sacc+=A1; sacc+=A2; sacc+=A3; PIN(sacc); W0; W1; PIN(PW); SBAR(); }while(0)
  #define EX(v) __builtin_amdgcn_exp2f(v)
  #define GAPB(MF,X,B) do{ MF; X[B]=EX(X[B]); X[B+1]=EX(X[B+1]); X[B+2]=EX(X[B+2]); X[B+3]=EX(X[B+3]); PIN(X); SBAR(); }while(0)
  #define VRD(i) do{ vlo[i]=vtr(vp_+(((i)>>2)*4096+((i)&3)*1024)); vhi[i]=vtr(vp_+(((i)>>2)*4096+((i)&3)*1024+512)); }while(0)
  #define KRD(G,j) do{ if(G){ kload2(kf,kp0+sl_next,j); SBAR(); } }while(0)
  #define STEP(C0,C1,P0,P1,t,GK,GV,GL) do{ SBAR(); \
    { bf16x8 kx0_,kx1_; KEXT(kx0_,kx1_,t); const bf16x8 qx_=QX(); C0=__builtin_amdgcn_mfma_f32_32x32x16_bf16(kx0_,qx_,zero16,0,0,0); C1=__builtin_amdgcn_mfma_f32_32x32x16_bf16(kx1_,qx_,zero16,0,0,0); } SBAR(); \
    const lds_cptr vp_=vp0+sl_prev; \
    VRD(0); SBAR(); float sacc=(P0[0]+P0[1]); \
    GAPA(C0=__builtin_amdgcn_mfma_f32_32x32x16_bf16(kf[0],qr[0],C0,0,0,0), P0[2],P0[3],P0[4],P0[5],     pw0[0]=PKW(P0,0), pw0[1]=PKW(P0,2), pw0); \
    VRD(4); SBAR(); GAPA(C1=__builtin_amdgcn_mfma_f32_32x32x16_bf16(kf[1],qr[0],C1,0,0,0), P0[6],P0[7],P0[8],P0[9],     pw0[2]=PKW(P0,4), pw0[3]=PKW(P0,6), pw0); \
    VRD(1); SBAR(); GAPA(C0=__builtin_amdgcn_mfma_f32_32x32x16_bf16(kf[2],qr[1],C0,0,0,0),   P0[10],P0[11],P0[12],P0[13], pw1[0]=PKW(P0,8), pw1[1]=PKW(P0,10), pw1); \
    VRD(5); SBAR(); GAPA(C1=__builtin_amdgcn_mfma_f32_32x32x16_bf16(kf[3],qr[1],C1,0,0,0),   P0[14],P0[15],P1[0],P1[1],   pw1[2]=PKW(P0,12),pw1[3]=PKW(P0,14), pw1); \
    VRD(2); SBAR(); GAPA(C0=__builtin_amdgcn_mfma_f32_32x32x16_bf16(kf[4],qr[2],C0,0,0,0),   P1[2],P1[3],P1[4],P1[5],     pw2[0]=PKW(P1,0), pw2[1]=PKW(P1,2), pw2); \
    VRD(6); SBAR(); GAPA(C1=__builtin_amdgcn_mfma_f32_32x32x16_bf16(kf[5],qr[2],C1,0,0,0),   P1[6],P1[7],P1[8],P1[9],     pw2[2]=PKW(P1,4), pw2[3]=PKW(P1,6), pw2); \
    VRD(3); SBAR(); GAPA(C0=__builtin_amdgcn_mfma_f32_32x32x16_bf16(kf[6],qr[3],C0,0,0,0),   P1[10],P1[11],P1[12],P1[13], pw3[0]=PKW(P1,8), pw3[1]=PKW(P1,10), pw3); \
    VRD(7); SBAR(); GAPA(C1=__builtin_amdgcn_mfma_f32_32x32x16_bf16(kf[7],qr[3],C1,0,0,0),   P1[14],P1[15],0.f,0.f,       pw3[2]=PKW(P1,12),pw3[3]=PKW(P1,14), pw3); \
    l_reg+=sacc; \
    if(GK){DMA_K((t)+3,sl_cur);} if(GV){DMA_V((t)+1,sl_next);} \
    CMASK(C0,C1,t); \
    { float a=MX3(C0[0],C0[1],C1[0]),b=MX3(C0[2],C0[3],C1[1]); a=MX3(a,C1[2],C1[3]); \
      _Pragma("unroll") for(int r=4;r<16;r+=4){a=MX3(a,C0[r],C0[r+1]);b=MX3(b,C0[r+2],C0[r+3]);a=MX3(a,C1[r],C1[r+1]);b=MX3(b,C1[r+2],C1[r+3]);} \
      float rm=__builtin_fmaxf(a,b); { auto rr=__builtin_amdgcn_permlane32_swap(__float_as_uint(rm),__float_as_uint(rm),false,false); rm=__builtin_fmaxf(__uint_as_float(rr[0]),__uint_as_float(rr[1])); } \
      resc=false; \
      if(__builtin_expect(__any(rm>(float)THRL),0)){ float e_; qxw=split2(-(mhat+__builtin_fmaxf(rm,0.f)),e_); const float dl=-e_-mhat; mhat=-e_; \
        _Pragma("unroll") for(int r=0;r<16;++r){C0[r]-=dl;C1[r]-=dl;} \
        const float f=__builtin_amdgcn_exp2f(-dl); l_reg*=f; if(hi==0)wsf[r32]=f; resc=true; } } \
    SBAR(); \
    GAPB(o[0]=__builtin_amdgcn_mfma_f32_32x32x16_bf16(PAF(0),VFR(0),o[0],0,0,0), C0,0); \
    GAPB(o[1]=__builtin_amdgcn_mfma_f32_32x32x16_bf16(PAF(0),VFR(4),o[1],0,0,0), C0,4); \
    KRD(GL,0); GAPB(o[0]=__builtin_amdgcn_mfma_f32_32x32x16_bf16(PAF(1),VFR(1),o[0],0,0,0), C0,8); \
    KRD(GL,1); GAPB(o[1]=__builtin_amdgcn_mfma_f32_32x32x16_bf16(PAF(1),VFR(5),o[1],0,0,0), C0,12); \
    KRD(GL,2); GAPB(o[0]=__builtin_amdgcn_mfma_f32_32x32x16_bf16(PAF(2),VFR(2),o[0],0,0,0), C1,0); \
    KRD(GL,3); GAPB(o[1]=__builtin_amdgcn_mfma_f32_32x32x16_bf16(PAF(2),VFR(6),o[1],0,0,0), C1,4); \
    GAPB(o[0]=__builtin_amdgcn_mfma_f32_32x32x16_bf16(PAF(3),VFR(3),o[0],0,0,0), C1,8); \
    GAPB(o[1]=__builtin_amdgcn_mfma_f32_32x32x16_bf16(PAF(3),VFR(7),o[1],0,0,0), C1,12); \
    }while(0)
  int t=1;
  #undef CMASK
  #define CMASK(P0,P1,t) do{}while(0)
  for(;t+5<NT;t+=2){
    STEP(pB0,pB1,pA0,pA1,t,true,true,true);     WAIT_BAR(2); RESC(); ROT();
    STEP(pA0,pA1,pB0,pB1,t+1,true,true,true);   WAIT_BAR(2); RESC(); ROT();
  }
  #undef CMASK
  #define CMASK(P0,P1,t) do{int jb_=(t)-(NT-4); if(jb_>=0)cmask(P0,P1,jb_,qrel,hi);}while(0)
  #define ENDW(tt) do{ if((tt)+3<NT){WAIT_BAR(2);} else if((tt)+2<NT){WAIT_BAR(1);} else {WAIT_BAR(0);} }while(0)
  for(;t+1<NT;t+=2){
    STEP(pB0,pB1,pA0,pA1,t,(t+3<NT),(t+1<NT),(t+1<NT));       ENDW(t);   RESC(); ROT();
    STEP(pA0,pA1,pB0,pB1,t+1,(t+4<NT),(t+2<NT),(t+2<NT));     ENDW(t+1); RESC(); ROT();
  }
  STEP(pB0,pB1,pA0,pA1,NT-1,false,false,false); RESC();
  { float sacc=pB0[0]+pB0[1]; _Pragma("unroll") for(int r=2;r<16;++r)sacc+=pB0[r]; _Pragma("unroll") for(int r=0;r<16;++r)sacc+=pB1[r]; l_reg+=sacc;
    pw0=(u32x4){PKW(pB0,0),PKW(pB0,2),PKW(pB0,4),PKW(pB0,6)};pw1=(u32x4){PKW(pB0,8),PKW(pB0,10),PKW(pB0,12),PKW(pB0,14)};pw2=(u32x4){PKW(pB1,0),PKW(pB1,2),PKW(pB1,4),PKW(pB1,6)};pw3=(u32x4){PKW(pB1,8),PKW(pB1,10),PKW(pB1,12),PKW(pB1,14)};
    const int vb0=(int)(lds0+LDS_V)+((lane>>4)&1)*32+(lane&3)*8+(4*hi+((lane&15)>>2))*64;
    SBAR(); pv(o,vb0+sl_cur,PAF(0),PAF(1),PAF(2),PAF(3)); }
  #undef PKW
  #undef PAF
  #undef VFR
  #undef PIN
  #undef MX3
  #undef GAPA
  #undef GAPB
  #undef EX
  #undef VRD
  #undef KRD
  #undef STEP
  #undef ENDW
  unsigned nxt_=0u; if(tid==0)nxt_=__hip_atomic_fetch_add(qown,1u,__ATOMIC_RELAXED,__HIP_MEMORY_SCOPE_AGENT);
  {auto rr=__builtin_amdgcn_permlane32_swap(__float_as_uint(l_reg),__float_as_uint(l_reg),false,false);l_reg=__uint_as_float(rr[0])+__uint_as_float(rr[1]);}
  if(hi==0)wsf[32+r32]=l_reg;asm volatile("s_waitcnt lgkmcnt(0)":::"memory");
  float rli[16];
  #pragma unroll
  for(int r=0;r<16;++r)rli[r]=__builtin_amdgcn_rcpf(wsf[32+crow(r,hi)]);
  bf16*Ow=O+(rowbase+q0+wid*QBLK)*DM+h*D;
  { bf16*stg=(bf16*)(shm+LDS_OST)+wid*2048;
    #pragma unroll
    for(int r=0;r<16;++r){const int orow=crow(r,hi);
      #pragma unroll
      for(int d0=0;d0<2;++d0)stg[orow*64+d0*32+r32]=__float2bfloat16(o[d0][r]*rli[r]);}
    asm volatile("s_waitcnt lgkmcnt(0)":::"memory");
    int le_=lane; asm volatile("":"+v"(le_));
    #pragma unroll
    for(int i=0;i<4;++i){const int row=i*8+(le_>>3),ch=le_&7; const u32x4 v=*(const u32x4*)(stg+row*64+ch*8); const u32x4 gv=*(const u32x4*)(Gt+(rowbase+q0+wid*QBLK+row)*DM+h*D+ch*8); u32x4 w;
      #pragma unroll
      for(int e=0;e<4;++e){ const float o0=__uint_as_float(v[e]<<16),o1=__uint_as_float(v[e]&0xffff0000u),g0=__uint_as_float(gv[e]<<16),g1=__uint_as_float(gv[e]&0xffff0000u);
        const float s0=g0*__builtin_amdgcn_rcpf(1.f+__builtin_amdgcn_exp2f(-1.4426950408889634f*g0)),s1=g1*__builtin_amdgcn_rcpf(1.f+__builtin_amdgcn_exp2f(-1.4426950408889634f*g1)); w[e]=cvtpk_s(o0*s0,o1*s1); }
      ATTN_STORE16(Ow+(long)row*DM+ch*8,w);} }
  if(tid==0)((__attribute__((address_space(3))) unsigned*)(shm3+LDS_REL))[65]=(nxt_<512u)?(qbase+nxt_):0xfffffffeu;
  asm volatile("s_waitcnt lgkmcnt(0)\n\ts_barrier":::"memory");
  #undef KEXT
  #undef QX
  #undef DMA_K
  #undef DMA_V
  #undef CMASK
  #undef START
  #undef RESC
  #undef ROT
}
constexpr int ATTN_LDS_BYTES=LDS_REL+512;
struct AttnTensors { const bf16* Q; const bf16* K; const bf16* V; bf16* O; const bf16* G; const float* CL; const float* TOT; const float* NRM; };
struct AttnUnit { int bh; int qb; };
struct DynOrder {
  unsigned*qhead; int xcc,wid0; __attribute__((address_space(3))) unsigned*slot;
  __device__ __forceinline__ int fresh_tid()const{ int t; asm volatile("v_mbcnt_lo_u32_b32 %0, -1, 0\n\tv_mbcnt_hi_u32_b32 %0, -1, %0":"=v"(t)); return t+wid0*64; }
  __device__ __forceinline__ bool next(int,AttnUnit&u)const{
    unsigned v=*slot;
    if(v==0xfffffffeu){ __syncthreads();
      if(fresh_tid()==0){ unsigned w=0xffffffffu; for(int k=0;k<8;++k){ const int qx=(xcc+k)&7; const unsigned n=__hip_atomic_fetch_add(qhead+64*qx,1u,__ATOMIC_RELAXED,__HIP_MEMORY_SCOPE_AGENT); if(n<512u){w=(unsigned)qx*512u+n;break;} } *slot=w; }
      __syncthreads(); v=*slot; }
    if(v==0xffffffffu)return false;
    const int qx=(int)(v>>9),n=(int)(v&511u),g=3-(n>>7); u.bh=qx*NHEAD+((n>>3)&15); u.qb=8*g+7-(n&7); return true; }
  __device__ __forceinline__ void a_ready(const AttnUnit&)const{}
  __device__ __forceinline__ void done(const AttnUnit&)const{}
};
template<class Sched,int THRL=8> __device__ __forceinline__ void attn_phase(char*lds,const AttnTensors&T,const Sched&S){
  AttnUnit u;
  for(int i=0;S.next(i,u);++i){ S.a_ready(u); attn_unit<THRL>(u.bh/NHEAD,u.bh%NHEAD,u.qb,T.Q,T.K,T.V,T.O,T.G,T.CL,T.TOT,T.NRM,lds,S.fresh_tid(),S.qhead+64*S.xcc,(unsigned)S.xcc*512u); S.done(u); }
}
#undef SBAR
#undef WAIT_BAR
}
#define GAS __attribute__((address_space(1)))
#define LAS __attribute__((address_space(3)))
typedef unsigned short bf16;
typedef unsigned v4u __attribute__((ext_vector_type(4)));
typedef float f32x4 __attribute__((ext_vector_type(4)));
typedef float f32x16 __attribute__((ext_vector_type(16)));
typedef short bf16x8 __attribute__((ext_vector_type(8)));
typedef short s16x4 __attribute__((ext_vector_type(4)));
constexpr int NWAVES = 8, NTHR = 512;
constexpr int NB = 8, SQ = 8192, DM = 1024, MT = NB * SQ;
constexpr int FOX_IN = 4112, KVW = 6144, BIN = 4096;
constexpr float LOG2E = 1.4426950408889634f;
constexpr float C2A = 0.125f * LOG2E;
constexpr float C2B = 0.08838834764831845f * LOG2E;
constexpr size_t MiB = 1u << 20;
constexpr size_t WS_RS1 = 0, WS_RS2 = 256 * 1024, WS_RS3 = 512 * 1024, CTL_ZERO_BYTES = 1 * MiB + 8192 + 16384;
constexpr size_t WS_NRM = 768 * 1024, WS_QH = 1024 * 1024;
constexpr size_t WS_BAR = 1 * MiB + 8192;
constexpr size_t WS_RS0 = 1 * MiB + 64 * 1024;
constexpr size_t WS_WINA = 2 * MiB, WS_WOUTA = 18 * MiB, WS_WKV = 22 * MiB, WS_WINB = 34 * MiB, WS_WOUTB = 50 * MiB, WS_WF = 54 * MiB;
constexpr size_t WS_Q = 184 * MiB, WS_K = 312 * MiB, WS_V = 440 * MiB, WS_G = 568 * MiB, WS_CL = 696 * MiB, WS_TOT = 700 * MiB, WS_O = 704 * MiB;
constexpr size_t WS_KV = 184 * MiB;
constexpr size_t WS_U = 56 * MiB;
constexpr size_t WS_LSE = 952 * MiB, WS_MA = 956 * MiB, WS_END = 1020 * MiB; constexpr int U_SPLIT_ROWS = 16384;
constexpr size_t U_BYTES_PER_BATCH = (size_t)SQ * BIN * 2, LSE_BYTES_PER_BATCH = (size_t)SQ * 24 * 4;
constexpr int RING_BYTES = 131072, LDS_BYTES = 147456;

__device__ __forceinline__ unsigned f2bf(float f) { unsigned u = __builtin_bit_cast(unsigned, f); return (u + 0x7fffu + ((u >> 16) & 1u)) >> 16; }
__device__ __forceinline__ unsigned pk2(float lo, float hi) { return f2bf(lo) | (f2bf(hi) << 16); }
typedef float f32x2_t __attribute__((ext_vector_type(2))); typedef __bf16 bf16x2_t __attribute__((ext_vector_type(2)));
__device__ __forceinline__ unsigned cvtpk(float lo, float hi) { f32x2_t v = {lo, hi}; bf16x2_t b = __builtin_convertvector(v, bf16x2_t); return __builtin_bit_cast(unsigned, b); }
__device__ __forceinline__ float bflo(unsigned w) { return __uint_as_float(w << 16); }
__device__ __forceinline__ float bfhi(unsigned w) { return __uint_as_float(w & 0xffff0000u); }
__device__ __forceinline__ float wave_sum(float v) {
    v = xr_sum<1>(v); v = xr_sum<2>(v); v = xr_sum<4>(v); v = xr_sum<8>(v); v = xr_sum<16>(v); v = xr_sum<32>(v);
    return v;
}
__device__ __forceinline__ float silu_f(float g) { return g * __builtin_amdgcn_rcpf(1.f + __builtin_amdgcn_exp2f(-LOG2E * g)); }

__device__ __forceinline__ void p0_transpose_item(const float* W, int K, int ldw, int nblk, const float* gain, bf16* WT, LAS float* scr, int item, int lane) {
    const int kb = item / nblk, nb = item % nblk, k0 = 64 * kb, n0 = 32 * nb;
    float wv_[32], gv_[32];
#pragma unroll
    for (int i = 0; i < 32; ++i) { const int kk = 2 * i + (lane >> 5); wv_[i] = W[(size_t)(k0 + kk) * ldw + n0 + (lane & 31)]; gv_[i] = gain ? gain[k0 + kk] : 1.f; }
#pragma unroll
    for (int i = 0; i < 32; ++i) { const int kk = 2 * i + (lane >> 5); scr[kk * 33 + (lane & 31)] = gv_[i] * wv_[i]; }
    asm volatile("s_waitcnt lgkmcnt(0)" ::: "memory");
    const int c = lane & 7;
#pragma unroll
    for (int j = 0; j < 4; ++j) { const int n = (lane >> 3) + 8 * j; const LAS float* s = scr + (8 * c) * 33 + n;
        v4u o; o.x = pk2(s[0 * 33], s[1 * 33]); o.y = pk2(s[2 * 33], s[3 * 33]); o.z = pk2(s[4 * 33], s[5 * 33]); o.w = pk2(s[6 * 33], s[7 * 33]);
        *(GAS v4u*)(WT + (size_t)(n0 + n) * K + k0 + 8 * c) = o; }
    asm volatile("s_waitcnt lgkmcnt(0)" ::: "memory");
}

#define RLX_AGENT __ATOMIC_RELAXED, __HIP_MEMORY_SCOPE_AGENT
#define XB_TMO      128
#define XB_XCNT(j)  (256  + 64 * (j))
#define XB_XSUB(j)  (1280 + 64 * (j))
#define XB_XGEN(j)  (2304 + 64 * (j))
#define XB_TOP      3328
#define XB_TOPGEN   3392
#define XCD_BAR_WORDS 3456
#define XB_SPIN_CAP (1u << 18)

__device__ __forceinline__ unsigned xb_ld(unsigned* p)              { return __hip_atomic_load(p, __ATOMIC_RELAXED, __HIP_MEMORY_SCOPE_AGENT); }
__device__ __forceinline__ unsigned xb_add(unsigned* p, unsigned v) { return __hip_atomic_fetch_add(p, v, __ATOMIC_RELAXED, __HIP_MEMORY_SCOPE_AGENT); }
__device__ __forceinline__ unsigned xb_xcc_id() { return (unsigned)__builtin_amdgcn_s_getreg((3 << 11) | 20) & 0xFu; }
#define XB_SPIN(cond, bar) do { unsigned _sp = 0; while (cond) { __builtin_amdgcn_s_sleep(1); \
    if ((++_sp & 255u) == 0u) { if (xb_ld(&(bar)[XB_TMO])) break; if (_sp > XB_SPIN_CAP) { atomicAdd(&(bar)[XB_TMO], 1u); break; } } } } while (0)

struct XcdBarrier {
    unsigned* bar; unsigned x;
    volatile LAS unsigned* st;
};

__device__ __forceinline__ XcdBarrier xcd_barrier_post(unsigned* bar, volatile LAS unsigned* st) {
    XcdBarrier b; b.bar = bar; b.x = xb_xcc_id(); b.st = st;
    if (threadIdx.x == 0) (void)xb_add(&bar[XB_XCNT(b.x)], 1u);
    return b;
}
__device__ __forceinline__ void xcd_barrier_complete(unsigned* bar, unsigned x, unsigned& nloc, unsigned& nx) {
    const unsigned G = gridDim.x * gridDim.y * gridDim.z;
    unsigned sum, cnt, mine, sp = 0u;
    for (;;) {
        sum = 0u; cnt = 0u; mine = 0u;
#pragma unroll
        for (unsigned j = 0; j < 16; ++j) { const unsigned c = xb_ld(&bar[XB_XCNT(j)]); sum += c; cnt += (c > 0u) ? 1u : 0u; mine = (j == x) ? c : mine; }
        if (sum == G) break;
        __builtin_amdgcn_s_sleep(1);
        if ((++sp & 255u) == 0u) { if (xb_ld(&bar[XB_TMO])) break; if (sp > XB_SPIN_CAP) { atomicAdd(&bar[XB_TMO], 1u); break; } }
    }
    nloc = mine > 0u ? mine : 1u; nx = cnt > 0u ? cnt : 1u;
}

__device__ __forceinline__ void xcd_barrier(const XcdBarrier& b) {
    asm volatile("s_waitcnt vmcnt(0)" ::: "memory");
    __syncthreads();
    if (threadIdx.x == 0) {
        unsigned* bar = b.bar;
        __builtin_amdgcn_s_waitcnt(0);
        unsigned nloc = b.st[0], nx = b.st[1];
        if (nloc == 0u) { xcd_barrier_complete(bar, b.x, nloc, nx); b.st[0] = nloc; b.st[1] = nx; }
        const unsigned old = xb_add(&bar[XB_XSUB(b.x)], 1u);
        const unsigned gen = old / nloc;
        if (old + 1u == (gen + 1u) * nloc) {
            __builtin_amdgcn_fence(__ATOMIC_RELEASE, "agent");
            asm volatile("s_waitcnt vmcnt(0)" ::: "memory");
            const unsigned og = xb_add(&bar[XB_TOP], 1u);
            const unsigned tg = og / nx;
            if (og + 1u == (tg + 1u) * nx) xb_add(&bar[XB_TOPGEN], 1u);
            else XB_SPIN(xb_ld(&bar[XB_TOPGEN]) == tg, bar);
            __builtin_amdgcn_fence(__ATOMIC_ACQUIRE, "agent");
            xb_add(&bar[XB_XGEN(b.x)], 1u);
            asm volatile("s_waitcnt vmcnt(0)" ::: "memory");
        } else {
            XB_SPIN(xb_ld(&bar[XB_XGEN(b.x)]) == gen, bar);
            __builtin_amdgcn_fence(__ATOMIC_ACQUIRE, "agent");
            asm volatile("s_waitcnt vmcnt(0)" ::: "memory");
        }
    }
    __syncthreads();
}

struct Args { const float* in[12]; float* out; unsigned char* ws; int ph_lo, ph_hi, nbc, pad; };

__device__ __forceinline__ void f_item(LAS unsigned char* lds, const bf16* hb, const bf16* Wf, const float* bfv, const float* rowss, float* CL, float* TOT, int item, int wid, int lane) {
    const int b = item >> 6, blk = item & 63, fr = lane & 15, fq = lane >> 4;
    const int tok0 = b * SQ + blk * 128 + wid * 16;
    f32x4 acc = (f32x4){0.f, 0.f, 0.f, 0.f};
    const bf16* xa = hb + (size_t)(tok0 + fr) * DM + fq * 8; const bf16* wb = Wf + (size_t)fr * DM + fq * 8;
#pragma unroll 1
    for (int k8 = 0; k8 < 4; ++k8) { bf16x8 a8[8], w8[8];
#pragma unroll
        for (int q = 0; q < 8; ++q) { a8[q] = *(const bf16x8*)(xa + (k8 * 8 + q) * 32); w8[q] = *(const bf16x8*)(wb + (k8 * 8 + q) * 32); }
        asm volatile("" : "+v"(a8[0]), "+v"(a8[1]), "+v"(a8[2]), "+v"(a8[3]), "+v"(a8[4]), "+v"(a8[5]), "+v"(a8[6]), "+v"(a8[7]));
#pragma unroll
        for (int q = 0; q < 8; ++q) acc = __builtin_amdgcn_mfma_f32_16x16x32_bf16(a8[q], w8[q], acc, 0, 0, 0); }
    const float bias = bfv[fr]; float s[4]; float run = 0.f;
#pragma unroll
    for (int e = 0; e < 4; ++e) { const float rs = __builtin_amdgcn_rsqf(rowss[tok0 + 4 * fq + e] * (1.0f / 1024.0f) + 1e-6f); const float f = acc[e] * rs + bias;
        const float ls = fminf(f, 0.f) - log1pf(__expf(-fabsf(f))); run += ls; s[e] = run; }
    float pre = 0.f;
#pragma unroll
    for (int j = 0; j < 3; ++j) { const float tj = xl_from_lane(run, fr + 16 * j); if (j < fq) pre += tj; }
    LAS float* wtot = (LAS float*)lds;
    if (fq == 3) wtot[wid * 16 + fr] = pre + run;
    __syncthreads();
    float wpre = 0.f, all = 0.f;
#pragma unroll
    for (int w = 0; w < 8; ++w) { const float t = wtot[w * 16 + fr]; all += t; if (w < wid) wpre += t; }
    const float base = wpre + pre;
    *(f32x4*)(CL + (size_t)(b * 16 + fr) * SQ + blk * 128 + wid * 16 + 4 * fq) = (f32x4){base + s[0], base + s[1], base + s[2], base + s[3]};
    if (wid == 0 && fq == 0) TOT[(b * 16 + fr) * 64 + blk] = all;
    __syncthreads();
}

__device__ __forceinline__ unsigned offb(unsigned row, unsigned ch) { return 256u * row + 16u * (ch ^ (((row & 3) << 2) | ((row >> 2) & 3))); }
__device__ __forceinline__ int crow(int r, int hi) { return (r & 3) + 8 * (r >> 2) + 4 * hi; }
__device__ __forceinline__ int t5_bucket(int dist) {
    if (dist < 16) return dist;
    int b = 16;
    b += dist >= 22; b += dist >= 30; b += dist >= 40; b += dist >= 54; b += dist >= 73; b += dist >= 99; b += dist >= 134; b += dist >= 182;
    b += dist >= 246; b += dist >= 332; b += dist >= 450; b += dist >= 609; b += dist >= 825; b += dist >= 1117; b += dist >= 1513;
    return b;
}
#define BATT_DECODE(IT, KG, UG, LSEP, DD, RR, PP, GH) do { const int bl_ = (IT) / 768, r_ = (IT) % 768, g_ = r_ >> 8, h_ = (r_ >> 5) & 7, pi_ = r_ & 31; \
    DD = (g_ == 0) ? 1 : (g_ == 1) ? 4 : 16; const int ppr_ = 32 / DD; RR = pi_ / ppr_; PP = pi_ % ppr_; GH = g_ * 8 + h_; \
    KG = KV + ((((size_t)(b0 + bl_) * 3 + g_) * 2) * 8 + h_) * ((size_t)SQ * 128); UG = (bl_ < 2 ? U + (size_t)bl_ * SQ * BIN : U2 + (size_t)(bl_ - 2) * SQ * BIN) + g_ * 1024 + h_ * 128; LSEP = LSE + (size_t)bl_ * SQ * 24; } while (0)
#define BATT_LOADK(KG, DD, RR, PP) do { const long koff_ = ((long)(RR) * (SQ / (DD)) + 256 * (PP) - 128 + row0) * 128 + ch0 * 8; const long kstr_ = 4096; \
    _Pragma("unroll") for (int i = 0; i < 12; ++i) kreg[i] = ((PP) > 0 || i >= 4) ? *(const v4u*)((KG) + koff_ + i * kstr_) : (v4u){0u, 0u, 0u, 0u}; } while (0)
__device__ __forceinline__ void battn_phase(LAS unsigned char* lds, const bf16* KV, bf16* U, bf16* U2, float* LSE, const float* relb, int b0, int nitems, int vcu, int G, int tid_in, int wid, int reps) {
    int row0, ch0;
    { int t0 = tid_in; asm volatile("" : "+v"(t0)); row0 = t0 >> 4; ch0 = t0 & 15; }
    LAS float* lut = (LAS float*)(lds + 98304);
    LAS float* wsf = (LAS float*)(lds + 98304 + 1024) + wid * 32;
    LAS bf16* stg = (LAS bf16*)(lds + 98304 + 2048 + wid * 4096);
    const int total = nitems * reps;
    int it = vcu; if (it >= total) return;
    const bf16* Kg; bf16* Ug; float* LSEp; int d, rr, pp, gh;
    v4u kreg[12];
    { const int itm = it % nitems; BATT_DECODE(itm, Kg, Ug, LSEp, d, rr, pp, gh); BATT_LOADK(Kg, d, rr, pp); }
    for (;;) {
        const bool dry = it + nitems < total;
        int tid = tid_in; asm volatile("" : "+v"(tid));
        const int lane = tid & 63, r32 = lane & 31, hi = lane >> 5; const unsigned loff = offb((unsigned)(tid >> 4), (unsigned)(tid & 15));
        bf16x8 qf[8];
        { const size_t qtok_ = (size_t)((256 * pp + 32 * wid + r32) * d + rr);
#pragma unroll
          for (int d0 = 0; d0 < 8; ++d0) qf[d0] = *(const bf16x8*)(Ug + qtok_ * BIN + d0 * 16 + hi * 8); }
        if (tid < 192) { const int rel_ = tid - 32; lut[tid] = (rel_ >= 0 && rel_ <= 128) ? relb[t5_bucket(rel_ * d) * 24 + gh] * LOG2E : 0.f; }
#pragma unroll
        for (int i = 0; i < 12; ++i) *(LAS v4u*)(lds + i * 8192 + loff) = kreg[i];
        __syncthreads();
        v4u vreg[12];
        { const long koff_ = ((long)rr * (SQ / d) + 256 * pp - 128 + (tid >> 4)) * 128 + (tid & 15) * 8; const long kstr_ = 4096;
#pragma unroll
          for (int i = 0; i < 12; ++i) vreg[i] = (pp > 0 || i >= 4) ? *(const v4u*)(Kg + (size_t)8 * SQ * 128 + koff_ + i * kstr_) : (v4u){0u, 0u, 0u, 0u}; }
        f32x16 s[5];
        const unsigned xr = ((r32 & 3) << 2) | ((r32 >> 2) & 3);
#pragma unroll
        for (int kb = 0; kb < 5; ++kb) { s[kb] = (f32x16){0.f,0.f,0.f,0.f,0.f,0.f,0.f,0.f,0.f,0.f,0.f,0.f,0.f,0.f,0.f,0.f};
            const LAS unsigned char* tb = lds + (wid + kb) * 8192 + 256 * r32;
#pragma unroll
            for (int d0 = 0; d0 < 8; ++d0) { const bf16x8 kf = *(const LAS bf16x8*)(tb + 16 * ((unsigned)(2 * d0 + hi) ^ xr)); s[kb] = __builtin_amdgcn_mfma_f32_32x32x16_bf16(kf, qf[d0], s[kb], 0, 0, 0); } }
        float mx = -INFINITY;
        const int e_ = r32 - 4 * hi; const LAS float* lp = lut + (e_ + 32);
#pragma unroll
        for (int kb = 0; kb < 5; ++kb) {
            if (pp == 0 && wid + kb < 4) {
#pragma unroll
                for (int r = 0; r < 16; ++r) s[kb][r] = -INFINITY;
            } else {
#pragma unroll
                for (int r = 0; r < 16; ++r) { const int cr = (r & 3) + 8 * (r >> 2); float v = s[kb][r] + lp[128 - 32 * kb - cr];
                    if (kb == 0) v = (e_ <= cr) ? v : -INFINITY;
                    if (kb == 4) v = (e_ >= cr) ? v : -INFINITY;
                    s[kb][r] = v; mx = fmaxf(mx, v); }
            }
        }
        mx = xr_max<32>(mx);
        float l = 0.f;
#pragma unroll
        for (int kb = 0; kb < 5; ++kb)
#pragma unroll
            for (int r = 0; r < 16; ++r) { const float p = __builtin_amdgcn_exp2f(s[kb][r] - mx); s[kb][r] = p; l += p; }
        l = xr_sum<32>(l);
        bf16x8 pf[5][2];
#pragma unroll
        for (int kb = 0; kb < 5; ++kb)
#pragma unroll
            for (int ks = 0; ks < 2; ++ks) { v4u w; w.x = cvtpk(s[kb][8 * ks + 0], s[kb][8 * ks + 1]); w.y = cvtpk(s[kb][8 * ks + 2], s[kb][8 * ks + 3]); w.z = cvtpk(s[kb][8 * ks + 4], s[kb][8 * ks + 5]); w.w = cvtpk(s[kb][8 * ks + 6], s[kb][8 * ks + 7]);
                pf[kb][ks] = __builtin_bit_cast(bf16x8, w); }
        __syncthreads();
#pragma unroll
        for (int i = 0; i < 12; ++i) *(LAS v4u*)(lds + i * 8192 + loff) = vreg[i];
        if (hi == 0) wsf[r32] = __builtin_amdgcn_rcpf(l);
        __syncthreads();
        bf16* const Uc = Ug; float* const Lc = LSEp; const int dc = d, rrc = rr, ppc = pp, ghc = gh;
        const int nit = it + G; const bool has_next = nit < total;
        if (has_next) { const int itm = nit % nitems; BATT_DECODE(itm, Kg, Ug, LSEp, d, rr, pp, gh); BATT_LOADK(Kg, d, rr, pp); }
        f32x16 o[4];
        int l2 = lane; asm volatile("" : "+v"(l2));
        const unsigned blk = (l2 >> 4) & 1, qq = (l2 & 15) >> 2, p4 = l2 & 3;
#pragma unroll
        for (int c = 0; c < 4; ++c) { o[c] = (f32x16){0.f,0.f,0.f,0.f,0.f,0.f,0.f,0.f,0.f,0.f,0.f,0.f,0.f,0.f,0.f,0.f};
#pragma unroll
            for (int kb = 0; kb < 5; ++kb)
#pragma unroll
                for (int ks = 0; ks < 2; ++ks) { s16x4 vv[2];
#pragma unroll
                    for (int t = 0; t < 2; ++t) { const unsigned row = 16 * ks + 8 * t + 4 * hi + qq; const LAS unsigned char* ap = lds + (wid + kb) * 8192 + offb(row, 4 * c + 2 * blk + (p4 >> 1)) + 8 * (p4 & 1);
                        vv[t] = __builtin_bit_cast(s16x4, __builtin_amdgcn_ds_read_tr16_b64_v4i16((LAS s16x4*)ap)); }
                    const bf16x8 vf = (bf16x8){vv[0][0], vv[0][1], vv[0][2], vv[0][3], vv[1][0], vv[1][1], vv[1][2], vv[1][3]};
                    o[c] = __builtin_amdgcn_mfma_f32_32x32x16_bf16(pf[kb][ks], vf, o[c], 0, 0, 0); } }
        float rl[16];
#pragma unroll
        for (int r = 0; r < 16; ++r) rl[r] = wsf[crow(r, hi)];
#pragma unroll
        for (int hc = 0; hc < 2; ++hc) {
#pragma unroll
            for (int r = 0; r < 16; ++r) { const int qr_ = crow(r, hi);
#pragma unroll
                for (int cc = 0; cc < 2; ++cc) stg[qr_ * 64 + cc * 32 + r32] = (bf16)cvtpk(o[2 * hc + cc][r] * rl[r], 0.f); }
#pragma unroll
            for (int i = 0; i < 4; ++i) { const int row = i * 8 + (l2 >> 3), ch = l2 & 7; const v4u v = *(const LAS v4u*)(stg + row * 64 + ch * 8);
                const size_t tok = (size_t)((256 * ppc + 32 * wid + row) * dc + rrc); if (!dry) *(v4u*)(Uc + tok * BIN + hc * 64 + ch * 8) = v; }
        }
        if (hi == 0 && !dry) Lc[(size_t)((256 * ppc + 32 * wid + r32) * dc + rrc) * 24 + ghc] = mx + __builtin_amdgcn_logf(l);
        __syncthreads();
        if (!has_next) break;
        it = nit;
    }
}
#ifndef PHASE_MASK
#define PHASE_MASK 0xffff
#endif
#define EN(k) ((PHASE_MASK >> (k)) & 1)
#ifndef PROBE_GEMM_REPS
#define PROBE_GEMM_REPS 1
#endif
#ifndef PROBE_BATT_REPS
#define PROBE_BATT_REPS 1
#endif
#ifndef PROBE_RES_REPS
#define PROBE_RES_REPS 1
#endif
#ifndef PROBE_MEM_REPS
#define PROBE_MEM_REPS 1
#endif
#ifndef PROBE_ATT_REPS
#define PROBE_ATT_REPS 1
#endif
enum { K_PRO = 0, K_AIN, K_AATT, K_AOUT, K_KV, K_BIN, K_BATT, K_BMRG, K_BOUT, K_FIN };
__global__ void __launch_bounds__(NTHR, 2) yoco_fwd(Args args) {
    extern __shared__ __attribute__((aligned(16))) unsigned char lds_raw[];
    cg::grid_group grid = cg::this_grid();
    LAS unsigned char* lds = (LAS unsigned char*)lds_raw;
    const int wid0 = __builtin_amdgcn_readfirstlane(threadIdx.x >> 6);
#define INP(k) ({ int k_ = (k); asm volatile("" : "+s"(k_)); (const float*)(GAS const float*)args.in[k_]; })
    volatile LAS unsigned* bst = (volatile LAS unsigned*)((LAS unsigned char*)lds_raw + LDS_BYTES - 64);
    if (threadIdx.x < 2) bst[threadIdx.x] = 0u;
    __syncthreads();
    (void)xcd_barrier_post((unsigned*)(args.ws + WS_BAR), bst);

    for (int ph = args.ph_lo; ; ++ph) {
        int G = gridDim.x; asm volatile("" : "+s"(G)); int bx = blockIdx.x; asm volatile("" : "+s"(bx)); int nbc = args.nbc; asm volatile("" : "+s"(nbc));
        const int vcu = (G % 8 == 0) ? (bx % 8) * (G / 8) + bx / 8 : bx;
        const int lnch = (nbc == 8) ? 0 : (nbc == 4) ? 1 : (nbc == 2) ? 2 : 3, nch = 1 << lnch;
        const int n_phase = 8 + 6 * nch + 1;
        const int NGW = G * NWAVES;
        if (ph >= args.ph_hi || ph >= n_phase) break;
        int kind, layer = 0, chunk = 0;
        if (ph == 0) kind = K_PRO;
        else if (ph < 7) { layer = (ph - 1) / 3; kind = K_AIN + (ph - 1) % 3; }
        else if (ph == 7) kind = K_KV;
        else if (ph < 8 + 6 * nch) { const int q = ph - 8, j = q / 3; layer = j >> lnch; chunk = j & (nch - 1); kind = K_BATT + (q - 3 * j); }
        else kind = K_FIN;

        for (int pass_ = 0; pass_ < 2; ++pass_) {
        if (pass_ == 1) { if (kind != K_BOUT && kind != K_KV) break; const int j = (kind == K_KV) ? 0 : (layer << lnch) + chunk + 1; if (j >= 2 * nch) break; layer = j >> lnch; chunk = j & (nch - 1); kind = K_BIN; }
        int tid; asm volatile("v_mbcnt_lo_u32_b32 %0, -1, 0\n\tv_mbcnt_hi_u32_b32 %0, -1, %0" : "=v"(tid)); tid += wid0 * 64;
        GAS unsigned char* ws = (GAS unsigned char*)args.ws; asm volatile("" : "+s"(ws)); GAS float* outg = (GAS float*)args.out; asm volatile("" : "+s"(outg)); float* out = (float*)outg; bf16* HB = (bf16*)out; bf16* LOP = HB + (size_t)MT * DM;
        const int lane = tid & 63, wid = __builtin_amdgcn_readfirstlane(tid >> 6); const int gw = vcu * NWAVES + wid;
        if (EN(K_PRO) && kind == K_PRO) {
            const float* x = INP(0); const float* norm_a = INP(2); const float* w_in_a = INP(3); const float* w_out_a = INP(5); const float* norm_kv = INP(6); const float* w_kv = INP(7); const float* norm_b = INP(8); const float* w_in_b = INP(9); const float* w_out_b = INP(10);
            for (int rp_ = 0; rp_ < PROBE_MEM_REPS; ++rp_) {
            LAS float* scr = (LAS float*)(lds + wid * 16384);
            constexpr int I_INA = 16 * 128, I_OUT = 16 * 32, I_KV = 16 * 192, I_INB = 16 * 128;
            constexpr int NITEMS = 2 * I_INA + 2 * I_OUT + I_KV + 2 * I_INB + 2 * I_OUT + 32;
#pragma unroll 1
            for (int it = gw; it < NITEMS; it += NGW) {
                int r = it;
                if (r < 2 * I_INA) { const int i = r / I_INA; p0_transpose_item(w_in_a + (size_t)i * DM * FOX_IN, DM, FOX_IN, 128, norm_a + i * DM, (bf16*)(ws + WS_WINA + (size_t)i * 8 * MiB), scr, r % I_INA, lane); continue; } r -= 2 * I_INA;
                if (r < 2 * I_OUT) { const int i = r / I_OUT; p0_transpose_item(w_out_a + (size_t)i * DM * DM, DM, DM, 32, nullptr, (bf16*)(ws + WS_WOUTA + (size_t)i * 2 * MiB), scr, r % I_OUT, lane); continue; } r -= 2 * I_OUT;
                if (r < I_KV) { p0_transpose_item(w_kv, DM, KVW, 192, norm_kv, (bf16*)(ws + WS_WKV), scr, r, lane); continue; } r -= I_KV;
                if (r < 2 * I_INB) { const int i = r / I_INB; p0_transpose_item(w_in_b + (size_t)i * DM * BIN, DM, BIN, 128, norm_b + i * DM, (bf16*)(ws + WS_WINB + (size_t)i * 8 * MiB), scr, r % I_INB, lane); continue; } r -= 2 * I_INB;
                if (r < 2 * I_OUT) { const int i = r / I_OUT; p0_transpose_item(w_out_b + (size_t)i * DM * DM, DM, DM, 32, nullptr, (bf16*)(ws + WS_WOUTB + (size_t)i * 2 * MiB), scr, r % I_OUT, lane); continue; } r -= 2 * I_OUT;
                { const int i = r >> 4, n = r & 15;
#pragma unroll 4
                  for (int j = 0; j < 16; ++j) { const int k = lane + 64 * j; ((bf16*)(ws + WS_WF))[(i * 16 + n) * DM + k] = (bf16)f2bf(norm_a[i * DM + k] * w_in_a[(size_t)i * DM * FOX_IN + (size_t)k * FOX_IN + 4096 + n]); } }
            }
            float* RS0 = (float*)(ws + WS_RS0);
#pragma unroll 1
            for (int m = gw; m < MT; m += NGW) {
                const f32x4* xr = (const f32x4*)(x + (size_t)m * DM) + lane; unsigned long long* hrow = (unsigned long long*)(HB + (size_t)m * DM) + lane;
                f32x4 v[4]; float s = 0.f;
#pragma unroll
                for (int j = 0; j < 4; ++j) v[j] = xr[64 * j];
                asm volatile("" : "+v"(v[0]), "+v"(v[1]), "+v"(v[2]), "+v"(v[3]));
#pragma unroll
                for (int j = 0; j < 4; ++j) s += (v[j].x * v[j].x + v[j].y * v[j].y) + (v[j].z * v[j].z + v[j].w * v[j].w);
                s = wave_sum(s);
#pragma unroll
                for (int j = 0; j < 4; ++j) { const unsigned h0 = cvtpk(v[j].x, v[j].y), h1 = cvtpk(v[j].z, v[j].w);
                    hrow[64 * j] = (unsigned long long)h0 | ((unsigned long long)h1 << 32); }
                if (lane == 0) RS0[m] = s;
            }
            }
        }
        else if (EN(K_AIN) && (kind == K_AIN || kind == K_KV || kind == K_BIN)) {
            pg8::Gemm g; pg8::EpiBf16Row E;
            if (kind == K_AIN) {
                const float* rs = (const float*)(ws + (layer == 0 ? WS_RS0 : WS_RS1));
#pragma unroll 1
                for (int it = vcu; it < 512; it += G)
                    f_item(lds, HB, (const bf16*)(ws + WS_WF) + (size_t)layer * 16 * DM, INP(4) + layer * 16, rs, (float*)(ws + WS_CL), (float*)(ws + WS_TOT), it, wid, lane);
                g = pg8::Gemm{HB, (const bf16*)(ws + WS_WINA + (size_t)layer * 8 * MiB), MT, 4096, DM, DM};
                E = pg8::EpiBf16Row{(bf16*)(ws + WS_Q), DM, rs, DM, (size_t)(WS_K - WS_Q) / 2, DM, C2A, nullptr, 0, 0, (unsigned*)(ws + WS_NRM) + (size_t)layer * 32768};
            } else if (kind == K_KV) {
                g = pg8::Gemm{HB, (const bf16*)(ws + WS_WKV), MT, KVW, DM, DM};
                E = pg8::EpiBf16Row{(bf16*)(ws + WS_KV), KVW, (const float*)(ws + WS_RS2), 0, 0, 0, 1.f, nullptr, 0, 1, nullptr};
            } else {
                const size_t row0 = (size_t)chunk * nbc * SQ;
                g = pg8::Gemm{HB + row0 * DM, (const bf16*)(ws + WS_WINB + (size_t)layer * 8 * MiB), nbc * SQ, BIN, DM, DM};
                E = pg8::EpiBf16Row{(bf16*)(ws + WS_U), BIN, (const float*)(ws + (layer == 0 ? WS_RS2 : WS_RS3)) + row0, 0, 0, 3072, C2B, HB + (size_t)MT * DM, U_SPLIT_ROWS, 0, nullptr};
            }
            pg8::StaticOrder S; S.init(g.M, g.N, G, bx);
            for (int rep_ = 0; rep_ < PROBE_GEMM_REPS; ++rep_) pg8::gemm_phase<pg8::EpiBf16Row, pg8::StaticOrder, true, true>(lds, g, S, E, tid);
        }
        else if (EN(K_AATT) && kind == K_AATT) {
            const attn_body::AttnTensors AT{(const attn_body::bf16*)(ws + WS_Q), (const attn_body::bf16*)(ws + WS_K), (const attn_body::bf16*)(ws + WS_V), (attn_body::bf16*)(ws + WS_O),
                                            (const attn_body::bf16*)(ws + WS_G), (const float*)(ws + WS_CL), (const float*)(ws + WS_TOT), (const float*)(ws + WS_NRM) + (size_t)layer * 32768};
            const attn_body::DynOrder S{(unsigned*)(ws + WS_QH) + layer * 512, (int)(__builtin_amdgcn_s_getreg((3 << 11) | 20) & 7), wid0, (LAS unsigned*)(lds + attn_body::LDS_REL + 260)};
            if (tid == 0) *S.slot = 0xfffffffeu;
            __syncthreads();
            attn_body::attn_phase<attn_body::DynOrder, 24>((char*)lds_raw, AT, S);
#if PROBE_ATT_REPS > 1
            { const attn_body::DynOrder S2{(unsigned*)(ws + WS_QH) + 1024 + layer * 512, S.xcc, wid0, S.slot}; __syncthreads(); attn_body::attn_phase<attn_body::DynOrder, 24>((char*)lds_raw, AT, S2); }
#endif

        }
        else if (EN(K_AOUT) && (kind == K_AOUT || kind == K_BOUT)) {
            pg8::Gemm g; pg8::EpiResid E;
            if (kind == K_AOUT) {
                g = pg8::Gemm{(const bf16*)(ws + WS_O), (const bf16*)(ws + WS_WOUTA + (size_t)layer * 2 * MiB), MT, DM, DM, DM};
                E = pg8::EpiResid{HB, LOP, nullptr, (float*)(ws + (layer == 0 ? WS_RS1 : WS_RS2)), DM, 0, layer == 0 ? INP(0) : (const float*)nullptr};
            } else {
                const size_t row0 = (size_t)chunk * nbc * SQ;
                g = pg8::Gemm{(const bf16*)(ws + WS_MA), (const bf16*)(ws + WS_WOUTB + (size_t)layer * 2 * MiB), nbc * SQ, DM, DM, DM};
                E = pg8::EpiResid{HB + row0 * DM, LOP + row0 * DM, layer == 0 ? (float*)nullptr : (float*)(ws + WS_KV) + (size_t)chunk * nbc * pg8::FIN_BSTRIDE, layer == 0 ? (float*)(ws + WS_RS3) + row0 : (float*)nullptr, DM, 0, nullptr};
            }
            pg8::StaticOrder S; S.init(g.M, g.N, G, bx);
#if PROBE_RES_REPS > 1
            { pg8::EpiResid E2 = E; E2.dry = 1; pg8::gemm_phase<pg8::EpiResid, pg8::StaticOrder, true, true>(lds, g, S, E2, tid); }
#endif
            pg8::gemm_phase<pg8::EpiResid, pg8::StaticOrder, true, true>(lds, g, S, E, tid);
        }
        else if (EN(K_BATT) && kind == K_BATT) {
            battn_phase(lds, (const bf16*)(ws + WS_KV), (bf16*)(ws + WS_U), HB + (size_t)MT * DM, (float*)(ws + WS_LSE), INP(1), chunk * nbc, nbc * 768, vcu, G, tid, wid, PROBE_BATT_REPS);
        }
        else if (EN(K_BMRG) && kind == K_BMRG) {
            const float* LSE = (const float*)(ws + WS_LSE); const bf16* U = (const bf16*)(ws + WS_U);
#pragma unroll 1
            for (int m = gw; m < nbc * SQ; m += NGW) {
                const int hh = lane >> 3; const float* lp = LSE + (size_t)m * 24 + hh;
                float l0 = lp[0], l1 = lp[8], l2 = lp[16];
                const bf16* urow = (m < U_SPLIT_ROWS ? U + (size_t)m * BIN : (const bf16*)(HB + (size_t)MT * DM) + (size_t)(m - U_SPLIT_ROWS) * BIN) + 16 * lane;
                v4u a[2], b[2], c[2], gt[2];
#pragma unroll
                for (int j = 0; j < 2; ++j) { a[j] = *(const v4u*)(urow + 8 * j); b[j] = *(const v4u*)(urow + 1024 + 8 * j); c[j] = *(const v4u*)(urow + 2048 + 8 * j); gt[j] = *(const v4u*)(urow + 3072 + 8 * j); }
                asm volatile("" : "+v"(l0), "+v"(l1), "+v"(l2), "+v"(a[0]), "+v"(a[1]), "+v"(b[0]), "+v"(b[1]), "+v"(c[0]), "+v"(c[1]), "+v"(gt[0]), "+v"(gt[1]));
                const float mxl = fmaxf(l0, fmaxf(l1, l2));
                float w0 = __builtin_amdgcn_exp2f(l0 - mxl), w1 = __builtin_amdgcn_exp2f(l1 - mxl), w2 = __builtin_amdgcn_exp2f(l2 - mxl); const float inv = __builtin_amdgcn_rcpf(w0 + w1 + w2); w0 *= inv; w1 *= inv; w2 *= inv;
#pragma unroll
                for (int j = 0; j < 2; ++j) { v4u o;
#pragma unroll
                    for (int e = 0; e < 4; ++e) { const float v0 = (w0 * bflo(a[j][e]) + w1 * bflo(b[j][e]) + w2 * bflo(c[j][e])) * silu_f(bflo(gt[j][e])), v1 = (w0 * bfhi(a[j][e]) + w1 * bfhi(b[j][e]) + w2 * bfhi(c[j][e])) * silu_f(bfhi(gt[j][e])); o[e] = cvtpk(v0, v1); }
                    *(v4u*)((bf16*)(ws + WS_MA) + (size_t)m * DM + 16 * lane + 8 * j) = o; }
            }
        }
        else if (EN(K_FIN) && kind == K_FIN) {
            const f32x4* gp0 = (const f32x4*)INP(11) + lane;
            for (int rp_ = 0; rp_ < PROBE_MEM_REPS; ++rp_)
#pragma unroll 1
            for (int m = gw; m < MT; m += NGW) {
                f32x4* orow = (f32x4*)(out + (size_t)m * DM) + lane; f32x4 v[4]; float s = 0.f;
                const f32x4* irow = (const f32x4*)((const float*)(ws + WS_KV) + (size_t)(m >> 13) * pg8::FIN_BSTRIDE + (size_t)(m & 8191) * DM) + lane;
#pragma unroll
                for (int j = 0; j < 4; ++j) v[j] = irow[64 * j];
                f32x4 gfin[4];
#pragma unroll
                for (int j = 0; j < 4; ++j) gfin[j] = gp0[64 * j];
                asm volatile("" : "+v"(v[0]), "+v"(v[1]), "+v"(v[2]), "+v"(v[3]), "+v"(gfin[0]), "+v"(gfin[1]), "+v"(gfin[2]), "+v"(gfin[3]));
#pragma unroll
                for (int j = 0; j < 4; ++j) s += (v[j].x * v[j].x + v[j].y * v[j].y) + (v[j].z * v[j].z + v[j].w * v[j].w);
                const float rs = 1.0f / sqrtf(wave_sum(s) * (1.0f / 1024.0f) + 1e-6f);
#pragma unroll
                for (int j = 0; j < 4; ++j) orow[64 * j] = v[j] * rs * gfin[j];
            }
        }
        }
        if (ph + 1 < args.ph_hi && ph + 1 < n_phase) { if (ph == args.ph_lo) grid.sync(); else { XcdBarrier xbar; xbar.bar = (unsigned*)(args.ws + WS_BAR); xbar.x = xb_xcc_id(); xbar.st = bst; xcd_barrier(xbar); } }
    }
}

extern "C" void kernel_launch(void* const* d_in, const int* in_sizes, int n_in, void* d_out, int out_size, void* d_ws, size_t ws_size, hipStream_t stream) {
    static int grid = 0, nbc = 1;
    if (grid == 0) {
        if (n_in != 12 || in_sizes[0] != MT * DM || out_size != MT * DM || ws_size < WS_END) { fprintf(stderr, "kernel_launch: unexpected shapes / workspace (n_in %d, ws %zu); nothing launched\n", n_in, ws_size); grid = -1; return; }
        int dev = 0, cus = 0, per_cu = 0;
        if (hipGetDevice(&dev) != hipSuccess || hipDeviceGetAttribute(&cus, hipDeviceAttributeMultiprocessorCount, dev) != hipSuccess) { grid = -1; return; }
        if (hipFuncSetAttribute((const void*)yoco_fwd, hipFuncAttributeMaxDynamicSharedMemorySize, LDS_BYTES) != hipSuccess) { fprintf(stderr, "kernel_launch: hipFuncSetAttribute failed\n"); grid = -1; return; }
        if (hipOccupancyMaxActiveBlocksPerMultiprocessor(&per_cu, (const void*)yoco_fwd, NTHR, LDS_BYTES) != hipSuccess || per_cu < 1) { fprintf(stderr, "kernel_launch: occupancy query gave %d\n", per_cu); per_cu = 1; }
        (void)hipGetLastError();
        grid = cus;
        nbc = 4;
    }
    if (grid < 0) return;
    (void)hipMemsetAsync((char*)d_ws, 0, CTL_ZERO_BYTES, stream);
    Args a{};
    for (int i = 0; i < 12; ++i) a.in[i] = (const float*)d_in[i];
    a.out = (float*)d_out; a.ws = (unsigned char*)d_ws; a.ph_lo = 0; a.ph_hi = 1 << 20; a.nbc = nbc; a.pad = 0;
    void* kargs[] = {&a};
    hipError_t e = hipLaunchCooperativeKernel((const void*)yoco_fwd, dim3(grid), dim3(NTHR), kargs, LDS_BYTES, stream);
    if (e != hipSuccess) fprintf(stderr, "kernel_launch: cooperative launch failed: %s (grid %d)\n", hipGetErrorString(e), grid);
}
```

```cpp
#include <hip/hip_runtime.h>
#include <hip/hip_cooperative_groups.h>
#include <hip/hip_bf16.h>
#include <cstdio>
#include <cstdint>
#include <cmath>
namespace cg = cooperative_groups;
template <int M> __device__ __forceinline__ float xl_partner_lt32(float v) { static_assert(M >= 1 && M < 32, "xor mask"); return __builtin_bit_cast(float, __builtin_amdgcn_ds_swizzle(__builtin_bit_cast(int, v), (M << 10) | 0x1f)); }
template <int M> __device__ __forceinline__ float xr_sum(float v) { if constexpr (M == 32) { const unsigned u = __builtin_bit_cast(unsigned, v); auto rr = __builtin_amdgcn_permlane32_swap(u, u, false, false); return __builtin_bit_cast(float, (unsigned)rr[0]) + __builtin_bit_cast(float, (unsigned)rr[1]); } else return v + xl_partner_lt32<M>(v); }
template <int M> __device__ __forceinline__ float xr_max(float v) { if constexpr (M == 32) { const unsigned u = __builtin_bit_cast(unsigned, v); auto rr = __builtin_amdgcn_permlane32_swap(u, u, false, false); return __builtin_fmaxf(__builtin_bit_cast(float, (unsigned)rr[0]), __builtin_bit_cast(float, (unsigned)rr[1])); } else return __builtin_fmaxf(v, xl_partner_lt32<M>(v)); }
template <int M> __device__ __forceinline__ float xr_min(float v) { if constexpr (M == 32) { const unsigned u = __builtin_bit_cast(unsigned, v); auto rr = __builtin_amdgcn_permlane32_swap(u, u, false, false); return __builtin_fminf(__builtin_bit_cast(float, (unsigned)rr[0]), __builtin_bit_cast(float, (unsigned)rr[1])); } else return __builtin_fminf(v, xl_partner_lt32<M>(v)); }
__device__ __forceinline__ float xl_from_lane(float v, int src_lane) { return __builtin_bit_cast(float, __builtin_amdgcn_ds_bpermute(src_lane << 2, __builtin_bit_cast(int, v))); }
namespace pg8 {
#define PG8_LAS __attribute__((address_space(3)))
typedef unsigned short bf16_t;
typedef short bf16x8 __attribute__((ext_vector_type(8)));
typedef float f32x4 __attribute__((ext_vector_type(4)));
typedef unsigned u32x4 __attribute__((ext_vector_type(4)));
constexpr int BM = 256, BK = 64, HALF = 128, HTB = HALF * BK * 2  , STAGE_BYTES = 8 * HTB, NXCD = 8, WGM = 8;

__host__ __device__ __forceinline__ int lds_byte(int r, int c) { const int st = (r >> 4) * 2 + (c >> 5), rr = r & 15, cc = c & 31, ob = rr * 64 + cc * 2; return st * 1024 + (ob ^ (((ob >> 9) & 1) << 5)); }
__host__ __device__ __forceinline__ void stage_rc(int b, int& R, int& C) { const int st = b / 1024, sb = b % 1024, swz = sb ^ (((sb >> 9) & 1) << 5); R = (st >> 1) * 16 + swz / 64; C = (st & 1) * 32 + (swz % 64) / 2; }
__host__ __device__ __forceinline__ int perm32(int rho) { const int n = rho >> 4, i = rho & 15; return 8 * (i >> 2) + 4 * n + (i & 3); }

struct Unit { int pm, pn; };
struct Gemm { const bf16_t* A; const bf16_t* Bt; int M, N, K, lda; };

struct StaticOrder {
    int nM, nN, nwg, G, c;
    __host__ __device__ void init(int M, int N, int G_, int c_) { nM = M / BM; nN = N / BM; nwg = nM * nN; G = G_; c = c_; }
    __host__ __device__ bool next(int i, Unit& u) const {
        const long L = (long)i * G + c; if (L >= nwg) return false;
        int wgid = (int)L; { const int q = nwg / NXCD, r = nwg % NXCD, xcd = wgid % NXCD, off = wgid / NXCD; wgid = (xcd < r ? xcd * (q + 1) : r * (q + 1) + (xcd - r) * q) + off; }
        const int nig = WGM * nN, gid = wgid / nig, fm = gid * WGM, gsz = (nM - fm) < WGM ? (nM - fm) : WGM;
        u.pm = fm + ((wgid % nig) % gsz); u.pn = (wgid % nig) / gsz; return true;
    }
    __device__ __forceinline__ void a_ready(const Unit&) const {}
    __device__ __forceinline__ void done(const Unit&) const {}
};

__device__ __forceinline__ unsigned cvt_pk_bf16(float lo, float hi) { unsigned r; asm volatile("v_cvt_pk_bf16_f32 %0, %1, %2" : "=v"(r) : "v"(lo), "v"(hi)); return r; }
constexpr float RMS_EPS_F = 1e-6f;
struct EpiBf16Row {
    static constexpr bool PERM = true, AFTER_DRAIN = false;
    bf16_t* O; int ldc; const float* rowss; int split_cols; size_t split_stride; int qcols; float qscale;
    bf16_t* O2; int o2rows;
    int kvmode;
    unsigned* nrm;
    __device__ __forceinline__ void operator()(const f32x4 (&acc)[2][2][4][2], const Unit& u, int wr, int wc, int fr, int fq) const {
        typedef __attribute__((address_space(1))) u32x4 gu32x4; typedef __attribute__((address_space(1))) const float gcf32;
        const int row0 = u.pm * BM + wr * 64 + fr; int colt = u.pn * BM; bf16_t* base = O;
        const float sc = (colt < qcols) ? qscale : 1.f; int t = 0;
        if (split_cols) { t = colt / split_cols; base += (size_t)t * split_stride; colt -= t * split_cols; }
        const int col0 = colt + wc * 32 + 8 * fq;
        const bool do_n = (nrm != nullptr) && (t < 2);
        float rsv[2][4];
#pragma unroll
        for (int ai = 0; ai < 2; ++ai)
#pragma unroll
            for (int m = 0; m < 4; ++m) rsv[ai][m] = ((gcf32*)rowss)[row0 + ai * HALF + m * 16];
        float mx[2][2] = {{0.f, 0.f}, {0.f, 0.f}};
#pragma unroll
        for (int ai = 0; ai < 2; ++ai)
#pragma unroll
            for (int m = 0; m < 4; ++m) { const int r = row0 + ai * HALF + m * 16; const float rs = __builtin_amdgcn_rsqf(rsv[ai][m] * (1.0f / 1024.0f) + RMS_EPS_F) * sc;
                bf16_t* rowp = ((o2rows && r >= o2rows) ? O2 + (size_t)(r - o2rows) * ldc : base + (size_t)r * ldc) + col0; size_t bjs = HALF;
                if (kvmode) { const int g = colt / 2048, kv = (colt >> 10) & 1, h0 = (colt >> 7) & 7, ld = 2 * g, b = r >> 13, tk = r & 8191;
                    const int pos = ((tk & ((1 << ld) - 1)) << (13 - ld)) + (tk >> ld);
                    rowp = O + ((((size_t)(b * 3 + g) * 2 + kv) * 8 + h0) * 8192 + pos) * 128 + wc * 32 + 8 * fq; bjs = (size_t)8192 * 128; }
#pragma unroll
                for (int bj = 0; bj < 2; ++bj) { const f32x4 v0 = acc[ai][bj][m][0] * rs, v1 = acc[ai][bj][m][1] * rs;
                    u32x4 w; w.x = cvt_pk_bf16(v0[0], v0[1]); w.y = cvt_pk_bf16(v0[2], v0[3]); w.z = cvt_pk_bf16(v1[0], v1[1]); w.w = cvt_pk_bf16(v1[2], v1[3]);
                    *(gu32x4*)(rowp + bj * bjs) = w;
                    if (do_n) { float ss = (v0[0] * v0[0] + v0[1] * v0[1]) + (v0[2] * v0[2] + v0[3] * v0[3]) + (v1[0] * v1[0] + v1[1] * v1[1]) + (v1[2] * v1[2] + v1[3] * v1[3]);
                        ss = xr_sum<16>(ss); ss = xr_sum<32>(ss); mx[ai][bj] = fmaxf(mx[ai][bj], ss); } } }
        if (do_n) {
#pragma unroll
            for (int ai = 0; ai < 2; ++ai)
#pragma unroll
                for (int bj = 0; bj < 2; ++bj) { float v = mx[ai][bj]; v = xr_max<1>(v); v = xr_max<2>(v); v = xr_max<4>(v); v = xr_max<8>(v);
                    if (fr == 0 && fq == 0) { const int b = u.pm >> 5, blk = ((u.pm & 31) << 1) + ai, head = (colt >> 6) + 2 * bj + (wc >> 1);
                        __hip_atomic_fetch_max(nrm + ((((size_t)(t * 8 + b) * 16 + head) * 64 + blk) * 2 + (wc & 1)), __float_as_uint(v), __ATOMIC_RELAXED, __HIP_MEMORY_SCOPE_AGENT); } }
        }
    }
};
constexpr size_t FIN_BSTRIDE = (size_t)8192 * 6144 * 2 / 4;
struct EpiResid {
    static constexpr bool PERM = true, AFTER_DRAIN = false;
    bf16_t* phi; bf16_t* plo; float* fin; float* rowss; int ldc; int dry; const float* xbase;
    template <bool FIN, bool XB> __device__ __forceinline__ void body(const f32x4 (&acc)[2][2][4][2], const Unit& u, int wr, int wc, int fr, int fq) const {
        typedef __attribute__((address_space(1))) u32x4 gu4; typedef __attribute__((address_space(1))) f32x4 gf4; typedef __attribute__((address_space(1))) const f32x4 gcf4;
        const int col0 = u.pn * BM + wc * 32 + 8 * fq, rbase = u.pm * BM + wr * 64 + fr;
        u32x4 H[2][2]; f32x4 X0[2][2], X1[2][2];
#define PG8_LOADG(g, b) do { const size_t off_ = (size_t)(rbase + ((g) >> 2) * HALF + ((g) & 3) * 16) * ldc + col0; \
        _Pragma("unroll") for (int bj = 0; bj < 2; ++bj) { const size_t o8_ = off_ + bj * HALF; if (XB) { X0[b][bj] = *(gcf4*)(xbase + o8_); X1[b][bj] = *(gcf4*)(xbase + o8_ + 4); } else H[b][bj] = *(const gu4*)(phi + o8_); } } while (0)
        PG8_LOADG(0, 0);
#pragma unroll
        for (int g = 0; g < 8; ++g) { const int ai = g >> 2, m = g & 3, cb = g & 1;
            if (g < 7) PG8_LOADG(g + 1, cb ^ 1);
            const int r = rbase + ai * HALF + m * 16; const size_t off = (size_t)r * ldc + col0; float s = 0.f;
            float* frow = FIN ? fin + (size_t)(r >> 13) * FIN_BSTRIDE + (size_t)(r & 8191) * 1024 + col0 : nullptr;
#pragma unroll
            for (int bj = 0; bj < 2; ++bj) { f32x4 o0, o1;
                if (XB) { o0 = X0[cb][bj]; o1 = X1[cb][bj]; }
                else { const u32x4 h = H[cb][bj]; o0[0] = __uint_as_float(h.x << 16); o0[1] = __uint_as_float(h.x & 0xffff0000u); o0[2] = __uint_as_float(h.y << 16); o0[3] = __uint_as_float(h.y & 0xffff0000u);
                    o1[0] = __uint_as_float(h.z << 16); o1[1] = __uint_as_float(h.z & 0xffff0000u); o1[2] = __uint_as_float(h.w << 16); o1[3] = __uint_as_float(h.w & 0xffff0000u); }
                o0 = o0 + acc[ai][bj][m][0]; o1 = o1 + acc[ai][bj][m][1];
                s += ((o0[0] * o0[0] + o0[1] * o0[1]) + (o0[2] * o0[2] + o0[3] * o0[3])) + ((o1[0] * o1[0] + o1[1] * o1[1]) + (o1[2] * o1[2] + o1[3] * o1[3]));
                if (FIN) { *(gf4*)(frow + bj * HALF) = o0; *(gf4*)(frow + bj * HALF + 4) = o1; }
                else { u32x4 nh; nh.x = cvt_pk_bf16(o0[0], o0[1]); nh.y = cvt_pk_bf16(o0[2], o0[3]); nh.z = cvt_pk_bf16(o1[0], o1[1]); nh.w = cvt_pk_bf16(o1[2], o1[3]); *(gu4*)(phi + off + bj * HALF) = nh; } }
            s = xr_sum<16>(s); s = xr_sum<32>(s);
            if (rowss && fq == 0) __hip_atomic_fetch_add(rowss + r, s, __ATOMIC_RELAXED, __HIP_MEMORY_SCOPE_AGENT);
        }
#undef PG8_LOADG
    }
    __device__ __forceinline__ void operator()(const f32x4 (&acc)[2][2][4][2], const Unit& u, int wr, int wc, int fr, int fq) const {
        if (dry) { f32x4 t = acc[0][0][0][0];
#pragma unroll
            for (int a = 0; a < 2; ++a)
#pragma unroll
                for (int b = 0; b < 2; ++b)
#pragma unroll
                    for (int m = 0; m < 4; ++m)
#pragma unroll
                        for (int n = 0; n < 2; ++n) t += acc[a][b][m][n];
            if (t[0] + t[1] + t[2] + t[3] == 1.2345e30f) phi[0] = 0; return; }
        if (fin) body<true, false>(acc, u, wr, wc, fr, fq); else if (xbase) body<false, true>(acc, u, wr, wc, fr, fq); else body<false, false>(acc, u, wr, wc, fr, fq);
    }
};

template <class Epi, class Sched, bool ALIGN_EPI = false, bool SP2 = false>
__device__ __forceinline__ void gemm_phase(PG8_LAS unsigned char* lds, const Gemm g, const Sched& S, const Epi& E, const int tid_in) {
    const int tid = tid_in, wid = __builtin_amdgcn_readfirstlane(tid >> 6), lane = tid & 63, wr = wid >> 2, wc = wid & 3, fr = lane & 15, fq = lane >> 4;
    const int K = g.K, nt = K / BK;
    unsigned voffA[2], voffB[2];
#pragma unroll
    for (int i = 0; i < 2; ++i) { int R, C; stage_rc(tid * 16 + i * 8192, R, C); const int Rb = Epi::PERM ? ((R & ~31) + perm32(R & 31)) : R;
        voffA[i] = (unsigned)(R * g.lda + C) * 2u; voffB[i] = (unsigned)(Rb * K + C) * 2u; }
    const size_t kstep = (size_t)(BK * 2);
    const size_t hstepA = (size_t)HALF * g.lda * 2, hstepB = (size_t)HALF * K * 2;
    const size_t tstepA = 2 * hstepA, tstepB = 2 * hstepB;
    const unsigned ldsw = (unsigned)wid * 1024u;
    const int aoff = lds_byte(wr * 64 + fr, fq * 8), boff = lds_byte(wc * 32 + fr, fq * 8);
#define PG8_SA(b, h) (((b) * 2 + (h)) * HTB)
#define PG8_SB(b, h) ((4 + (b) * 2 + (h)) * HTB)
#define PG8_STAGE(bufoff, gbase, voff) do { _Pragma("unroll") for (int _i = 0; _i < 2; ++_i) \
        __builtin_amdgcn_global_load_lds((const unsigned*)((const char*)(gbase) + (voff)[_i]), (PG8_LAS unsigned*)(lds + (bufoff) + ldsw + _i * 8192), 16, 0, 0); } while (0)
#define PG8_LDA(dst, b, h) do { _Pragma("unroll") for (int m = 0; m < 4; ++m) _Pragma("unroll") for (int k = 0; k < 2; ++k) dst[m][k] = *(const PG8_LAS bf16x8*)(lds + PG8_SA(b, h) + aoff + m * 2048 + k * 1024); } while (0)
#define PG8_LDB(dst, b, h) do { _Pragma("unroll") for (int n = 0; n < 2; ++n) _Pragma("unroll") for (int k = 0; k < 2; ++k) dst[n][k] = *(const PG8_LAS bf16x8*)(lds + PG8_SB(b, h) + boff + n * 2048 + k * 1024); } while (0)
#define PG8_MMA(ai, bj, At, Bt) do { __builtin_amdgcn_s_setprio(1); _Pragma("unroll") for (int m = 0; m < 4; ++m) _Pragma("unroll") for (int n = 0; n < 2; ++n) _Pragma("unroll") for (int k = 0; k < 2; ++k) \
        acc[ai][bj][m][n] = __builtin_amdgcn_mfma_f32_16x16x32_bf16(Bt[n][k], At[m][k], acc[ai][bj][m][n], 0, 0, 0); __builtin_amdgcn_s_setprio(0); } while (0)
#define PG8_WAIT_V(n) asm volatile("s_waitcnt vmcnt(" #n ")" ::: "memory")
#define PG8_WAIT_L(n) asm volatile("s_waitcnt lgkmcnt(" #n ")" ::: "memory")
#define PG8_BAR __builtin_amdgcn_s_barrier()
#define PG8_SCHED __builtin_amdgcn_sched_barrier(0)
    Unit cur, nxt; int ui = 0;
    if (!S.next(0, cur)) return;
    f32x4 acc[2][2][4][2];
#pragma unroll
    for (int a = 0; a < 2; ++a)
#pragma unroll
        for (int b = 0; b < 2; ++b)
#pragma unroll
            for (int m = 0; m < 4; ++m)
#pragma unroll
                for (int n = 0; n < 2; ++n) acc[a][b][m][n] = (f32x4){0.f, 0.f, 0.f, 0.f};
    bf16x8 At[4][2], B0[2][2], B1[2][2];
    const char* cA = (const char*)g.A + (size_t)cur.pm * tstepA; const char* cB = (const char*)g.Bt + (size_t)cur.pn * tstepB;
    S.a_ready(cur);
    if constexpr (SP2) {
        PG8_STAGE(PG8_SB(0, 0), cB, voffB); PG8_STAGE(PG8_SB(0, 1), cB + hstepB, voffB); PG8_STAGE(PG8_SA(0, 0), cA, voffA); PG8_STAGE(PG8_SA(0, 1), cA + hstepA, voffA);
        if (wr == 1) PG8_BAR;
        PG8_WAIT_V(2); PG8_BAR;
        PG8_STAGE(PG8_SB(1, 0), cB + kstep, voffB); PG8_STAGE(PG8_SA(1, 0), cA + kstep, voffA); PG8_STAGE(PG8_SB(1, 1), cB + hstepB + kstep, voffB);
        PG8_WAIT_V(6); PG8_BAR;
    } else {
        PG8_STAGE(PG8_SB(0, 0), cB, voffB); PG8_STAGE(PG8_SA(0, 0), cA, voffA); PG8_STAGE(PG8_SB(0, 1), cB + hstepB, voffB); PG8_STAGE(PG8_SA(0, 1), cA + hstepA, voffA);
        if (wr == 1) PG8_BAR;
        PG8_WAIT_V(4); PG8_BAR;
        PG8_STAGE(PG8_SB(1, 0), cB + kstep, voffB); PG8_STAGE(PG8_SA(1, 0), cA + kstep, voffA); PG8_STAGE(PG8_SB(1, 1), cB + hstepB + kstep, voffB);
        PG8_WAIT_V(6); PG8_BAR;
    }
    for (;;) {
        const bool has_next = S.next(ui + 1, nxt);
        const char* nA = has_next ? (const char*)g.A + (size_t)nxt.pm * tstepA : cA; const char* nB = has_next ? (const char*)g.Bt + (size_t)nxt.pn * tstepB : cB;
        for (int t = 0; t < nt; t += 2) {
            const bool last = (t == nt - 2);
            const char* a1 = cA + (size_t)(t + 1) * kstep;
            const char* a2 = last ? nA : cA + (size_t)(t + 2) * kstep; const char* b2 = last ? nB : cB + (size_t)(t + 2) * kstep;
            const char* a3 = a2 + kstep; const char* b3 = b2 + kstep;
            if (last && has_next) S.a_ready(nxt);
            if constexpr (SP2) {
            PG8_LDB(B0, 0, 0); PG8_LDB(B1, 0, 1); PG8_SCHED; PG8_LDA(At, 0, 0); PG8_STAGE(PG8_SA(1, 1), a1 + hstepA, voffA);
            PG8_WAIT_V(8); PG8_WAIT_L(0); PG8_BAR; PG8_MMA(0, 0, At, B0); PG8_MMA(0, 1, At, B1); PG8_BAR; PG8_SCHED;
            PG8_LDA(At, 0, 1); PG8_STAGE(PG8_SB(0, 0), b2, voffB); PG8_STAGE(PG8_SB(0, 1), b2 + hstepB, voffB); PG8_STAGE(PG8_SA(0, 0), a2, voffA);
            PG8_WAIT_V(8); PG8_WAIT_L(0); PG8_BAR; PG8_MMA(1, 0, At, B0); PG8_MMA(1, 1, At, B1); PG8_BAR; PG8_SCHED;
            PG8_LDB(B0, 1, 0); PG8_LDB(B1, 1, 1); PG8_SCHED; PG8_LDA(At, 1, 0); PG8_STAGE(PG8_SA(0, 1), a2 + hstepA, voffA);
            PG8_WAIT_V(8); PG8_WAIT_L(0); PG8_BAR; PG8_MMA(0, 0, At, B0); PG8_MMA(0, 1, At, B1); PG8_BAR; PG8_SCHED;
            PG8_LDA(At, 1, 1); PG8_STAGE(PG8_SB(1, 0), b3, voffB); PG8_STAGE(PG8_SB(1, 1), b3 + hstepB, voffB); PG8_STAGE(PG8_SA(1, 0), a3, voffA);
            PG8_WAIT_V(8); PG8_WAIT_L(0); PG8_BAR; PG8_MMA(1, 0, At, B0); PG8_MMA(1, 1, At, B1); PG8_BAR; PG8_SCHED;
            } else {
            PG8_LDB(B0, 0, 0); PG8_SCHED; PG8_LDA(At, 0, 0); PG8_STAGE(PG8_SA(1, 1), a1 + hstepA, voffA);
            PG8_WAIT_L(8); PG8_BAR; PG8_WAIT_L(0); PG8_MMA(0, 0, At, B0); PG8_BAR; PG8_SCHED;
            PG8_LDB(B1, 0, 1); PG8_STAGE(PG8_SB(0, 0), b2, voffB);
            PG8_BAR; PG8_WAIT_L(0); PG8_MMA(0, 1, At, B1); PG8_BAR;
            PG8_LDA(At, 0, 1); PG8_STAGE(PG8_SA(0, 0), a2, voffA);
            PG8_BAR; PG8_WAIT_L(0); PG8_MMA(1, 0, At, B0); PG8_BAR; PG8_SCHED;
            PG8_STAGE(PG8_SB(0, 1), b2 + hstepB, voffB);
            PG8_WAIT_V(6); PG8_BAR; PG8_MMA(1, 1, At, B1); PG8_BAR;
            PG8_LDB(B0, 1, 0); PG8_SCHED; PG8_LDA(At, 1, 0); PG8_STAGE(PG8_SA(0, 1), a2 + hstepA, voffA);
            PG8_WAIT_L(8); PG8_BAR; PG8_WAIT_L(0); PG8_MMA(0, 0, At, B0); PG8_BAR; PG8_SCHED;
            PG8_LDB(B1, 1, 1); PG8_STAGE(PG8_SB(1, 0), b3, voffB);
            PG8_BAR; PG8_WAIT_L(0); PG8_MMA(0, 1, At, B1); PG8_BAR;
            PG8_LDA(At, 1, 1); PG8_STAGE(PG8_SA(1, 0), a3, voffA);
            PG8_BAR; PG8_WAIT_L(0); PG8_MMA(1, 0, At, B0); PG8_BAR; PG8_SCHED;
            PG8_STAGE(PG8_SB(1, 1), b3 + hstepB, voffB);
            PG8_WAIT_V(6); PG8_BAR; PG8_MMA(1, 1, At, B1); PG8_BAR;
            }
        }
        if constexpr (ALIGN_EPI) { if (wr == 0) PG8_BAR; }
        if constexpr (!Epi::AFTER_DRAIN) { E(acc, cur, wr, wc, fr, fq); S.done(cur); }
        if (!has_next) break;
#pragma unroll
        for (int a = 0; a < 2; ++a)
#pragma unroll
            for (int b = 0; b < 2; ++b)
#pragma unroll
                for (int m = 0; m < 4; ++m)
#pragma unroll
                    for (int n = 0; n < 2; ++n) acc[a][b][m][n] = (f32x4){0.f, 0.f, 0.f, 0.f};
        cur = nxt; cA = nA; cB = nB; ++ui;
        if constexpr (ALIGN_EPI) { if (wr == 1) PG8_BAR; }
    }
    PG8_WAIT_V(0);
    if constexpr (!ALIGN_EPI) { if (wr == 0) PG8_BAR; }
    PG8_BAR;
    if constexpr (Epi::AFTER_DRAIN) { E.fused(acc, cur, wr, wc, fr, fq, lds, wid, lane); S.done(cur); }
#undef PG8_SA
#undef PG8_SB
#undef PG8_STAGE
#undef PG8_LDA
#undef PG8_LDB
#undef PG8_MMA
#undef PG8_WAIT_V
#undef PG8_WAIT_L
#undef PG8_BAR
#undef PG8_SCHED
}
}
namespace attn_body {
using bf16=__hip_bfloat16;
using bf16x8=__attribute__((ext_vector_type(8)))short;
using s16x4=__attribute__((ext_vector_type(4)))short;
using f32x16=__attribute__((ext_vector_type(16)))float;
using u32x4=__attribute__((ext_vector_type(4)))unsigned;
constexpr int BATCH=8,NHEAD=16,SEQ=8192,D=64,DM=NHEAD*D;
constexpr int NW=8,QBLK=32,QB=QBLK*NW,KVBLK=64,NQB=SEQ/QB;
constexpr int ATTN_PITCH=DM, ATTN_UNIT_ROWS=QB;
__device__ __forceinline__ int crow(int r,int hi){return (r&3)+8*(r>>2)+4*hi;}
#define SBAR() __builtin_amdgcn_sched_barrier(0)
__device__ __forceinline__ void cmask(f32x16&p0,f32x16&p1,int jb,int qrel,int hi){
  const float NEG=-INFINITY; int kb=64*jb+4*hi;
  #pragma unroll
  for(int r=0;r<16;++r){int kv=kb+(r&3)+8*(r>>2); if(kv>qrel)p0[r]=NEG; if(kv+32>qrel)p1[r]=NEG;}
}

constexpr int NSLOT=3, SLOTB=8192;
constexpr int LDS_K=0, LDS_V=NSLOT*SLOTB, LDS_WS=2*NSLOT*SLOTB, LDS_OST=LDS_WS+NW*64*4, LDS_BYTES=LDS_OST+NW*4096;
constexpr int LDS_C2=LDS_BYTES, LDS_REL=LDS_C2+SEQ*4;
constexpr float C2=0.125f*1.4426950408889634f;
__device__ __forceinline__ void glds16(const void*gsrc,unsigned lds_dst){unsigned keep;
  asm volatile("s_mov_b32 %0, m0\n\ts_mov_b32 m0, %2\n\ts_nop 0\n\tglobal_load_lds_dwordx4 %1, off\n\ts_mov_b32 m0, %0":"=&s"(keep):"v"(gsrc),"s"(lds_dst):"memory");}
__device__ __forceinline__ void glds16s(const void*sbase,unsigned voff,unsigned lds_dst){unsigned keep;
  asm volatile("s_mov_b32 %0, m0\n\ts_mov_b32 m0, %3\n\ts_nop 0\n\tglobal_load_lds_dwordx4 %1, %2\n\ts_mov_b32 m0, %0":"=&s"(keep):"v"(voff),"s"(sbase),"s"(lds_dst):"memory");}
__device__ __forceinline__ float max3f(float a,float b,float c){float r;asm("v_max3_f32 %0, %1, %2, %3":"=v"(r):"v"(a),"v"(b),"v"(c));return r;}
__device__ __forceinline__ float max2f(float a,float b){float r;asm("v_max_f32_e32 %0, %1, %2":"=v"(r):"v"(a),"v"(b));return r;}
__device__ __forceinline__ float fadd_s(float a,float b){float r;asm("v_add_f32_e32 %0, %1, %2":"=v"(r):"v"(a),"v"(b));return r;}
__device__ __forceinline__ float fsub_s(float a,float b){float r;asm("v_sub_f32_e32 %0, %1, %2":"=v"(r):"v"(a),"v"(b));return r;}
typedef float f32x2_t __attribute__((ext_vector_type(2))); typedef __bf16 bf16x2_t __attribute__((ext_vector_type(2)));
__device__ __forceinline__ unsigned cvtpk_s(float lo,float hi){f32x2_t v={lo,hi};bf16x2_t b=__builtin_convertvector(v,bf16x2_t);return __builtin_bit_cast(unsigned,b);}
#define WAIT_BAR(N) asm volatile("s_waitcnt vmcnt(" #N ") lgkmcnt(0)\n\ts_barrier":::"memory")

__device__ __forceinline__ void qkt(f32x16&p0,f32x16&p1,const char*Kslot,const bf16x8*qr,int r32,int hi){
  const char*kb=Kslot+hi*1024+r32*16;
  #pragma unroll
  for(int d0=0;d0<4;++d0){
    const bf16x8 b0=*reinterpret_cast<const bf16x8*>(kb+d0*2048);
    const bf16x8 b1=*reinterpret_cast<const bf16x8*>(kb+d0*2048+512);
    {p0=__builtin_amdgcn_mfma_f32_32x32x16_bf16(b0,qr[d0],p0,0,0,0);p1=__builtin_amdgcn_mfma_f32_32x32x16_bf16(b1,qr[d0],p1,0,0,0);}}
}
typedef __attribute__((address_space(3))) const char* lds_cptr;
typedef short v4i16_t __attribute__((ext_vector_type(4)));
__device__ __forceinline__ void kload8(bf16x8*kf,lds_cptr kp){
  kf[0]=*(const __attribute__((address_space(3))) bf16x8*)(kp);      kf[1]=*(const __attribute__((address_space(3))) bf16x8*)(kp+512);
  kf[2]=*(const __attribute__((address_space(3))) bf16x8*)(kp+2048); kf[3]=*(const __attribute__((address_space(3))) bf16x8*)(kp+2560);
  kf[4]=*(const __attribute__((address_space(3))) bf16x8*)(kp+4096); kf[5]=*(const __attribute__((address_space(3))) bf16x8*)(kp+4608);
  kf[6]=*(const __attribute__((address_space(3))) bf16x8*)(kp+6144); kf[7]=*(const __attribute__((address_space(3))) bf16x8*)(kp+6656);
}
__device__ __forceinline__ void kload2(bf16x8*kf,lds_cptr kp,int j){ kf[2*j]=*(const __attribute__((address_space(3))) bf16x8*)(kp+j*2048); kf[2*j+1]=*(const __attribute__((address_space(3))) bf16x8*)(kp+j*2048+512); }
__device__ __forceinline__ s16x4 vtr(lds_cptr p){ return __builtin_bit_cast(s16x4,__builtin_amdgcn_ds_read_tr16_b64_v4i16((__attribute__((address_space(3))) v4i16_t*)p)); }
__device__ __forceinline__ float rowmax(const f32x16&p0,const f32x16&p1){
  float a=max3f(p0[0],p0[1],p1[0]),b=max3f(p0[2],p0[3],p1[1]);a=max3f(a,p1[2],p1[3]);
  #pragma unroll
  for(int r=4;r<16;r+=4){a=max3f(a,p0[r],p0[r+1]);b=max3f(b,p0[r+2],p0[r+3]);a=max3f(a,p1[r],p1[r+1]);b=max3f(b,p1[r+2],p1[r+3]);}
  const float m=max2f(a,b);
  auto rr=__builtin_amdgcn_permlane32_swap(__float_as_uint(m),__float_as_uint(m),false,false);
  return max2f(__uint_as_float(rr[0]),__uint_as_float(rr[1]));
}
__device__ __forceinline__ void pv(f32x16*o,int vb,bf16x8 pa0,bf16x8 pa1,bf16x8 pa2,bf16x8 pa3){
  #pragma unroll
  for(int d0=0;d0<2;++d0){s16x4 lo[4],hi[4];
    #pragma unroll
    for(int ks=0;ks<4;++ks){
      asm volatile("ds_read_b64_tr_b16 %0,%1 offset:%c2":"=&v"(lo[ks]):"v"(vb),"i"(d0*4096+ks*1024):"memory");
      asm volatile("ds_read_b64_tr_b16 %0,%1 offset:%c2":"=&v"(hi[ks]):"v"(vb),"i"(d0*4096+ks*1024+512):"memory");}
    asm volatile("s_waitcnt lgkmcnt(0)":::"memory");SBAR();
    #define PK(k) (bf16x8){lo[k][0],lo[k][1],lo[k][2],lo[k][3],hi[k][0],hi[k][1],hi[k][2],hi[k][3]}
    o[d0]=__builtin_amdgcn_mfma_f32_32x32x16_bf16(pa0,PK(0),o[d0],0,0,0);
    o[d0]=__builtin_amdgcn_mfma_f32_32x32x16_bf16(pa1,PK(1),o[d0],0,0,0);
    o[d0]=__builtin_amdgcn_mfma_f32_32x32x16_bf16(pa2,PK(2),o[d0],0,0,0);
    o[d0]=__builtin_amdgcn_mfma_f32_32x32x16_bf16(pa3,PK(3),o[d0],0,0,0);
    #undef PK
  }
}

#ifndef ATTN_STORE16
#define ATTN_STORE16(p,v) (*(u32x4*)(p)=(v))
#endif
typedef float f32x4_t __attribute__((ext_vector_type(4)));
__device__ __forceinline__ unsigned split2(float v,float&eff){ unsigned w=cvtpk_s(v,0.f); const float h=__uint_as_float(w<<16); w=cvtpk_s(v,fsub_s(v,h)); eff=fadd_s(h,__uint_as_float(w&0xffff0000u)); return w; }
template<int THRL> __device__ __forceinline__ void attn_unit(int b,int h,int qb,const bf16*Q,const bf16*__restrict__ K,const bf16*__restrict__ V,bf16*O,const bf16*__restrict__ Gt,const float*__restrict__ CL,const float*__restrict__ TOT,const float*__restrict__ NRM,char*shm,const int tid_in,unsigned*qown,const unsigned qbase){
  const int tid=tid_in,lane=tid&63,r32=lane&31,hi=lane>>5; const int wid=__builtin_amdgcn_readfirstlane(tid>>6);
  const long rowbase=(long)b*SEQ; const int q0=qb*QB;
  const bf16*Qw=Q+(rowbase+q0+wid*QBLK)*DM+h*D;
  const bf16*Kh=K+rowbase*DM+h*D,*Vh=V+rowbase*DM+h*D;
  const lds_cptr shm3=(lds_cptr)shm;
  const unsigned lds0=(unsigned)(uintptr_t)shm;
  float*wsf=(float*)(shm+LDS_WS)+wid*64;
  const unsigned koff=(unsigned)((lane*DM+wid*8)*2);
  const unsigned voff=(unsigned)(((16*(wid&3)+(lane>>2))*DM+(wid>>2)*32+(lane&3)*8)*2);
  const unsigned kdst=lds0+LDS_K+wid*1024, vdst=lds0+LDS_V+wid*1024;
  #define DMA_K(t,slot) glds16s(Kh+(long)(t)*KVBLK*DM,koff,(unsigned)__builtin_amdgcn_readfirstlane(kdst+(slot)))
  #define DMA_V(t,slot) glds16s(Vh+(long)(t)*KVBLK*DM,voff,(unsigned)__builtin_amdgcn_readfirstlane(vdst+(slot)))
  const char*Kbase=shm+LDS_K; bf16x8 kf[8];
  const lds_cptr kp0=shm3+LDS_K+hi*1024+r32*16; const lds_cptr vp0=shm3+LDS_V+((lane>>4)&1)*32+(lane&3)*8+(4*hi+((lane&15)>>2))*64;
  bf16x8 qr[4];
  #pragma unroll
  for(int d0=0;d0<4;++d0)qr[d0]=*reinterpret_cast<const bf16x8*>(&Qw[(long)r32*DM+d0*16+hi*8]);
  float cq2; int t_start;
  { typedef __attribute__((address_space(3))) float lf32; lf32*relL=(lf32*)(shm3+LDS_REL); __attribute__((address_space(3))) unsigned*c2P=(__attribute__((address_space(3))) unsigned*)(shm3+LDS_C2);
    float tv=0.f,nk0=0.f,nk1=0.f,nq0=0.f,nq1=0.f,nq2=0.f,nq3=0.f;
    const float cqraw=CL[(long)(b*NHEAD+h)*SEQ+q0+wid*QBLK+r32];
    if(wid==0){ tv=TOT[(b*NHEAD+h)*64+lane]; const float*nq=NRM+(long)((0*BATCH+b)*NHEAD+h)*128,*nk=NRM+(long)((1*BATCH+b)*NHEAD+h)*128; nk0=nk[2*lane]; nk1=nk[2*lane+1]; nq0=nq[4*qb]; nq1=nq[4*qb+1]; nq2=nq[4*qb+2]; nq3=nq[4*qb+3]; }
    { const bf16*Kd=K+(rowbase+q0+wid*QBLK+r32)*DM+h*D+hi*8; float dot=0.f; bf16x8 kd[4];
      #pragma unroll
      for(int d0=0;d0<4;++d0)kd[d0]=*reinterpret_cast<const bf16x8*>(Kd+d0*16);
      asm volatile("":"+v"(kd[0]),"+v"(kd[1]),"+v"(kd[2]),"+v"(kd[3]));
      #pragma unroll
      for(int d0=0;d0<4;++d0){
        #pragma unroll
        for(int e=0;e<8;++e)dot+=__uint_as_float((unsigned)(unsigned short)qr[d0][e]<<16)*__uint_as_float((unsigned)(unsigned short)kd[d0][e]<<16); }
      dot=xr_sum<32>(dot);
      dot=xr_min<16>(dot); dot=xr_min<8>(dot); dot=xr_min<4>(dot); dot=xr_min<2>(dot); dot=xr_min<1>(dot);
      if(lane==0)relL[66+wid]=dot; }
    __syncthreads();
    if(wid==0){ float inc=tv;
      _Pragma("unroll") for(int o_=1;o_<64;o_<<=1){ const float y_=xl_from_lane(inc,lane-o_); if(lane>=o_)inc+=y_; }
      const float exc=inc-tv; const float eref=__builtin_bit_cast(float,__builtin_amdgcn_readlane(__builtin_bit_cast(int,exc),2*qb)); relL[lane]=exc-eref;
      const float bk2=nk0+nk1; const float bq2=__builtin_fmaxf(nq0+nq1,nq2+nq3);
      float smin=relL[66]; _Pragma("unroll") for(int w_=1;w_<NW;++w_)smin=__builtin_fminf(smin,relL[66+w_]);
      const float Bj=sqrtf(bq2*bk2)*1.02f,Dj=(inc-eref)*1.4426950408889634f;
      const bool keep=(lane>=2*qb)||!(Dj>=Bj-smin+30.5f);
      const unsigned long long km=__ballot(keep); const int bs_=__ffsll((long long)km)-1; if(lane==0)((__attribute__((address_space(3))) int*)relL)[64]=bs_; }
    __syncthreads();
    const int bs=__builtin_amdgcn_readfirstlane(((__attribute__((address_space(3))) int*)relL)[64]); t_start=2*bs;
    const int NTl=(q0+QB)/KVBLK-t_start;
    const float*clp=CL+(long)(b*NHEAD+h)*SEQ;
    { f32x4_t cv_[4];
      #pragma unroll
      for(int k_=0;k_<4;++k_){ const int i_=tid+k_*NW*64; cv_[k_]=*(const f32x4_t*)(clp+128*bs+4*(i_<NTl*16?i_:tid)); }
      asm volatile("":"+v"(cv_[0]),"+v"(cv_[1]),"+v"(cv_[2]),"+v"(cv_[3]));
      #pragma unroll
      for(int k_=0;k_<4;++k_){ const int i_=tid+k_*NW*64; if(i_<NTl*16){ const f32x4_t v_=cv_[k_]; const float rl_=relL[bs+(i_>>5)]; float e_;
        u32x4 w_; w_.x=split2((v_.x+rl_)*-1.4426950408889634f,e_); w_.y=split2((v_.y+rl_)*-1.4426950408889634f,e_); w_.z=split2((v_.z+rl_)*-1.4426950408889634f,e_); w_.w=split2((v_.w+rl_)*-1.4426950408889634f,e_);
        *(__attribute__((address_space(3))) u32x4*)(c2P+4*i_)=w_; } } }
    cq2=(cqraw+relL[2*qb+(wid>>2)])*1.4426950408889634f;
    __syncthreads(); }
  Kh+=(long)t_start*KVBLK*DM; Vh+=(long)t_start*KVBLK*DM;
  const int NT=(q0+QB)/KVBLK-t_start;
  const __attribute__((address_space(3))) unsigned* c2f=(const __attribute__((address_space(3))) unsigned*)(shm3+LDS_C2)+r32;
  unsigned qxw;
  #define QX() __builtin_bit_cast(bf16x8,(u32x4){hi?0u:0x3f803f80u,hi?0u:qxw,0u,0u})
  #define KEXT(KX0,KX1,t) do{ const unsigned wa_=c2f[(t)*64], wb_=c2f[(t)*64+32]; KX0=__builtin_bit_cast(bf16x8,(u32x4){wa_,0x3f803f80u,0u,0u}); KX1=__builtin_bit_cast(bf16x8,(u32x4){wb_,0x3f803f80u,0u,0u}); }while(0)
  DMA_K(0,0);DMA_V(0,0);DMA_K(1,SLOTB);
  float mhat,l_reg=0.f;f32x16 o[2];o[0]=f32x16{};o[1]=f32x16{}; { float e_; qxw=split2(cq2,e_); mhat=-e_; } const f32x16 zero16=f32x16{};
  const int qrel=wid*QBLK+r32;
  #define CMASK(P0,P1,t) do{int jb_=(t)-(NT-4); if(jb_>=0)cmask(P0,P1,jb_,qrel,hi);}while(0)
  bool resc=false;
  #define START(P0,P1) do{ const float rm=rowmax(P0,P1); resc=false; \
    { float e_; qxw=split2(-fadd_s(mhat,rm),e_); const float dl=fsub_s(-e_,mhat); mhat=-e_; \
      _Pragma("unroll") for(int r=0;r<16;++r){P0[r]=fsub_s(P0[r],dl);P1[r]=fsub_s(P1[r],dl);} } \
    _Pragma("unroll") for(int r=0;r<16;++r)P0[r]=__builtin_amdgcn_exp2f(P0[r]); }while(0)
  #define RESC() do{ if(resc){ asm volatile("s_waitcnt lgkmcnt(0)":::"memory"); \
      _Pragma("unroll") for(int d_=0;d_<2;++d_) _Pragma("unroll") for(int r=0;r<16;++r)o[d_][r]*=wsf[crow(r,hi)]; } }while(0)
  f32x16 pA0,pA1,pB0,pB1;
  int sl_prev=0,sl_cur=0,sl_next=SLOTB;
  #define ROT() do{sl_prev=sl_cur;sl_cur=sl_next;sl_next=(sl_next==(NSLOT-1)*SLOTB)?0:sl_next+SLOTB;}while(0)
  DMA_K(2,2*SLOTB);
  WAIT_BAR(3);
  { bf16x8 kx0_,kx1_; KEXT(kx0_,kx1_,0); const bf16x8 qx_=QX(); pA0=__builtin_amdgcn_mfma_f32_32x32x16_bf16(kx0_,qx_,zero16,0,0,0); pA1=__builtin_amdgcn_mfma_f32_32x32x16_bf16(kx1_,qx_,zero16,0,0,0); }
  qkt(pA0,pA1,Kbase,qr,r32,hi);asm volatile("s_nop 15\n\ts_nop 7":"+v"(pA0),"+v"(pA1));CMASK(pA0,pA1,0);
  START(pA0,pA1);
  _Pragma("unroll") for(int r=0;r<16;++r)pA1[r]=__builtin_amdgcn_exp2f(pA1[r]);
  WAIT_BAR(0);
  DMA_K(3,0);DMA_V(1,SLOTB);
  ROT();
  kload8(kf,kp0+sl_cur);
  WAIT_BAR(2);
  s16x4 vlo[8],vhi[8]; u32x4 pw0,pw1,pw2,pw3;
  #define PKW(P,B) cvtpk_s(P[B],P[B+1])
  #define PAF(k) __builtin_bit_cast(bf16x8,pw##k)
  #define VFR(i) (bf16x8){vlo[i][0],vlo[i][1],vlo[i][2],vlo[i][3],vhi[i][0],vhi[i][1],vhi[i][2],vhi[i][3]}
  #define PIN(x) asm volatile("":"+v"(x))
  #define MX3(a,b,c) __builtin_fmaxf(__builtin_fmaxf((a),(b)),(c))
  #define GAPA(MF,A0,A1,A2,A3,W0,W1,PW) do{ MF; sacc+=A0; sacc+=A1; sacc+=A2; sacc+=A3; PIN(sacc); W0; W1; PIN(PW); SBAR(); }while(0)
  #define EX(v) __builtin_amdgcn_exp2f(v)
  #define GAPB(MF,X,B) do{ MF; X[B]=EX(X[B]); X[B+1]=EX(X[B+1]); X[B+2]=EX(X[B+2]); X[B+3]=EX(X[B+3]); PIN(X); SBAR(); }while(0)
  #define VRD(i) do{ vlo[i]=vtr(vp_+(((i)>>2)*4096+((i)&3)*1024)); vhi[i]=vtr(vp_+(((i)>>2)*4096+((i)&3)*1024+512)); }while(0)
  #define KRD(G,j) do{ if(G){ kload2(kf,kp0+sl_next,j); SBAR(); } }while(0)
  #define STEP(C0,C1,P0,P1,t,GK,GV,GL) do{ SBAR(); \
    { bf16x8 kx0_,kx1_; KEXT(kx0_,kx1_,t); const bf16x8 qx_=QX(); C0=__builtin_amdgcn_mfma_f32_32x32x16_bf16(kx0_,qx_,zero16,0,0,0); C1=__builtin_amdgcn_mfma_f32_32x32x16_bf16(kx1_,qx_,zero16,0,0,0); } SBAR(); \
    const lds_cptr vp_=vp0+sl_prev; \
    VRD(0); SBAR(); float sacc=(P0[0]+P0[1]); \
    GAPA(C0=__builtin_amdgcn_mfma_f32_32x32x16_bf16(kf[0],qr[0],C0,0,0,0), P0[2],P0[3],P0[4],P0[5],     pw0[0]=PKW(P0,0), pw0[1]=PKW(P0,2), pw0); \
    VRD(4); SBAR(); GAPA(C1=__builtin_amdgcn_mfma_f32_32x32x16_bf16(kf[1],qr[0],C1,0,0,0), P0[6],P0[7],P0[8],P0[9],     pw0[2]=PKW(P0,4), pw0[3]=PKW(P0,6), pw0); \
    VRD(1); SBAR(); GAPA(C0=__builtin_amdgcn_mfma_f32_32x32x16_bf16(kf[2],qr[1],C0,0,0,0),   P0[10],P0[11],P0[12],P0[13], pw1[0]=PKW(P0,8), pw1[1]=PKW(P0,10), pw1); \
    VRD(5); SBAR(); GAPA(C1=__builtin_amdgcn_mfma_f32_32x32x16_bf16(kf[3],qr[1],C1,0,0,0),   P0[14],P0[15],P1[0],P1[1],   pw1[2]=PKW(P0,12),pw1[3]=PKW(P0,14), pw1); \
    VRD(2); SBAR(); GAPA(C0=__builtin_amdgcn_mfma_f32_32x32x16_bf16(kf[4],qr[2],C0,0,0,0),   P1[2],P1[3],P1[4],P1[5],     pw2[0]=PKW(P1,0), pw2[1]=PKW(P1,2), pw2); \
    VRD(6); SBAR(); GAPA(C1=__builtin_amdgcn_mfma_f32_32x32x16_bf16(kf[5],qr[2],C1,0,0,0),   P1[6],P1[7],P1[8],P1[9],     pw2[2]=PKW(P1,4), pw2[3]=PKW(P1,6), pw2); \
    VRD(3); SBAR(); GAPA(C0=__builtin_amdgcn_mfma_f32_32x32x16_bf16(kf[6],qr[3],C0,0,0,0),   P1[10],P1[11],P1[12],P1[13], pw3[0]=PKW(P1,8), pw3[1]=PKW(P1,10), pw3); \
    VRD(7); SBAR(); GAPA(C1=__builtin_amdgcn_mfma_f32_32x32x16_bf16(kf[7],qr[3],C1,0,0,0),   P1[14],P1[15],0.f,0.f,       pw3[2]=PKW(P1,12),pw3[3]=PKW(P1,14), pw3); \
    l_reg+=sacc; \
    if(GK){DMA_K((t)+3,sl_cur);} if(GV){DMA_V((t)+1,sl_next);} \
    CMASK(C0,C1,t); \
    { float a=MX3(C0[0],C0[1],C1[0]),b=MX3(C0[2],C0[3],C1[1]); a=MX3(a,C1[2],C1[3]); \
      _Pragma("unroll") for(int r=4;r<16;r+=4){a=MX3(a,C0[r],C0[r+1]);b=MX3(b,C0[r+2],C0[r+3]);a=MX3(a,C1[r],C1[r+1]);b=MX3(b,C1[r+2],C1[r+3]);} \
      float rm=__builtin_fmaxf(a,b); { auto rr=__builtin_amdgcn_permlane32_swap(__float_as_uint(rm),__float_as_uint(rm),false,false); rm=__builtin_fmaxf(__uint_as_float(rr[0]),__uint_as_float(rr[1])); } \
      resc=false; \
      if(__builtin_expect(__any(rm>(float)THRL),0)){ float e_; qxw=split2(-(mhat+__builtin_fmaxf(rm,0.f)),e_); const float dl=-e_-mhat; mhat=-e_; \
        _Pragma("unroll") for(int r=0;r<16;++r){C0[r]-=dl;C1[r]-=dl;} \
        const float f=__builtin_amdgcn_exp2f(-dl); l_reg*=f; if(hi==0)wsf[r32]=f; resc=true; } } \
    SBAR(); \
    GAPB(o[0]=__builtin_amdgcn_mfma_f32_32x32x16_bf16(PAF(0),VFR(0),o[0],0,0,0), C0,0); \
    GAPB(o[1]=__builtin_amdgcn_mfma_f32_32x32x16_bf16(PAF(0),VFR(4),o[1],0,0,0), C0,4); \
    KRD(GL,0); GAPB(o[0]=__builtin_amdgcn_mfma_f32_32x32x16_bf16(PAF(1),VFR(1),o[0],0,0,0), C0,8); \
    KRD(GL,1); GAPB(o[1]=__builtin_amdgcn_mfma_f32_32x32x16_bf16(PAF(1),VFR(5),o[1],0,0,0), C0,12); \
    KRD(GL,2); GAPB(o[0]=__builtin_amdgcn_mfma_f32_32x32x16_bf16(PAF(2),VFR(2),o[0],0,0,0), C1,0); \
    KRD(GL,3); GAPB(o[1]=__builtin_amdgcn_mfma_f32_32x32x16_bf16(PAF(2),VFR(6),o[1],0,0,0), C1,4); \
    GAPB(o[0]=__builtin_amdgcn_mfma_f32_32x32x16_bf16(PAF(3),VFR(3),o[0],0,0,0), C1,8); \
    GAPB(o[1]=__builtin_amdgcn_mfma_f32_32x32x16_bf16(PAF(3),VFR(7),o[1],0,0,0), C1,12); \
    }while(0)
  int t=1;
  #undef CMASK
  #define CMASK(P0,P1,t) do{}while(0)
  for(;t+5<NT;t+=2){
    STEP(pB0,pB1,pA0,pA1,t,true,true,true);     WAIT_BAR(2); RESC(); ROT();
    STEP(pA0,pA1,pB0,pB1,t+1,true,true,true);   WAIT_BAR(2); RESC(); ROT();
  }
  #undef CMASK
  #define CMASK(P0,P1,t) do{int jb_=(t)-(NT-4); if(jb_>=0)cmask(P0,P1,jb_,qrel,hi);}while(0)
  #define ENDW(tt) do{ if((tt)+3<NT){WAIT_BAR(2);} else if((tt)+2<NT){WAIT_BAR(1);} else {WAIT_BAR(0);} }while(0)
  for(;t+1<NT;t+=2){
    STEP(pB0,pB1,pA0,pA1,t,(t+3<NT),(t+1<NT),(t+1<NT));       ENDW(t);   RESC(); ROT();
    STEP(pA0,pA1,pB0,pB1,t+1,(t+4<NT),(t+2<NT),(t+2<NT));     ENDW(t+1); RESC(); ROT();
  }
  STEP(pB0,pB1,pA0,pA1,NT-1,false,false,false); RESC();
  { float sacc=pB0[0]+pB0[1]; _Pragma("unroll") for(int r=2;r<16;++r)sacc+=pB0[r]; _Pragma("unroll") for(int r=0;r<16;++r)sacc+=pB1[r]; l_reg+=sacc;
    pw0=(u32x4){PKW(pB0,0),PKW(pB0,2),PKW(pB0,4),PKW(pB0,6)};pw1=(u32x4){PKW(pB0,8),PKW(pB0,10),PKW(pB0,12),PKW(pB0,14)};pw2=(u32x4){PKW(pB1,0),PKW(pB1,2),PKW(pB1,4),PKW(pB1,6)};pw3=(u32x4){PKW(pB1,8),PKW(pB1,10),PKW(pB1,12),PKW(pB1,14)};
    const int vb0=(int)(lds0+LDS_V)+((lane>>4)&1)*32+(lane&3)*8+(4*hi+((lane&15)>>2))*64;
    SBAR(); pv(o,vb0+sl_cur,PAF(0),PAF(1),PAF(2),PAF(3)); }
  #undef PKW
  #undef PAF
  #undef VFR
  #undef PIN
  #undef MX3
  #undef GAPA
  #undef GAPB
  #undef EX
  #undef VRD
  #undef KRD
  #undef STEP
  #undef ENDW
  unsigned nxt_=0u; if(tid==0)nxt_=__hip_atomic_fetch_add(qown,1u,__ATOMIC_RELAXED,__HIP_MEMORY_SCOPE_AGENT);
  {auto rr=__builtin_amdgcn_permlane32_swap(__float_as_uint(l_reg),__float_as_uint(l_reg),false,false);l_reg=__uint_as_float(rr[0])+__uint_as_float(rr[1]);}
  if(hi==0)wsf[32+r32]=l_reg;asm volatile("s_waitcnt lgkmcnt(0)":::"memory");
  float rli[16];
  #pragma unroll
  for(int r=0;r<16;++r)rli[r]=__builtin_amdgcn_rcpf(wsf[32+crow(r,hi)]);
  bf16*Ow=O+(rowbase+q0+wid*QBLK)*DM+h*D;
  { bf16*stg=(bf16*)(shm+LDS_OST)+wid*2048;
    #pragma unroll
    for(int r=0;r<16;++r){const int orow=crow(r,hi);
      #pragma unroll
      for(int d0=0;d0<2;++d0)stg[orow*64+d0*32+r32]=__float2bfloat16(o[d0][r]*rli[r]);}
    asm volatile("s_waitcnt lgkmcnt(0)":::"memory");
    int le_=lane; asm volatile("":"+v"(le_));
    #pragma unroll
    for(int i=0;i<4;++i){const int row=i*8+(le_>>3),ch=le_&7; const u32x4 v=*(const u32x4*)(stg+row*64+ch*8); const u32x4 gv=*(const u32x4*)(Gt+(rowbase+q0+wid*QBLK+row)*DM+h*D+ch*8); u32x4 w;
      #pragma unroll
      for(int e=0;e<4;++e){ const float o0=__uint_as_float(v[e]<<16),o1=__uint_as_float(v[e]&0xffff0000u),g0=__uint_as_float(gv[e]<<16),g1=__uint_as_float(gv[e]&0xffff0000u);
        const float s0=g0*__builtin_amdgcn_rcpf(1.f+__builtin_amdgcn_exp2f(-1.4426950408889634f*g0)),s1=g1*__builtin_amdgcn_rcpf(1.f+__builtin_amdgcn_exp2f(-1.4426950408889634f*g1)); w[e]=cvtpk_s(o0*s0,o1*s1); }
      ATTN_STORE16(Ow+(long)row*DM+ch*8,w);} }
  if(tid==0)((__attribute__((address_space(3))) unsigned*)(shm3+LDS_REL))[65]=(nxt_<512u)?(qbase+nxt_):0xfffffffeu;
  asm volatile("s_waitcnt lgkmcnt(0)\n\ts_barrier":::"memory");
  #undef KEXT
  #undef QX
  #undef DMA_K
  #undef DMA_V
  #undef CMASK
  #undef START
  #undef RESC
  #undef ROT
}
constexpr int ATTN_LDS_BYTES=LDS_REL+512;
struct AttnTensors { const bf16* Q; const bf16* K; const bf16* V; bf16* O; const bf16* G; const float* CL; const float* TOT; const float* NRM; };
struct AttnUnit { int bh; int qb; };
struct DynOrder {
  unsigned*qhead; int xcc,wid0; __attribute__((address_space(3))) unsigned*slot;
  __device__ __forceinline__ int fresh_tid()const{ int t; asm volatile("v_mbcnt_lo_u32_b32 %0, -1, 0\n\tv_mbcnt_hi_u32_b32 %0, -1, %0":"=v"(t)); return t+wid0*64; }
  __device__ __forceinline__ bool next(int,AttnUnit&u)const{
    unsigned v=*slot;
    if(v==0xfffffffeu){ __syncthreads();
      if(fresh_tid()==0){ unsigned w=0xffffffffu; for(int k=0;k<8;++k){ const int qx=(xcc+k)&7; const unsigned n=__hip_atomic_fetch_add(qhead+64*qx,1u,__ATOMIC_RELAXED,__HIP_MEMORY_SCOPE_AGENT); if(n<512u){w=(unsigned)qx*512u+n;break;} } *slot=w; }
      __syncthreads(); v=*slot; }
    if(v==0xffffffffu)return false;
    const int qx=(int)(v>>9),n=(int)(v&511u),g=3-(n>>7); u.bh=qx*NHEAD+((n>>3)&15); u.qb=8*g+7-(n&7); return true; }
  __device__ __forceinline__ void a_ready(const AttnUnit&)const{}
  __device__ __forceinline__ void done(const AttnUnit&)const{}
};
template<class Sched,int THRL=8> __device__ __forceinline__ void attn_phase(char*lds,const AttnTensors&T,const Sched&S){
  AttnUnit u;
  for(int i=0;S.next(i,u);++i){ S.a_ready(u); attn_unit<THRL>(u.bh/NHEAD,u.bh%NHEAD,u.qb,T.Q,T.K,T.V,T.O,T.G,T.CL,T.TOT,T.NRM,lds,S.fresh_tid(),S.qhead+64*S.xcc,(unsigned)S.xcc*512u); S.done(u); }
}
#undef SBAR
#undef WAIT_BAR
}
#define GAS __attribute__((address_space(1)))
#define LAS __attribute__((address_space(3)))
typedef unsigned short bf16;
typedef unsigned v4u __attribute__((ext_vector_type(4)));
typedef float f32x4 __attribute__((ext_vector_type(4)));
typedef float f32x16 __attribute__((ext_vector_type(16)));
typedef short bf16x8 __attribute__((ext_vector_type(8)));
typedef short s16x4 __attribute__((ext_vector_type(4)));
constexpr int NWAVES = 8, NTHR = 512;
constexpr int NB = 8, SQ = 8192, DM = 1024, MT = NB * SQ;
constexpr int FOX_IN = 4112, KVW = 6144, BIN = 4096;
constexpr float LOG2E = 1.4426950408889634f;
constexpr float C2A = 0.125f * LOG2E;
constexpr float C2B = 0.08838834764831845f * LOG2E;
constexpr size_t MiB = 1u << 20;
constexpr size_t WS_RS1 = 0, WS_RS2 = 256 * 1024, WS_RS3 = 512 * 1024, CTL_ZERO_BYTES = 1 * MiB + 8192 + 16384;
constexpr size_t WS_NRM = 768 * 1024, WS_QH = 1024 * 1024;
constexpr size_t WS_BAR = 1 * MiB + 8192;
constexpr size_t WS_RS0 = 1 * MiB + 64 * 1024;
constexpr size_t WS_WINA = 2 * MiB, WS_WOUTA = 18 * MiB, WS_WKV = 22 * MiB, WS_WINB = 34 * MiB, WS_WOUTB = 50 * MiB, WS_WF = 54 * MiB;
constexpr size_t WS_Q = 184 * MiB, WS_K = 312 * MiB, WS_V = 440 * MiB, WS_G = 568 * MiB, WS_CL = 696 * MiB, WS_TOT = 700 * MiB, WS_O = 704 * MiB;
constexpr size_t WS_KV = 184 * MiB;
constexpr size_t WS_U = 56 * MiB;
constexpr size_t WS_LSE = 952 * MiB, WS_MA = 956 * MiB, WS_END = 1020 * MiB; constexpr int U_SPLIT_ROWS = 16384;
constexpr size_t U_BYTES_PER_BATCH = (size_t)SQ * BIN * 2, LSE_BYTES_PER_BATCH = (size_t)SQ * 24 * 4;
constexpr int RING_BYTES = 131072, LDS_BYTES = 147456;

__device__ __forceinline__ unsigned f2bf(float f) { unsigned u = __builtin_bit_cast(unsigned, f); return (u + 0x7fffu + ((u >> 16) & 1u)) >> 16; }
__device__ __forceinline__ unsigned pk2(float lo, float hi) { return f2bf(lo) | (f2bf(hi) << 16); }
typedef float f32x2_t __attribute__((ext_vector_type(2))); typedef __bf16 bf16x2_t __attribute__((ext_vector_type(2)));
__device__ __forceinline__ unsigned cvtpk(float lo, float hi) { f32x2_t v = {lo, hi}; bf16x2_t b = __builtin_convertvector(v, bf16x2_t); return __builtin_bit_cast(unsigned, b); }
__device__ __forceinline__ float bflo(unsigned w) { return __uint_as_float(w << 16); }
__device__ __forceinline__ float bfhi(unsigned w) { return __uint_as_float(w & 0xffff0000u); }
__device__ __forceinline__ float wave_sum(float v) {
    v = xr_sum<1>(v); v = xr_sum<2>(v); v = xr_sum<4>(v); v = xr_sum<8>(v); v = xr_sum<16>(v); v = xr_sum<32>(v);
    return v;
}
__device__ __forceinline__ float silu_f(float g) { return g * __builtin_amdgcn_rcpf(1.f + __builtin_amdgcn_exp2f(-LOG2E * g)); }

__device__ __forceinline__ void p0_transpose_item(const float* W, int K, int ldw, int nblk, const float* gain, bf16* WT, LAS float* scr, int item, int lane) {
    const int kb = item / nblk, nb = item % nblk, k0 = 64 * kb, n0 = 32 * nb;
    float wv_[32], gv_[32];
#pragma unroll
    for (int i = 0; i < 32; ++i) { const int kk = 2 * i + (lane >> 5); wv_[i] = W[(size_t)(k0 + kk) * ldw + n0 + (lane & 31)]; gv_[i] = gain ? gain[k0 + kk] : 1.f; }
#pragma unroll
    for (int i = 0; i < 32; ++i) { const int kk = 2 * i + (lane >> 5); scr[kk * 33 + (lane & 31)] = gv_[i] * wv_[i]; }
    asm volatile("s_waitcnt lgkmcnt(0)" ::: "memory");
    const int c = lane & 7;
#pragma unroll
    for (int j = 0; j < 4; ++j) { const int n = (lane >> 3) + 8 * j; const LAS float* s = scr + (8 * c) * 33 + n;
        v4u o; o.x = pk2(s[0 * 33], s[1 * 33]); o.y = pk2(s[2 * 33], s[3 * 33]); o.z = pk2(s[4 * 33], s[5 * 33]); o.w = pk2(s[6 * 33], s[7 * 33]);
        *(GAS v4u*)(WT + (size_t)(n0 + n) * K + k0 + 8 * c) = o; }
    asm volatile("s_waitcnt lgkmcnt(0)" ::: "memory");
}

#define RLX_AGENT __ATOMIC_RELAXED, __HIP_MEMORY_SCOPE_AGENT
#define XB_TMO      128
#define XB_XCNT(j)  (256  + 64 * (j))
#define XB_XSUB(j)  (1280 + 64 * (j))
#define XB_XGEN(j)  (2304 + 64 * (j))
#define XB_TOP      3328
#define XB_TOPGEN   3392
#define XCD_BAR_WORDS 3456
#define XB_SPIN_CAP (1u << 18)

__device__ __forceinline__ unsigned xb_ld(unsigned* p)              { return __hip_atomic_load(p, __ATOMIC_RELAXED, __HIP_MEMORY_SCOPE_AGENT); }
__device__ __forceinline__ unsigned xb_add(unsigned* p, unsigned v) { return __hip_atomic_fetch_add(p, v, __ATOMIC_RELAXED, __HIP_MEMORY_SCOPE_AGENT); }
__device__ __forceinline__ unsigned xb_xcc_id() { return (unsigned)__builtin_amdgcn_s_getreg((3 << 11) | 20) & 0xFu; }
#define XB_SPIN(cond, bar) do { unsigned _sp = 0; while (cond) { __builtin_amdgcn_s_sleep(1); \
    if ((++_sp & 255u) == 0u) { if (xb_ld(&(bar)[XB_TMO])) break; if (_sp > XB_SPIN_CAP) { atomicAdd(&(bar)[XB_TMO], 1u); break; } } } } while (0)

struct XcdBarrier {
    unsigned* bar; unsigned x;
    volatile LAS unsigned* st;
};

__device__ __forceinline__ XcdBarrier xcd_barrier_post(unsigned* bar, volatile LAS unsigned* st) {
    XcdBarrier b; b.bar = bar; b.x = xb_xcc_id(); b.st = st;
    if (threadIdx.x == 0) (void)xb_add(&bar[XB_XCNT(b.x)], 1u);
    return b;
}
__device__ __forceinline__ void xcd_barrier_complete(unsigned* bar, unsigned x, unsigned& nloc, unsigned& nx) {
    const unsigned G = gridDim.x * gridDim.y * gridDim.z;
    unsigned sum, cnt, mine, sp = 0u;
    for (;;) {
        sum = 0u; cnt = 0u; mine = 0u;
#pragma unroll
        for (unsigned j = 0; j < 16; ++j) { const unsigned c = xb_ld(&bar[XB_XCNT(j)]); sum += c; cnt += (c > 0u) ? 1u : 0u; mine = (j == x) ? c : mine; }
        if (sum == G) break;
        __builtin_amdgcn_s_sleep(1);
        if ((++sp & 255u) == 0u) { if (xb_ld(&bar[XB_TMO])) break; if (sp > XB_SPIN_CAP) { atomicAdd(&bar[XB_TMO], 1u); break; } }
    }
    nloc = mine > 0u ? mine : 1u; nx = cnt > 0u ? cnt : 1u;
}

__device__ __forceinline__ void xcd_barrier(const XcdBarrier& b) {
    asm volatile("s_waitcnt vmcnt(0)" ::: "memory");
    __syncthreads();
    if (threadIdx.x == 0) {
        unsigned* bar = b.bar;
        __builtin_amdgcn_s_waitcnt(0);
        unsigned nloc = b.st[0], nx = b.st[1];
        if (nloc == 0u) { xcd_barrier_complete(bar, b.x, nloc, nx); b.st[0] = nloc; b.st[1] = nx; }
        const unsigned old = xb_add(&bar[XB_XSUB(b.x)], 1u);
        const unsigned gen = old / nloc;
        if (old + 1u == (gen + 1u) * nloc) {
            __builtin_amdgcn_fence(__ATOMIC_RELEASE, "agent");
            asm volatile("s_waitcnt vmcnt(0)" ::: "memory");
            const unsigned og = xb_add(&bar[XB_TOP], 1u);
            const unsigned tg = og / nx;
            if (og + 1u == (tg + 1u) * nx) xb_add(&bar[XB_TOPGEN], 1u);
            else XB_SPIN(xb_ld(&bar[XB_TOPGEN]) == tg, bar);
            __builtin_amdgcn_fence(__ATOMIC_ACQUIRE, "agent");
            xb_add(&bar[XB_XGEN(b.x)], 1u);
            asm volatile("s_waitcnt vmcnt(0)" ::: "memory");
        } else {
            XB_SPIN(xb_ld(&bar[XB_XGEN(b.x)]) == gen, bar);
            __builtin_amdgcn_fence(__ATOMIC_ACQUIRE, "agent");
            asm volatile("s_waitcnt vmcnt(0)" ::: "memory");
        }
    }
    __syncthreads();
}

struct Args { const float* in[12]; float* out; unsigned char* ws; int ph_lo, ph_hi, nbc, pad; };

__device__ __forceinline__ void f_item(LAS unsigned char* lds, const bf16* hb, const bf16* Wf, const float* bfv, const float* rowss, float* CL, float* TOT, int item, int wid, int lane) {
    const int b = item >> 6, blk = item & 63, fr = lane & 15, fq = lane >> 4;
    const int tok0 = b * SQ + blk * 128 + wid * 16;
    f32x4 acc = (f32x4){0.f, 0.f, 0.f, 0.f};
    const bf16* xa = hb + (size_t)(tok0 + fr) * DM + fq * 8; const bf16* wb = Wf + (size_t)fr * DM + fq * 8;
#pragma unroll 1
    for (int k8 = 0; k8 < 4; ++k8) { bf16x8 a8[8], w8[8];
#pragma unroll
        for (int q = 0; q < 8; ++q) { a8[q] = *(const bf16x8*)(xa + (k8 * 8 + q) * 32); w8[q] = *(const bf16x8*)(wb + (k8 * 8 + q) * 32); }
        asm volatile("" : "+v"(a8[0]), "+v"(a8[1]), "+v"(a8[2]), "+v"(a8[3]), "+v"(a8[4]), "+v"(a8[5]), "+v"(a8[6]), "+v"(a8[7]));
#pragma unroll
        for (int q = 0; q < 8; ++q) acc = __builtin_amdgcn_mfma_f32_16x16x32_bf16(a8[q], w8[q], acc, 0, 0, 0); }
    const float bias = bfv[fr]; float s[4]; float run = 0.f;
#pragma unroll
    for (int e = 0; e < 4; ++e) { const float rs = __builtin_amdgcn_rsqf(rowss[tok0 + 4 * fq + e] * (1.0f / 1024.0f) + 1e-6f); const float f = acc[e] * rs + bias;
        const float ls = fminf(f, 0.f) - log1pf(__expf(-fabsf(f))); run += ls; s[e] = run; }
    float pre = 0.f;
#pragma unroll
    for (int j = 0; j < 3; ++j) { const float tj = xl_from_lane(run, fr + 16 * j); if (j < fq) pre += tj; }
    LAS float* wtot = (LAS float*)lds;
    if (fq == 3) wtot[wid * 16 + fr] = pre + run;
    __syncthreads();
    float wpre = 0.f, all = 0.f;
#pragma unroll
    for (int w = 0; w < 8; ++w) { const float t = wtot[w * 16 + fr]; all += t; if (w < wid) wpre += t; }
    const float base = wpre + pre;
    *(f32x4*)(CL + (size_t)(b * 16 + fr) * SQ + blk * 128 + wid * 16 + 4 * fq) = (f32x4){base + s[0], base + s[1], base + s[2], base + s[3]};
    if (wid == 0 && fq == 0) TOT[(b * 16 + fr) * 64 + blk] = all;
    __syncthreads();
}

__device__ __forceinline__ unsigned offb(unsigned row, unsigned ch) { return 256u * row + 16u * (ch ^ (((row & 3) << 2) | ((row >> 2) & 3))); }
__device__ __forceinline__ int crow(int r, int hi) { return (r & 3) + 8 * (r >> 2) + 4 * hi; }
__device__ __forceinline__ int t5_bucket(int dist) {
    if (dist < 16) return dist;
    int b = 16;
    b += dist >= 22; b += dist >= 30; b += dist >= 40; b += dist >= 54; b += dist >= 73; b += dist >= 99; b += dist >= 134; b += dist >= 182;
    b += dist >= 246; b += dist >= 332; b += dist >= 450; b += dist >= 609; b += dist >= 825; b += dist >= 1117; b += dist >= 1513;
    return b;
}
#define BATT_DECODE(IT, KG, UG, LSEP, DD, RR, PP, GH) do { const int bl_ = (IT) / 768, r_ = (IT) % 768, g_ = r_ >> 8, h_ = (r_ >> 5) & 7, pi_ = r_ & 31; \
    DD = (g_ == 0) ? 1 : (g_ == 1) ? 4 : 16; const int ppr_ = 32 / DD; RR = pi_ / ppr_; PP = pi_ % ppr_; GH = g_ * 8 + h_; \
    KG = KV + ((((size_t)(b0 + bl_) * 3 + g_) * 2) * 8 + h_) * ((size_t)SQ * 128); UG = (bl_ < 2 ? U + (size_t)bl_ * SQ * BIN : U2 + (size_t)(bl_ - 2) * SQ * BIN) + g_ * 1024 + h_ * 128; LSEP = LSE + (size_t)bl_ * SQ * 24; } while (0)
#define BATT_LOADK(KG, DD, RR, PP) do { const long koff_ = ((long)(RR) * (SQ / (DD)) + 256 * (PP) - 128 + row0) * 128 + ch0 * 8; const long kstr_ = 4096; \
    _Pragma("unroll") for (int i = 0; i < 12; ++i) kreg[i] = ((PP) > 0 || i >= 4) ? *(const v4u*)((KG) + koff_ + i * kstr_) : (v4u){0u, 0u, 0u, 0u}; } while (0)
__device__ __forceinline__ void battn_phase(LAS unsigned char* lds, const bf16* KV, bf16* U, bf16* U2, float* LSE, const float* relb, int b0, int nitems, int vcu, int G, int tid_in, int wid, int reps) {
    int row0, ch0;
    { int t0 = tid_in; asm volatile("" : "+v"(t0)); row0 = t0 >> 4; ch0 = t0 & 15; }
    LAS float* lut = (LAS float*)(lds + 98304);
    LAS float* wsf = (LAS float*)(lds + 98304 + 1024) + wid * 32;
    LAS bf16* stg = (LAS bf16*)(lds + 98304 + 2048 + wid * 4096);
    const int total = nitems * reps;
    int it = vcu; if (it >= total) return;
    const bf16* Kg; bf16* Ug; float* LSEp; int d, rr, pp, gh;
    v4u kreg[12];
    { const int itm = it % nitems; BATT_DECODE(itm, Kg, Ug, LSEp, d, rr, pp, gh); BATT_LOADK(Kg, d, rr, pp); }
    for (;;) {
        const bool dry = it + nitems < total;
        int tid = tid_in; asm volatile("" : "+v"(tid));
        const int lane = tid & 63, r32 = lane & 31, hi = lane >> 5; const unsigned loff = offb((unsigned)(tid >> 4), (unsigned)(tid & 15));
        bf16x8 qf[8];
        { const size_t qtok_ = (size_t)((256 * pp + 32 * wid + r32) * d + rr);
#pragma unroll
          for (int d0 = 0; d0 < 8; ++d0) qf[d0] = *(const bf16x8*)(Ug + qtok_ * BIN + d0 * 16 + hi * 8); }
        if (tid < 192) { const int rel_ = tid - 32; lut[tid] = (rel_ >= 0 && rel_ <= 128) ? relb[t5_bucket(rel_ * d) * 24 + gh] * LOG2E : 0.f; }
#pragma unroll
        for (int i = 0; i < 12; ++i) *(LAS v4u*)(lds + i * 8192 + loff) = kreg[i];
        __syncthreads();
        v4u vreg[12];
        { const long koff_ = ((long)rr * (SQ / d) + 256 * pp - 128 + (tid >> 4)) * 128 + (tid & 15) * 8; const long kstr_ = 4096;
#pragma unroll
          for (int i = 0; i < 12; ++i) vreg[i] = (pp > 0 || i >= 4) ? *(const v4u*)(Kg + (size_t)8 * SQ * 128 + koff_ + i * kstr_) : (v4u){0u, 0u, 0u, 0u}; }
        f32x16 s[5];
        const unsigned xr = ((r32 & 3) << 2) | ((r32 >> 2) & 3);
#pragma unroll
        for (int kb = 0; kb < 5; ++kb) { s[kb] = (f32x16){0.f,0.f,0.f,0.f,0.f,0.f,0.f,0.f,0.f,0.f,0.f,0.f,0.f,0.f,0.f,0.f};
            const LAS unsigned char* tb = lds + (wid + kb) * 8192 + 256 * r32;
#pragma unroll
            for (int d0 = 0; d0 < 8; ++d0) { const bf16x8 kf = *(const LAS bf16x8*)(tb + 16 * ((unsigned)(2 * d0 + hi) ^ xr)); s[kb] = __builtin_amdgcn_mfma_f32_32x32x16_bf16(kf, qf[d0], s[kb], 0, 0, 0); } }
        float mx = -INFINITY;
        const int e_ = r32 - 4 * hi; const LAS float* lp = lut + (e_ + 32);
#pragma unroll
        for (int kb = 0; kb < 5; ++kb) {
            if (pp == 0 && wid + kb < 4) {
#pragma unroll
                for (int r = 0; r < 16; ++r) s[kb][r] = -INFINITY;
            } else {
#pragma unroll
                for (int r = 0; r < 16; ++r) { const int cr = (r & 3) + 8 * (r >> 2); float v = s[kb][r] + lp[128 - 32 * kb - cr];
                    if (kb == 0) v = (e_ <= cr) ? v : -INFINITY;
                    if (kb == 4) v = (e_ >= cr) ? v : -INFINITY;
                    s[kb][r] = v; mx = fmaxf(mx, v); }
            }
        }
        mx = xr_max<32>(mx);
        float l = 0.f;
#pragma unroll
        for (int kb = 0; kb < 5; ++kb)
#pragma unroll
            for (int r = 0; r < 16; ++r) { const float p = __builtin_amdgcn_exp2f(s[kb][r] - mx); s[kb][r] = p; l += p; }
        l = xr_sum<32>(l);
        bf16x8 pf[5][2];
#pragma unroll
        for (int kb = 0; kb < 5; ++kb)
#pragma unroll
            for (int ks = 0; ks < 2; ++ks) { v4u w; w.x = cvtpk(s[kb][8 * ks + 0], s[kb][8 * ks + 1]); w.y = cvtpk(s[kb][8 * ks + 2], s[kb][8 * ks + 3]); w.z = cvtpk(s[kb][8 * ks + 4], s[kb][8 * ks + 5]); w.w = cvtpk(s[kb][8 * ks + 6], s[kb][8 * ks + 7]);
                pf[kb][ks] = __builtin_bit_cast(bf16x8, w); }
        __syncthreads();
#pragma unroll
        for (int i = 0; i < 12; ++i) *(LAS v4u*)(lds + i * 8192 + loff) = vreg[i];
        if (hi == 0) wsf[r32] = __builtin_amdgcn_rcpf(l);
        __syncthreads();
        bf16* const Uc = Ug; float* const Lc = LSEp; const int dc = d, rrc = rr, ppc = pp, ghc = gh;
        const int nit = it + G; const bool has_next = nit < total;
        if (has_next) { const int itm = nit % nitems; BATT_DECODE(itm, Kg, Ug, LSEp, d, rr, pp, gh); BATT_LOADK(Kg, d, rr, pp); }
        f32x16 o[4];
        int l2 = lane; asm volatile("" : "+v"(l2));
        const unsigned blk = (l2 >> 4) & 1, qq = (l2 & 15) >> 2, p4 = l2 & 3;
#pragma unroll
        for (int c = 0; c < 4; ++c) { o[c] = (f32x16){0.f,0.f,0.f,0.f,0.f,0.f,0.f,0.f,0.f,0.f,0.f,0.f,0.f,0.f,0.f,0.f};
#pragma unroll
            for (int kb = 0; kb < 5; ++kb)
#pragma unroll
                for (int ks = 0; ks < 2; ++ks) { s16x4 vv[2];
#pragma unroll
                    for (int t = 0; t < 2; ++t) { const unsigned row = 16 * ks + 8 * t + 4 * hi + qq; const LAS unsigned char* ap = lds + (wid + kb) * 8192 + offb(row, 4 * c + 2 * blk + (p4 >> 1)) + 8 * (p4 & 1);
                        vv[t] = __builtin_bit_cast(s16x4, __builtin_amdgcn_ds_read_tr16_b64_v4i16((LAS s16x4*)ap)); }
                    const bf16x8 vf = (bf16x8){vv[0][0], vv[0][1], vv[0][2], vv[0][3], vv[1][0], vv[1][1], vv[1][2], vv[1][3]};
                    o[c] = __builtin_amdgcn_mfma_f32_32x32x16_bf16(pf[kb][ks], vf, o[c], 0, 0, 0); } }
        float rl[16];
#pragma unroll
        for (int r = 0; r < 16; ++r) rl[r] = wsf[crow(r, hi)];
#pragma unroll
        for (int hc = 0; hc < 2; ++hc) {
#pragma unroll
            for (int r = 0; r < 16; ++r) { const int qr_ = crow(r, hi);
#pragma unroll
                for (int cc = 0; cc < 2; ++cc) stg[qr_ * 64 + cc * 32 + r32] = (bf16)cvtpk(o[2 * hc + cc][r] * rl[r], 0.f); }
#pragma unroll
            for (int i = 0; i < 4; ++i) { const int row = i * 8 + (l2 >> 3), ch = l2 & 7; const v4u v = *(const LAS v4u*)(stg + row * 64 + ch * 8);
                const size_t tok = (size_t)((256 * ppc + 32 * wid + row) * dc + rrc); if (!dry) *(v4u*)(Uc + tok * BIN + hc * 64 + ch * 8) = v; }
        }
        if (hi == 0 && !dry) Lc[(size_t)((256 * ppc + 32 * wid + r32) * dc + rrc) * 24 + ghc] = mx + __builtin_amdgcn_logf(l);
        __syncthreads();
        if (!has_next) break;
        it = nit;
    }
}
#ifndef PHASE_MASK
#define PHASE_MASK 0xffff
#endif
#define EN(k) ((PHASE_MASK >> (k)) & 1)
#ifndef PROBE_GEMM_REPS
#define PROBE_GEMM_REPS 1
#endif
#ifndef PROBE_BATT_REPS
#define PROBE_BATT_REPS 1
#endif
#ifndef PROBE_RES_REPS
#define PROBE_RES_REPS 1
#endif
#ifndef PROBE_MEM_REPS
#define PROBE_MEM_REPS 1
#endif
#ifndef PROBE_ATT_REPS
#define PROBE_ATT_REPS 1
#endif
enum { K_PRO = 0, K_AIN, K_AATT, K_AOUT, K_KV, K_BIN, K_BATT, K_BMRG, K_BOUT, K_FIN };
__global__ void __launch_bounds__(NTHR, 2) yoco_fwd(Args args) {
    extern __shared__ __attribute__((aligned(16))) unsigned char lds_raw[];
    cg::grid_group grid = cg::this_grid();
    LAS unsigned char* lds = (LAS unsigned char*)lds_raw;
    const int wid0 = __builtin_amdgcn_readfirstlane(threadIdx.x >> 6);
#define INP(k) ({ int k_ = (k); asm volatile("" : "+s"(k_)); (const float*)(GAS const float*)args.in[k_]; })
    volatile LAS unsigned* bst = (volatile LAS unsigned*)((LAS unsigned char*)lds_raw + LDS_BYTES - 64);
    if (threadIdx.x < 2) bst[threadIdx.x] = 0u;
    __syncthreads();
    (void)xcd_barrier_post((unsigned*)(args.ws + WS_BAR), bst);

    for (int ph = args.ph_lo; ; ++ph) {
        int G = gridDim.x; asm volatile("" : "+s"(G)); int bx = blockIdx.x; asm volatile("" : "+s"(bx)); int nbc = args.nbc; asm volatile("" : "+s"(nbc));
        const int vcu = (G % 8 == 0) ? (bx % 8) * (G / 8) + bx / 8 : bx;
        const int lnch = (nbc == 8) ? 0 : (nbc == 4) ? 1 : (nbc == 2) ? 2 : 3, nch = 1 << lnch;
        const int n_phase = 8 + 6 * nch + 1;
        const int NGW = G * NWAVES;
        if (ph >= args.ph_hi || ph >= n_phase) break;
        int kind, layer = 0, chunk = 0;
        if (ph == 0) kind = K_PRO;
        else if (ph < 7) { layer = (ph - 1) / 3; kind = K_AIN + (ph - 1) % 3; }
        else if (ph == 7) kind = K_KV;
        else if (ph < 8 + 6 * nch) { const int q = ph - 8, j = q / 3; layer = j >> lnch; chunk = j & (nch - 1); kind = K_BATT + (q - 3 * j); }
        else kind = K_FIN;

        for (int pass_ = 0; pass_ < 2; ++pass_) {
        if (pass_ == 1) { if (kind != K_BOUT && kind != K_KV) break; const int j = (kind == K_KV) ? 0 : (layer << lnch) + chunk + 1; if (j >= 2 * nch) break; layer = j >> lnch; chunk = j & (nch - 1); kind = K_BIN; }
        int tid; asm volatile("v_mbcnt_lo_u32_b32 %0, -1, 0\n\tv_mbcnt_hi_u32_b32 %0, -1, %0" : "=v"(tid)); tid += wid0 * 64;
        GAS unsigned char* ws = (GAS unsigned char*)args.ws; asm volatile("" : "+s"(ws)); GAS float* outg = (GAS float*)args.out; asm volatile("" : "+s"(outg)); float* out = (float*)outg; bf16* HB = (bf16*)out; bf16* LOP = HB + (size_t)MT * DM;
        const int lane = tid & 63, wid = __builtin_amdgcn_readfirstlane(tid >> 6); const int gw = vcu * NWAVES + wid;
        if (EN(K_PRO) && kind == K_PRO) {
            const float* x = INP(0); const float* norm_a = INP(2); const float* w_in_a = INP(3); const float* w_out_a = INP(5); const float* norm_kv = INP(6); const float* w_kv = INP(7); const float* norm_b = INP(8); const float* w_in_b = INP(9); const float* w_out_b = INP(10);
            for (int rp_ = 0; rp_ < PROBE_MEM_REPS; ++rp_) {
            LAS float* scr = (LAS float*)(lds + wid * 16384);
            constexpr int I_INA = 16 * 128, I_OUT = 16 * 32, I_KV = 16 * 192, I_INB = 16 * 128;
            constexpr int NITEMS = 2 * I_INA + 2 * I_OUT + I_KV + 2 * I_INB + 2 * I_OUT + 32;
#pragma unroll 1
            for (int it = gw; it < NITEMS; it += NGW) {
                int r = it;
                if (r < 2 * I_INA) { const int i = r / I_INA; p0_transpose_item(w_in_a + (size_t)i * DM * FOX_IN, DM, FOX_IN, 128, norm_a + i * DM, (bf16*)(ws + WS_WINA + (size_t)i * 8 * MiB), scr, r % I_INA, lane); continue; } r -= 2 * I_INA;
                if (r < 2 * I_OUT) { const int i = r / I_OUT; p0_transpose_item(w_out_a + (size_t)i * DM * DM, DM, DM, 32, nullptr, (bf16*)(ws + WS_WOUTA + (size_t)i * 2 * MiB), scr, r % I_OUT, lane); continue; } r -= 2 * I_OUT;
                if (r < I_KV) { p0_transpose_item(w_kv, DM, KVW, 192, norm_kv, (bf16*)(ws + WS_WKV), scr, r, lane); continue; } r -= I_KV;
                if (r < 2 * I_INB) { const int i = r / I_INB; p0_transpose_item(w_in_b + (size_t)i * DM * BIN, DM, BIN, 128, norm_b + i * DM, (bf16*)(ws + WS_WINB + (size_t)i * 8 * MiB), scr, r % I_INB, lane); continue; } r -= 2 * I_INB;
                if (r < 2 * I_OUT) { const int i = r / I_OUT; p0_transpose_item(w_out_b + (size_t)i * DM * DM, DM, DM, 32, nullptr, (bf16*)(ws + WS_WOUTB + (size_t)i * 2 * MiB), scr, r % I_OUT, lane); continue; } r -= 2 * I_OUT;
                { const int i = r >> 4, n = r & 15;
#pragma unroll 4
                  for (int j = 0; j < 16; ++j) { const int k = lane + 64 * j; ((bf16*)(ws + WS_WF))[(i * 16 + n) * DM + k] = (bf16)f2bf(norm_a[i * DM + k] * w_in_a[(size_t)i * DM * FOX_IN + (size_t)k * FOX_IN + 4096 + n]); } }
            }
            float* RS0 = (float*)(ws + WS_RS0);
#pragma unroll 1
            for (int m = gw; m < MT; m += NGW) {
                const f32x4* xr = (const f32x4*)(x + (size_t)m * DM) + lane; unsigned long long* hrow = (unsigned long long*)(HB + (size_t)m * DM) + lane;
                f32x4 v[4]; float s = 0.f;
#pragma unroll
                for (int j = 0; j < 4; ++j) v[j] = xr[64 * j];
                asm volatile("" : "+v"(v[0]), "+v"(v[1]), "+v"(v[2]), "+v"(v[3]));
#pragma unroll
                for (int j = 0; j < 4; ++j) s += (v[j].x * v[j].x + v[j].y * v[j].y) + (v[j].z * v[j].z + v[j].w * v[j].w);
                s = wave_sum(s);
#pragma unroll
                for (int j = 0; j < 4; ++j) { const unsigned h0 = cvtpk(v[j].x, v[j].y), h1 = cvtpk(v[j].z, v[j].w);
                    hrow[64 * j] = (unsigned long long)h0 | ((unsigned long long)h1 << 32); }
                if (lane == 0) RS0[m] = s;
            }
            }
        }
        else if (EN(K_AIN) && (kind == K_AIN || kind == K_KV || kind == K_BIN)) {
            pg8::Gemm g; pg8::EpiBf16Row E;
            if (kind == K_AIN) {
                const float* rs = (const float*)(ws + (layer == 0 ? WS_RS0 : WS_RS1));
#pragma unroll 1
                for (int it = vcu; it < 512; it += G)
                    f_item(lds, HB, (const bf16*)(ws + WS_WF) + (size_t)layer * 16 * DM, INP(4) + layer * 16, rs, (float*)(ws + WS_CL), (float*)(ws + WS_TOT), it, wid, lane);
                g = pg8::Gemm{HB, (const bf16*)(ws + WS_WINA + (size_t)layer * 8 * MiB), MT, 4096, DM, DM};
                E = pg8::EpiBf16Row{(bf16*)(ws + WS_Q), DM, rs, DM, (size_t)(WS_K - WS_Q) / 2, DM, C2A, nullptr, 0, 0, (unsigned*)(ws + WS_NRM) + (size_t)layer * 32768};
            } else if (kind == K_KV) {
                g = pg8::Gemm{HB, (const bf16*)(ws + WS_WKV), MT, KVW, DM, DM};
                E = pg8::EpiBf16Row{(bf16*)(ws + WS_KV), KVW, (const float*)(ws + WS_RS2), 0, 0, 0, 1.f, nullptr, 0, 1, nullptr};
            } else {
                const size_t row0 = (size_t)chunk * nbc * SQ;
                g = pg8::Gemm{HB + row0 * DM, (const bf16*)(ws + WS_WINB + (size_t)layer * 8 * MiB), nbc * SQ, BIN, DM, DM};
                E = pg8::EpiBf16Row{(bf16*)(ws + WS_U), BIN, (const float*)(ws + (layer == 0 ? WS_RS2 : WS_RS3)) + row0, 0, 0, 3072, C2B, HB + (size_t)MT * DM, U_SPLIT_ROWS, 0, nullptr};
            }
            pg8::StaticOrder S; S.init(g.M, g.N, G, bx);
            for (int rep_ = 0; rep_ < PROBE_GEMM_REPS; ++rep_) pg8::gemm_phase<pg8::EpiBf16Row, pg8::StaticOrder, true, true>(lds, g, S, E, tid);
        }
        else if (EN(K_AATT) && kind == K_AATT) {
            const attn_body::AttnTensors AT{(const attn_body::bf16*)(ws + WS_Q), (const attn_body::bf16*)(ws + WS_K), (const attn_body::bf16*)(ws + WS_V), (attn_body::bf16*)(ws + WS_O),
                                            (const attn_body::bf16*)(ws + WS_G), (const float*)(ws + WS_CL), (const float*)(ws + WS_TOT), (const float*)(ws + WS_NRM) + (size_t)layer * 32768};
            const attn_body::DynOrder S{(unsigned*)(ws + WS_QH) + layer * 512, (int)(__builtin_amdgcn_s_getreg((3 << 11) | 20) & 7), wid0, (LAS unsigned*)(lds + attn_body::LDS_REL + 260)};
            if (tid == 0) *S.slot = 0xfffffffeu;
            __syncthreads();
            attn_body::attn_phase<attn_body::DynOrder, 24>((char*)lds_raw, AT, S);
#if PROBE_ATT_REPS > 1
            { const attn_body::DynOrder S2{(unsigned*)(ws + WS_QH) + 1024 + layer * 512, S.xcc, wid0, S.slot}; __syncthreads(); attn_body::attn_phase<attn_body::DynOrder, 24>((char*)lds_raw, AT, S2); }
#endif

        }
        else if (EN(K_AOUT) && (kind == K_AOUT || kind == K_BOUT)) {
            pg8::Gemm g; pg8::EpiResid E;
            if (kind == K_AOUT) {
                g = pg8::Gemm{(const bf16*)(ws + WS_O), (const bf16*)(ws + WS_WOUTA + (size_t)layer * 2 * MiB), MT, DM, DM, DM};
                E = pg8::EpiResid{HB, LOP, nullptr, (float*)(ws + (layer == 0 ? WS_RS1 : WS_RS2)), DM, 0, layer == 0 ? INP(0) : (const float*)nullptr};
            } else {
                const size_t row0 = (size_t)chunk * nbc * SQ;
                g = pg8::Gemm{(const bf16*)(ws + WS_MA), (const bf16*)(ws + WS_WOUTB + (size_t)layer * 2 * MiB), nbc * SQ, DM, DM, DM};
                E = pg8::EpiResid{HB + row0 * DM, LOP + row0 * DM, layer == 0 ? (float*)nullptr : (float*)(ws + WS_KV) + (size_t)chunk * nbc * pg8::FIN_BSTRIDE, layer == 0 ? (float*)(ws + WS_RS3) + row0 : (float*)nullptr, DM, 0, nullptr};
            }
            pg8::StaticOrder S; S.init(g.M, g.N, G, bx);
#if PROBE_RES_REPS > 1
            { pg8::EpiResid E2 = E; E2.dry = 1; pg8::gemm_phase<pg8::EpiResid, pg8::StaticOrder, true, true>(lds, g, S, E2, tid); }
#endif
            pg8::gemm_phase<pg8::EpiResid, pg8::StaticOrder, true, true>(lds, g, S, E, tid);
        }
        else if (EN(K_BATT) && kind == K_BATT) {
            battn_phase(lds, (const bf16*)(ws + WS_KV), (bf16*)(ws + WS_U), HB + (size_t)MT * DM, (float*)(ws + WS_LSE), INP(1), chunk * nbc, nbc * 768, vcu, G, tid, wid, PROBE_BATT_REPS);
        }
        else if (EN(K_BMRG) && kind == K_BMRG) {
            const float* LSE = (const float*)(ws + WS_LSE); const bf16* U = (const bf16*)(ws + WS_U);
#pragma unroll 1
            for (int m = gw; m < nbc * SQ; m += NGW) {
                const int hh = lane >> 3; const float* lp = LSE + (size_t)m * 24 + hh;
                float l0 = lp[0], l1 = lp[8], l2 = lp[16];
                const bf16* urow = (m < U_SPLIT_ROWS ? U + (size_t)m * BIN : (const bf16*)(HB + (size_t)MT * DM) + (size_t)(m - U_SPLIT_ROWS) * BIN) + 16 * lane;
                v4u a[2], b[2], c[2], gt[2];
#pragma unroll
                for (int j = 0; j < 2; ++j) { a[j] = *(const v4u*)(urow + 8 * j); b[j] = *(const v4u*)(urow + 1024 + 8 * j); c[j] = *(const v4u*)(urow + 2048 + 8 * j); gt[j] = *(const v4u*)(urow + 3072 + 8 * j); }
                asm volatile("" : "+v"(l0), "+v"(l1), "+v"(l2), "+v"(a[0]), "+v"(a[1]), "+v"(b[0]), "+v"(b[1]), "+v"(c[0]), "+v"(c[1]), "+v"(gt[0]), "+v"(gt[1]));
                const float mxl = fmaxf(l0, fmaxf(l1, l2));
                float w0 = __builtin_amdgcn_exp2f(l0 - mxl), w1 = __builtin_amdgcn_exp2f(l1 - mxl), w2 = __builtin_amdgcn_exp2f(l2 - mxl); const float inv = __builtin_amdgcn_rcpf(w0 + w1 + w2); w0 *= inv; w1 *= inv; w2 *= inv;
#pragma unroll
                for (int j = 0; j < 2; ++j) { v4u o;
#pragma unroll
                    for (int e = 0; e < 4; ++e) { const float v0 = (w0 * bflo(a[j][e]) + w1 * bflo(b[j][e]) + w2 * bflo(c[j][e])) * silu_f(bflo(gt[j][e])), v1 = (w0 * bfhi(a[j][e]) + w1 * bfhi(b[j][e]) + w2 * bfhi(c[j][e])) * silu_f(bfhi(gt[j][e])); o[e] = cvtpk(v0, v1); }
                    *(v4u*)((bf16*)(ws + WS_MA) + (size_t)m * DM + 16 * lane + 8 * j) = o; }
            }
        }
        else if (EN(K_FIN) && kind == K_FIN) {
            const f32x4* gp0 = (const f32x4*)INP(11) + lane;
            for (int rp_ = 0; rp_ < PROBE_MEM_REPS; ++rp_)
#pragma unroll 1
            for (int m = gw; m < MT; m += NGW) {
                f32x4* orow = (f32x4*)(out + (size_t)m * DM) + lane; f32x4 v[4]; float s = 0.f;
                const f32x4* irow = (const f32x4*)((const float*)(ws + WS_KV) + (size_t)(m >> 13) * pg8::FIN_BSTRIDE + (size_t)(m & 8191) * DM) + lane;
#pragma unroll
                for (int j = 0; j < 4; ++j) v[j] = irow[64 * j];
                f32x4 gfin[4];
#pragma unroll
                for (int j = 0; j < 4; ++j) gfin[j] = gp0[64 * j];
                asm volatile("" : "+v"(v[0]), "+v"(v[1]), "+v"(v[2]), "+v"(v[3]), "+v"(gfin[0]), "+v"(gfin[1]), "+v"(gfin[2]), "+v"(gfin[3]));
#pragma unroll
                for (int j = 0; j < 4; ++j) s += (v[j].x * v[j].x + v[j].y * v[j].y) + (v[j].z * v[j].z + v[j].w * v[j].w);
                const float rs = 1.0f / sqrtf(wave_sum(s) * (1.0f / 1024.0f) + 1e-6f);
#pragma unroll
                for (int j = 0; j < 4; ++j) orow[64 * j] = v[j] * rs * gfin[j];
            }
        }
        }
        if (ph + 1 < args.ph_hi && ph + 1 < n_phase) { if (ph == args.ph_lo) grid.sync(); else { XcdBarrier xbar; xbar.bar = (unsigned*)(args.ws + WS_BAR); xbar.x = xb_xcc_id(); xbar.st = bst; xcd_barrier(xbar); } }
    }
}

extern "C" void kernel_launch(void* const* d_in, const int* in_sizes, int n_in, void* d_out, int out_size, void* d_ws, size_t ws_size, hipStream_t stream) {
    static int grid = 0, nbc = 1;
    if (grid == 0) {
        if (n_in != 12 || in_sizes[0] != MT * DM || out_size != MT * DM || ws_size < WS_END) { fprintf(stderr, "kernel_launch: unexpected shapes / workspace (n_in %d, ws %zu); nothing launched\n", n_in, ws_size); grid = -1; return; }
        int dev = 0, cus = 0, per_cu = 0;
        if (hipGetDevice(&dev) != hipSuccess || hipDeviceGetAttribute(&cus, hipDeviceAttributeMultiprocessorCount, dev) != hipSuccess) { grid = -1; return; }
        if (hipFuncSetAttribute((const void*)yoco_fwd, hipFuncAttributeMaxDynamicSharedMemorySize, LDS_BYTES) != hipSuccess) { fprintf(stderr, "kernel_launch: hipFuncSetAttribute failed\n"); grid = -1; return; }
        if (hipOccupancyMaxActiveBlocksPerMultiprocessor(&per_cu, (const void*)yoco_fwd, NTHR, LDS_BYTES) != hipSuccess || per_cu < 1) { fprintf(stderr, "kernel_launch: occupancy query gave %d\n", per_cu); per_cu = 1; }
        (void)hipGetLastError();
        grid = cus;
        nbc = 4;
    }
    if (grid < 0) return;
    (void)hipMemsetAsync((char*)d_ws, 0, CTL_ZERO_BYTES, stream);
    Args a{};
    for (int i = 0; i < 12; ++i) a.in[i] = (const float*)d_in[i];
    a.out = (float*)d_out; a.ws = (unsigned char*)d_ws; a.ph_lo = 0; a.ph_hi = 1 << 20; a.nbc = nbc; a.pad = 0;
    void* kargs[] = {&a};
    hipError_t e = hipLaunchCooperativeKernel((const void*)yoco_fwd, dim3(grid), dim3(NTHR), kargs, LDS_BYTES, stream);
    if (e != hipSuccess) fprintf(stderr, "kernel_launch: cooperative launch failed: %s (grid %d)\n", hipGetErrorString(e), grid);
}
```

```cpp
#include <hip/hip_runtime.h>
#include <hip/hip_cooperative_groups.h>
#include <hip/hip_bf16.h>
#include <cstdio>
#include <cstdint>
#include <cmath>
namespace cg = cooperative_groups;
template <int M> __device__ __forceinline__ float xl_partner_lt32(float v) { static_assert(M >= 1 && M < 32, "xor mask"); return __builtin_bit_cast(float, __builtin_amdgcn_ds_swizzle(__builtin_bit_cast(int, v), (M << 10) | 0x1f)); }
template <int M> __device__ __forceinline__ float xr_sum(float v) { if constexpr (M == 32) { const unsigned u = __builtin_bit_cast(unsigned, v); auto rr = __builtin_amdgcn_permlane32_swap(u, u, false, false); return __builtin_bit_cast(float, (unsigned)rr[0]) + __builtin_bit_cast(float, (unsigned)rr[1]); } else return v + xl_partner_lt32<M>(v); }
template <int M> __device__ __forceinline__ float xr_max(float v) { if constexpr (M == 32) { const unsigned u = __builtin_bit_cast(unsigned, v); auto rr = __builtin_amdgcn_permlane32_swap(u, u, false, false); return __builtin_fmaxf(__builtin_bit_cast(float, (unsigned)rr[0]), __builtin_bit_cast(float, (unsigned)rr[1])); } else return __builtin_fmaxf(v, xl_partner_lt32<M>(v)); }
template <int M> __device__ __forceinline__ float xr_min(float v) { if constexpr (M == 32) { const unsigned u = __builtin_bit_cast(unsigned, v); auto rr = __builtin_amdgcn_permlane32_swap(u, u, false, false); return __builtin_fminf(__builtin_bit_cast(float, (unsigned)rr[0]), __builtin_bit_cast(float, (unsigned)rr[1])); } else return __builtin_fminf(v, xl_partner_lt32<M>(v)); }
__device__ __forceinline__ float xl_from_lane(float v, int src_lane) { return __builtin_bit_cast(float, __builtin_amdgcn_ds_bpermute(src_lane << 2, __builtin_bit_cast(int, v))); }
namespace pg8 {
#define PG8_LAS __attribute__((address_space(3)))
typedef unsigned short bf16_t;
typedef short bf16x8 __attribute__((ext_vector_type(8)));
typedef float f32x4 __attribute__((ext_vector_type(4)));
typedef unsigned u32x4 __attribute__((ext_vector_type(4)));
constexpr int BM = 256, BK = 64, HALF = 128, HTB = HALF * BK * 2  , STAGE_BYTES = 8 * HTB, NXCD = 8, WGM = 8;

__host__ __device__ __forceinline__ int lds_byte(int r, int c) { const int st = (r >> 4) * 2 + (c >> 5), rr = r & 15, cc = c & 31, ob = rr * 64 + cc * 2; return st * 1024 + (ob ^ (((ob >> 9) & 1) << 5)); }
__host__ __device__ __forceinline__ void stage_rc(int b, int& R, int& C) { const int st = b / 1024, sb = b % 1024, swz = sb ^ (((sb >> 9) & 1) << 5); R = (st >> 1) * 16 + swz / 64; C = (st & 1) * 32 + (swz % 64) / 2; }
__host__ __device__ __forceinline__ int perm32(int rho) { const int n = rho >> 4, i = rho & 15; return 8 * (i >> 2) + 4 * n + (i & 3); }

struct Unit { int pm, pn; };
struct Gemm { const bf16_t* A; const bf16_t* Bt; int M, N, K, lda; };

struct StaticOrder {
    int nM, nN, nwg, G, c;
    __host__ __device__ void init(int M, int N, int G_, int c_) { nM = M / BM; nN = N / BM; nwg = nM * nN; G = G_; c = c_; }
    __host__ __device__ bool next(int i, Unit& u) const {
        const long L = (long)i * G + c; if (L >= nwg) return false;
        int wgid = (int)L; { const int q = nwg / NXCD, r = nwg % NXCD, xcd = wgid % NXCD, off = wgid / NXCD; wgid = (xcd < r ? xcd * (q + 1) : r * (q + 1) + (xcd - r) * q) + off; }
        const int nig = WGM * nN, gid = wgid / nig, fm = gid * WGM, gsz = (nM - fm) < WGM ? (nM - fm) : WGM;
        u.pm = fm + ((wgid % nig) % gsz); u.pn = (wgid % nig) / gsz; return true;
    }
    __device__ __forceinline__ void a_ready(const Unit&) const {}
    __device__ __forceinline__ void done(const Unit&) const {}
};

__device__ __forceinline__ unsigned cvt_pk_bf16(float lo, float hi) { unsigned r; asm volatile("v_cvt_pk_bf16_f32 %0, %1, %2" : "=v"(r) : "v"(lo), "v"(hi)); return r; }
constexpr float RMS_EPS_F = 1e-6f;
struct EpiBf16Row {
    static constexpr bool PERM = true, AFTER_DRAIN = false;
    bf16_t* O; int ldc; const float* rowss; int split_cols; size_t split_stride; int qcols; float qscale;
    bf16_t* O2; int o2rows;
    int kvmode;
    unsigned* nrm;
    __device__ __forceinline__ void operator()(const f32x4 (&acc)[2][2][4][2], const Unit& u, int wr, int wc, int fr, int fq) const {
        typedef __attribute__((address_space(1))) u32x4 gu32x4; typedef __attribute__((address_space(1))) const float gcf32;
        const int row0 = u.pm * BM + wr * 64 + fr; int colt = u.pn * BM; bf16_t* base = O;
        const float sc = (colt < qcols) ? qscale : 1.f; int t = 0;
        if (split_cols) { t = colt / split_cols; base += (size_t)t * split_stride; colt -= t * split_cols; }
        const int col0 = colt + wc * 32 + 8 * fq;
        const bool do_n = (nrm != nullptr) && (t < 2);
        float rsv[2][4];
#pragma unroll
        for (int ai = 0; ai < 2; ++ai)
#pragma unroll
            for (int m = 0; m < 4; ++m) rsv[ai][m] = ((gcf32*)rowss)[row0 + ai * HALF + m * 16];
        float mx[2][2] = {{0.f, 0.f}, {0.f, 0.f}};
#pragma unroll
        for (int ai = 0; ai < 2; ++ai)
#pragma unroll
            for (int m = 0; m < 4; ++m) { const int r = row0 + ai * HALF + m * 16; const float rs = __builtin_amdgcn_rsqf(rsv[ai][m] * (1.0f / 1024.0f) + RMS_EPS_F) * sc;
                bf16_t* rowp = ((o2rows && r >= o2rows) ? O2 + (size_t)(r - o2rows) * ldc : base + (size_t)r * ldc) + col0; size_t bjs = HALF;
                if (kvmode) { const int g = colt / 2048, kv = (colt >> 10) & 1, h0 = (colt >> 7) & 7, ld = 2 * g, b = r >> 13, tk = r & 8191;
                    const int pos = ((tk & ((1 << ld) - 1)) << (13 - ld)) + (tk >> ld);
                    rowp = O + ((((size_t)(b * 3 + g) * 2 + kv) * 8 + h0) * 8192 + pos) * 128 + wc * 32 + 8 * fq; bjs = (size_t)8192 * 128; }
#pragma unroll
                for (int bj = 0; bj < 2; ++bj) { const f32x4 v0 = acc[ai][bj][m][0] * rs, v1 = acc[ai][bj][m][1] * rs;
                    u32x4 w; w.x = cvt_pk_bf16(v0[0], v0[1]); w.y = cvt_pk_bf16(v0[2], v0[3]); w.z = cvt_pk_bf16(v1[0], v1[1]); w.w = cvt_pk_bf16(v1[2], v1[3]);
                    *(gu32x4*)(rowp + bj * bjs) = w;
                    if (do_n) { float ss = (v0[0] * v0[0] + v0[1] * v0[1]) + (v0[2] * v0[2] + v0[3] * v0[3]) + (v1[0] * v1[0] + v1[1] * v1[1]) + (v1[2] * v1[2] + v1[3] * v1[3]);
                        ss = xr_sum<16>(ss); ss = xr_sum<32>(ss); mx[ai][bj] = fmaxf(mx[ai][bj], ss); } } }
        if (do_n) {
#pragma unroll
            for (int ai = 0; ai < 2; ++ai)
#pragma unroll
                for (int bj = 0; bj < 2; ++bj) { float v = mx[ai][bj]; v = xr_max<1>(v); v = xr_max<2>(v); v = xr_max<4>(v); v = xr_max<8>(v);
                    if (fr == 0 && fq == 0) { const int b = u.pm >> 5, blk = ((u.pm & 31) << 1) + ai, head = (colt >> 6) + 2 * bj + (wc >> 1);
                        __hip_atomic_fetch_max(nrm + ((((size_t)(t * 8 + b) * 16 + head) * 64 + blk) * 2 + (wc & 1)), __float_as_uint(v), __ATOMIC_RELAXED, __HIP_MEMORY_SCOPE_AGENT); } }
        }
    }
};
constexpr size_t FIN_BSTRIDE = (size_t)8192 * 6144 * 2 / 4;
struct EpiResid {
    static constexpr bool PERM = true, AFTER_DRAIN = false;
    bf16_t* phi; bf16_t* plo; float* fin; float* rowss; int ldc; int dry; const float* xbase;
    template <bool FIN, bool XB> __device__ __forceinline__ void body(const f32x4 (&acc)[2][2][4][2], const Unit& u, int wr, int wc, int fr, int fq) const {
        typedef __attribute__((address_space(1))) u32x4 gu4; typedef __attribute__((address_space(1))) f32x4 gf4; typedef __attribute__((address_space(1))) const f32x4 gcf4;
        const int col0 = u.pn * BM + wc * 32 + 8 * fq, rbase = u.pm * BM + wr * 64 + fr;
        u32x4 H[2][2]; f32x4 X0[2][2], X1[2][2];
#define PG8_LOADG(g, b) do { const size_t off_ = (size_t)(rbase + ((g) >> 2) * HALF + ((g) & 3) * 16) * ldc + col0; \
        _Pragma("unroll") for (int bj = 0; bj < 2; ++bj) { const size_t o8_ = off_ + bj * HALF; if (XB) { X0[b][bj] = *(gcf4*)(xbase + o8_); X1[b][bj] = *(gcf4*)(xbase + o8_ + 4); } else H[b][bj] = *(const gu4*)(phi + o8_); } } while (0)
        PG8_LOADG(0, 0);
#pragma unroll
        for (int g = 0; g < 8; ++g) { const int ai = g >> 2, m = g & 3, cb = g & 1;
            if (g < 7) PG8_LOADG(g + 1, cb ^ 1);
            const int r = rbase + ai * HALF + m * 16; const size_t off = (size_t)r * ldc + col0; float s = 0.f;
            float* frow = FIN ? fin + (size_t)(r >> 13) * FIN_BSTRIDE + (size_t)(r & 8191) * 1024 + col0 : nullptr;
#pragma unroll
            for (int bj = 0; bj < 2; ++bj) { f32x4 o0, o1;
                if (XB) { o0 = X0[cb][bj]; o1 = X1[cb][bj]; }
                else { const u32x4 h = H[cb][bj]; o0[0] = __uint_as_float(h.x << 16); o0[1] = __uint_as_float(h.x & 0xffff0000u); o0[2] = __uint_as_float(h.y << 16); o0[3] = __uint_as_float(h.y & 0xffff0000u);
                    o1[0] = __uint_as_float(h.z << 16); o1[1] = __uint_as_float(h.z & 0xffff0000u); o1[2] = __uint_as_float(h.w << 16); o1[3] = __uint_as_float(h.w & 0xffff0000u); }
                o0 = o0 + acc[ai][bj][m][0]; o1 = o1 + acc[ai][bj][m][1];
                s += ((o0[0] * o0[0] + o0[1] * o0[1]) + (o0[2] * o0[2] + o0[3] * o0[3])) + ((o1[0] * o1[0] + o1[1] * o1[1]) + (o1[2] * o1[2] + o1[3] * o1[3]));
                if (FIN) { *(gf4*)(frow + bj * HALF) = o0; *(gf4*)(frow + bj * HALF + 4) = o1; }
                else { u32x4 nh; nh.x = cvt_pk_bf16(o0[0], o0[1]); nh.y = cvt_pk_bf16(o0[2], o0[3]); nh.z = cvt_pk_bf16(o1[0], o1[1]); nh.w = cvt_pk_bf16(o1[2], o1[3]); *(gu4*)(phi + off + bj * HALF) = nh; } }
            s = xr_sum<16>(s); s = xr_sum<32>(s);
            if (rowss && fq == 0) __hip_atomic_fetch_add(rowss + r, s, __ATOMIC_RELAXED, __HIP_MEMORY_SCOPE_AGENT);
        }
#undef PG8_LOADG
    }
    __device__ __forceinline__ void operator()(const f32x4 (&acc)[2][2][4][2], const Unit& u, int wr, int wc, int fr, int fq) const {
        if (dry) { f32x4 t = acc[0][0][0][0];
#pragma unroll
            for (int a = 0; a < 2; ++a)
#pragma unroll
                for (int b = 0; b < 2; ++b)
#pragma unroll
                    for (int m = 0; m < 4; ++m)
#pragma unroll
                        for (int n = 0; n < 2; ++n) t += acc[a][b][m][n];
            if (t[0] + t[1] + t[2] + t[3] == 1.2345e30f) phi[0] = 0; return; }
        if (fin) body<true, false>(acc, u, wr, wc, fr, fq); else if (xbase) body<false, true>(acc, u, wr, wc, fr, fq); else body<false, false>(acc, u, wr, wc, fr, fq);
    }
};

template <class Epi, class Sched, bool ALIGN_EPI = false, bool SP2 = false>
__device__ __forceinline__ void gemm_phase(PG8_LAS unsigned char* lds, const Gemm g, const Sched& S, const Epi& E, const int tid_in) {
    const int tid = tid_in, wid = __builtin_amdgcn_readfirstlane(tid >> 6), lane = tid & 63, wr = wid >> 2, wc = wid & 3, fr = lane & 15, fq = lane >> 4;
    const int K = g.K, nt = K / BK;
    unsigned voffA[2], voffB[2];
#pragma unroll
    for (int i = 0; i < 2; ++i) { int R, C; stage_rc(tid * 16 + i * 8192, R, C); const int Rb = Epi::PERM ? ((R & ~31) + perm32(R & 31)) : R;
        voffA[i] = (unsigned)(R * g.lda + C) * 2u; voffB[i] = (unsigned)(Rb * K + C) * 2u; }
    const size_t kstep = (size_t)(BK * 2);
    const size_t hstepA = (size_t)HALF * g.lda * 2, hstepB = (size_t)HALF * K * 2;
    const size_t tstepA = 2 * hstepA, tstepB = 2 * hstepB;
    const unsigned ldsw = (unsigned)wid * 1024u;
    const int aoff = lds_byte(wr * 64 + fr, fq * 8), boff = lds_byte(wc * 32 + fr, fq * 8);
#define PG8_SA(b, h) (((b) * 2 + (h)) * HTB)
#define PG8_SB(b, h) ((4 + (b) * 2 + (h)) * HTB)
#define PG8_STAGE(bufoff, gbase, voff) do { _Pragma("unroll") for (int _i = 0; _i < 2; ++_i) \
        __builtin_amdgcn_global_load_lds((const unsigned*)((const char*)(gbase) + (voff)[_i]), (PG8_LAS unsigned*)(lds + (bufoff) + ldsw + _i * 8192), 16, 0, 0); } while (0)
#define PG8_LDA(dst, b, h) do { _Pragma("unroll") for (int m = 0; m < 4; ++m) _Pragma("unroll") for (int k = 0; k < 2; ++k) dst[m][k] = *(const PG8_LAS bf16x8*)(lds + PG8_SA(b, h) + aoff + m * 2048 + k * 1024); } while (0)
#define PG8_LDB(dst, b, h) do { _Pragma("unroll") for (int n = 0; n < 2; ++n) _Pragma("unroll") for (int k = 0; k < 2; ++k) dst[n][k] = *(const PG8_LAS bf16x8*)(lds + PG8_SB(b, h) + boff + n * 2048 + k * 1024); } while (0)
#define PG8_MMA(ai, bj, At, Bt) do { __builtin_amdgcn_s_setprio(1); _Pragma("unroll") for (int m = 0; m < 4; ++m) _Pragma("unroll") for (int n = 0; n < 2; ++n) _Pragma("unroll") for (int k = 0; k < 2; ++k) \
        acc[ai][bj][m][n] = __builtin_amdgcn_mfma_f32_16x16x32_bf16(Bt[n][k], At[m][k], acc[ai][bj][m][n], 0, 0, 0); __builtin_amdgcn_s_setprio(0); } while (0)
#define PG8_WAIT_V(n) asm volatile("s_waitcnt vmcnt(" #n ")" ::: "memory")
#define PG8_WAIT_L(n) asm volatile("s_waitcnt lgkmcnt(" #n ")" ::: "memory")
#define PG8_BAR __builtin_amdgcn_s_barrier()
#define PG8_SCHED __builtin_amdgcn_sched_barrier(0)
    Unit cur, nxt; int ui = 0;
    if (!S.next(0, cur)) return;
    f32x4 acc[2][2][4][2];
#pragma unroll
    for (int a = 0; a < 2; ++a)
#pragma unroll
        for (int b = 0; b < 2; ++b)
#pragma unroll
            for (int m = 0; m < 4; ++m)
#pragma unroll
                for (int n = 0; n < 2; ++n) acc[a][b][m][n] = (f32x4){0.f, 0.f, 0.f, 0.f};
    bf16x8 At[4][2], B0[2][2], B1[2][2];
    const char* cA = (const char*)g.A + (size_t)cur.pm * tstepA; const char* cB = (const char*)g.Bt + (size_t)cur.pn * tstepB;
    S.a_ready(cur);
    if constexpr (SP2) {
        PG8_STAGE(PG8_SB(0, 0), cB, voffB); PG8_STAGE(PG8_SB(0, 1), cB + hstepB, voffB); PG8_STAGE(PG8_SA(0, 0), cA, voffA); PG8_STAGE(PG8_SA(0, 1), cA + hstepA, voffA);
        if (wr == 1) PG8_BAR;
        PG8_WAIT_V(2); PG8_BAR;
        PG8_STAGE(PG8_SB(1, 0), cB + kstep, voffB); PG8_STAGE(PG8_SA(1, 0), cA + kstep, voffA); PG8_STAGE(PG8_SB(1, 1), cB + hstepB + kstep, voffB);
        PG8_WAIT_V(6); PG8_BAR;
    } else {
        PG8_STAGE(PG8_SB(0, 0), cB, voffB); PG8_STAGE(PG8_SA(0, 0), cA, voffA); PG8_STAGE(PG8_SB(0, 1), cB + hstepB, voffB); PG8_STAGE(PG8_SA(0, 1), cA + hstepA, voffA);
        if (wr == 1) PG8_BAR;
        PG8_WAIT_V(4); PG8_BAR;
        PG8_STAGE(PG8_SB(1, 0), cB + kstep, voffB); PG8_STAGE(PG8_SA(1, 0), cA + kstep, voffA); PG8_STAGE(PG8_SB(1, 1), cB + hstepB + kstep, voffB);
        PG8_WAIT_V(6); PG8_BAR;
    }
    for (;;) {
        const bool has_next = S.next(ui + 1, nxt);
        const char* nA = has_next ? (const char*)g.A + (size_t)nxt.pm * tstepA : cA; const char* nB = has_next ? (const char*)g.Bt + (size_t)nxt.pn * tstepB : cB;
        for (int t = 0; t < nt; t += 2) {
            const bool last = (t == nt - 2);
            const char* a1 = cA + (size_t)(t + 1) * kstep;
            const char* a2 = last ? nA : cA + (size_t)(t + 2) * kstep; const char* b2 = last ? nB : cB + (size_t)(t + 2) * kstep;
            const char* a3 = a2 + kstep; const char* b3 = b2 + kstep;
            if (last && has_next) S.a_ready(nxt);
            if constexpr (SP2) {
            PG8_LDB(B0, 0, 0); PG8_LDB(B1, 0, 1); PG8_SCHED; PG8_LDA(At, 0, 0); PG8_STAGE(PG8_SA(1, 1), a1 + hstepA, voffA);
            PG8_WAIT_V(8); PG8_WAIT_L(0); PG8_BAR; PG8_MMA(0, 0, At, B0); PG8_MMA(0, 1, At, B1); PG8_BAR; PG8_SCHED;
            PG8_LDA(At, 0, 1); PG8_STAGE(PG8_SB(0, 0), b2, voffB); PG8_STAGE(PG8_SB(0, 1), b2 + hstepB, voffB); PG8_STAGE(PG8_SA(0, 0), a2, voffA);
            PG8_WAIT_V(8); PG8_WAIT_L(0); PG8_BAR; PG8_MMA(1, 0, At, B0); PG8_MMA(1, 1, At, B1); PG8_BAR; PG8_SCHED;
            PG8_LDB(B0, 1, 0); PG8_LDB(B1, 1, 1); PG8_SCHED; PG8_LDA(At, 1, 0); PG8_STAGE(PG8_SA(0, 1), a2 + hstepA, voffA);
            PG8_WAIT_V(8); PG8_WAIT_L(0); PG8_BAR; PG8_MMA(0, 0, At, B0); PG8_MMA(0, 1, At, B1); PG8_BAR; PG8_SCHED;
            PG8_LDA(At, 1, 1); PG8_STAGE(PG8_SB(1, 0), b3, voffB); PG8_STAGE(PG8_SB(1, 1), b3 + hstepB, voffB); PG8_STAGE(PG8_SA(1, 0), a3, voffA);
            PG8_WAIT_V(8); PG8_WAIT_L(0); PG8_BAR; PG8_MMA(1, 0, At, B0); PG8_MMA(1, 1, At, B1); PG8_BAR; PG8_SCHED;
            } else {
            PG8_LDB(B0, 0, 0); PG8_SCHED; PG8_LDA(At, 0, 0); PG8_STAGE(PG8_SA(1, 1), a1 + hstepA, voffA);
            PG8_WAIT_L(8); PG8_BAR; PG8_WAIT_L(0); PG8_MMA(0, 0, At, B0); PG8_BAR; PG8_SCHED;
            PG8_LDB(B1, 0, 1); PG8_STAGE(PG8_SB(0, 0), b2, voffB);
            PG8_BAR; PG8_WAIT_L(0); PG8_MMA(0, 1, At, B1); PG8_BAR;
            PG8_LDA(At, 0, 1); PG8_STAGE(PG8_SA(0, 0), a2, voffA);
            PG8_BAR; PG8_WAIT_L(0); PG8_MMA(1, 0, At, B0); PG8_BAR; PG8_SCHED;
            PG8_STAGE(PG8_SB(0, 1), b2 + hstepB, voffB);
            PG8_WAIT_V(6); PG8_BAR; PG8_MMA(1, 1, At, B1); PG8_BAR;
            PG8_LDB(B0, 1, 0); PG8_SCHED; PG8_LDA(At, 1, 0); PG8_STAGE(PG8_SA(0, 1), a2 + hstepA, voffA);
            PG8_WAIT_L(8); PG8_BAR; PG8_WAIT_L(0); PG8_MMA(0, 0, At, B0); PG8_BAR; PG8_SCHED;
            PG8_LDB(B1, 1, 1); PG8_STAGE(PG8_SB(1, 0), b3, voffB);
            PG8_BAR; PG8_WAIT_L(0); PG8_MMA(0, 1, At, B1); PG8_BAR;
            PG8_LDA(At, 1, 1); PG8_STAGE(PG8_SA(1, 0), a3, voffA);
            PG8_BAR; PG8_WAIT_L(0); PG8_MMA(1, 0, At, B0); PG8_BAR; PG8_SCHED;
            PG8_STAGE(PG8_SB(1, 1), b3 + hstepB, voffB);
            PG8_WAIT_V(6); PG8_BAR; PG8_MMA(1, 1, At, B1); PG8_BAR;
            }
        }
        if constexpr (ALIGN_EPI) { if (wr == 0) PG8_BAR; }
        if constexpr (!Epi::AFTER_DRAIN) { E(acc, cur, wr, wc, fr, fq); S.done(cur); }
        if (!has_next) break;
#pragma unroll
        for (int a = 0; a < 2; ++a)
#pragma unroll
            for (int b = 0; b < 2; ++b)
#pragma unroll
                for (int m = 0; m < 4; ++m)
#pragma unroll
                    for (int n = 0; n < 2; ++n) acc[a][b][m][n] = (f32x4){0.f, 0.f, 0.f, 0.f};
        cur = nxt; cA = nA; cB = nB; ++ui;
        if constexpr (ALIGN_EPI) { if (wr == 1) PG8_BAR; }
    }
    PG8_WAIT_V(0);
    if constexpr (!ALIGN_EPI) { if (wr == 0) PG8_BAR; }
    PG8_BAR;
    if constexpr (Epi::AFTER_DRAIN) { E.fused(acc, cur, wr, wc, fr, fq, lds, wid, lane); S.done(cur); }
#undef PG8_SA
#undef PG8_SB
#undef PG8_STAGE
#undef PG8_LDA
#undef PG8_LDB
#undef PG8_MMA
#undef PG8_WAIT_V
#undef PG8_WAIT_L
#undef PG8_BAR
#undef PG8_SCHED
}
}
namespace attn_body {
using bf16=__hip_bfloat16;
using bf16x8=__attribute__((ext_vector_type(8)))short;
using s16x4=__attribute__((ext_vector_type(4)))short;
using f32x16=__attribute__((ext_vector_type(16)))float;
using u32x4=__attribute__((ext_vector_type(4)))unsigned;
constexpr int BATCH=8,NHEAD=16,SEQ=8192,D=64,DM=NHEAD*D;
constexpr int NW=8,QBLK=32,QB=QBLK*NW,KVBLK=64,NQB=SEQ/QB;
constexpr int ATTN_PITCH=DM, ATTN_UNIT_ROWS=QB;
__device__ __forceinline__ int crow(int r,int hi){return (r&3)+8*(r>>2)+4*hi;}
#define SBAR() __builtin_amdgcn_sched_barrier(0)
__device__ __forceinline__ void cmask(f32x16&p0,f32x16&p1,int jb,int qrel,int hi){
  const float NEG=-INFINITY; int kb=64*jb+4*hi;
  #pragma unroll
  for(int r=0;r<16;++r){int kv=kb+(r&3)+8*(r>>2); if(kv>qrel)p0[r]=NEG; if(kv+32>qrel)p1[r]=NEG;}
}

constexpr int NSLOT=3, SLOTB=8192;
constexpr int LDS_K=0, LDS_V=NSLOT*SLOTB, LDS_WS=2*NSLOT*SLOTB, LDS_OST=LDS_WS+NW*64*4, LDS_BYTES=LDS_OST+NW*4096;
constexpr int LDS_C2=LDS_BYTES, LDS_REL=LDS_C2+SEQ*4;
constexpr float C2=0.125f*1.4426950408889634f;
__device__ __forceinline__ void glds16(const void*gsrc,unsigned lds_dst){unsigned keep;
  asm volatile("s_mov_b32 %0, m0\n\ts_mov_b32 m0, %2\n\ts_nop 0\n\tglobal_load_lds_dwordx4 %1, off\n\ts_mov_b32 m0, %0":"=&s"(keep):"v"(gsrc),"s"(lds_dst):"memory");}
__device__ __forceinline__ void glds16s(const void*sbase,unsigned voff,unsigned lds_dst){unsigned keep;
  asm volatile("s_mov_b32 %0, m0\n\ts_mov_b32 m0, %3\n\ts_nop 0\n\tglobal_load_lds_dwordx4 %1, %2\n\ts_mov_b32 m0, %0":"=&s"(keep):"v"(voff),"s"(sbase),"s"(lds_dst):"memory");}
__device__ __forceinline__ float max3f(float a,float b,float c){float r;asm("v_max3_f32 %0, %1, %2, %3":"=v"(r):"v"(a),"v"(b),"v"(c));return r;}
__device__ __forceinline__ float max2f(float a,float b){float r;asm("v_max_f32_e32 %0, %1, %2":"=v"(r):"v"(a),"v"(b));return r;}
__device__ __forceinline__ float fadd_s(float a,float b){float r;asm("v_add_f32_e32 %0, %1, %2":"=v"(r):"v"(a),"v"(b));return r;}
__device__ __forceinline__ float fsub_s(float a,float b){float r;asm("v_sub_f32_e32 %0, %1, %2":"=v"(r):"v"(a),"v"(b));return r;}
typedef float f32x2_t __attribute__((ext_vector_type(2))); typedef __bf16 bf16x2_t __attribute__((ext_vector_type(2)));
__device__ __forceinline__ unsigned cvtpk_s(float lo,float hi){f32x2_t v={lo,hi};bf16x2_t b=__builtin_convertvector(v,bf16x2_t);return __builtin_bit_cast(unsigned,b);}
#define WAIT_BAR(N) asm volatile("s_waitcnt vmcnt(" #N ") lgkmcnt(0)\n\ts_barrier":::"memory")

__device__ __forceinline__ void qkt(f32x16&p0,f32x16&p1,const char*Kslot,const bf16x8*qr,int r32,int hi){
  const char*kb=Kslot+hi*1024+r32*16;
  #pragma unroll
  for(int d0=0;d0<4;++d0){
    const bf16x8 b0=*reinterpret_cast<const bf16x8*>(kb+d0*2048);
    const bf16x8 b1=*reinterpret_cast<const bf16x8*>(kb+d0*2048+512);
    {p0=__builtin_amdgcn_mfma_f32_32x32x16_bf16(b0,qr[d0],p0,0,0,0);p1=__builtin_amdgcn_mfma_f32_32x32x16_bf16(b1,qr[d0],p1,0,0,0);}}
}
typedef __attribute__((address_space(3))) const char* lds_cptr;
typedef short v4i16_t __attribute__((ext_vector_type(4)));
__device__ __forceinline__ void kload8(bf16x8*kf,lds_cptr kp){
  kf[0]=*(const __attribute__((address_space(3))) bf16x8*)(kp);      kf[1]=*(const __attribute__((address_space(3))) bf16x8*)(kp+512);
  kf[2]=*(const __attribute__((address_space(3))) bf16x8*)(kp+2048); kf[3]=*(const __attribute__((address_space(3))) bf16x8*)(kp+2560);
  kf[4]=*(const __attribute__((address_space(3))) bf16x8*)(kp+4096); kf[5]=*(const __attribute__((address_space(3))) bf16x8*)(kp+4608);
  kf[6]=*(const __attribute__((address_space(3))) bf16x8*)(kp+6144); kf[7]=*(const __attribute__((address_space(3))) bf16x8*)(kp+6656);
}
__device__ __forceinline__ void kload2(bf16x8*kf,lds_cptr kp,int j){ kf[2*j]=*(const __attribute__((address_space(3))) bf16x8*)(kp+j*2048); kf[2*j+1]=*(const __attribute__((address_space(3))) bf16x8*)(kp+j*2048+512); }
__device__ __forceinline__ s16x4 vtr(lds_cptr p){ return __builtin_bit_cast(s16x4,__builtin_amdgcn_ds_read_tr16_b64_v4i16((__attribute__((address_space(3))) v4i16_t*)p)); }
__device__ __forceinline__ float rowmax(const f32x16&p0,const f32x16&p1){
  float a=max3f(p0[0],p0[1],p1[0]),b=max3f(p0[2],p0[3],p1[1]);a=max3f(a,p1[2],p1[3]);
  #pragma unroll
  for(int r=4;r<16;r+=4){a=max3f(a,p0[r],p0[r+1]);b=max3f(b,p0[r+2],p0[r+3]);a=max3f(a,p1[r],p1[r+1]);b=max3f(b,p1[r+2],p1[r+3]);}
  const float m=max2f(a,b);
  auto rr=__builtin_amdgcn_permlane32_swap(__float_as_uint(m),__float_as_uint(m),false,false);
  return max2f(__uint_as_float(rr[0]),__uint_as_float(rr[1]));
}
__device__ __forceinline__ void pv(f32x16*o,int vb,bf16x8 pa0,bf16x8 pa1,bf16x8 pa2,bf16x8 pa3){
  #pragma unroll
  for(int d0=0;d0<2;++d0){s16x4 lo[4],hi[4];
    #pragma unroll
    for(int ks=0;ks<4;++ks){
      asm volatile("ds_read_b64_tr_b16 %0,%1 offset:%c2":"=&v"(lo[ks]):"v"(vb),"i"(d0*4096+ks*1024):"memory");
      asm volatile("ds_read_b64_tr_b16 %0,%1 offset:%c2":"=&v"(hi[ks]):"v"(vb),"i"(d0*4096+ks*1024+512):"memory");}
    asm volatile("s_waitcnt lgkmcnt(0)":::"memory");SBAR();
    #define PK(k) (bf16x8){lo[k][0],lo[k][1],lo[k][2],lo[k][3],hi[k][0],hi[k][1],hi[k][2],hi[k][3]}
    o[d0]=__builtin_amdgcn_mfma_f32_32x32x16_bf16(pa0,PK(0),o[d0],0,0,0);
    o[d0]=__builtin_amdgcn_mfma_f32_32x32x16_bf16(pa1,PK(1),o[d0],0,0,0);
    o[d0]=__builtin_amdgcn_mfma_f32_32x32x16_bf16(pa2,PK(2),o[d0],0,0,0);
    o[d0]=__builtin_amdgcn_mfma_f32_32x32x16_bf16(pa3,PK(3),o[d0],0,0,0);
    #undef PK
  }
}

#ifndef ATTN_STORE16
#define ATTN_STORE16(p,v) (*(u32x4*)(p)=(v))
#endif
typedef float f32x4_t __attribute__((ext_vector_type(4)));
__device__ __forceinline__ unsigned split2(float v,float&eff){ unsigned w=cvtpk_s(v,0.f); const float h=__uint_as_float(w<<16); w=cvtpk_s(v,fsub_s(v,h)); eff=fadd_s(h,__uint_as_float(w&0xffff0000u)); return w; }
template<int THRL> __device__ __forceinline__ void attn_unit(int b,int h,int qb,const bf16*Q,const bf16*__restrict__ K,const bf16*__restrict__ V,bf16*O,const bf16*__restrict__ Gt,const float*__restrict__ CL,const float*__restrict__ TOT,const float*__restrict__ NRM,char*shm,const int tid_in,unsigned*qown,const unsigned qbase){
  const int tid=tid_in,lane=tid&63,r32=lane&31,hi=lane>>5; const int wid=__builtin_amdgcn_readfirstlane(tid>>6);
  const long rowbase=(long)b*SEQ; const int q0=qb*QB;
  const bf16*Qw=Q+(rowbase+q0+wid*QBLK)*DM+h*D;
  const bf16*Kh=K+rowbase*DM+h*D,*Vh=V+rowbase*DM+h*D;
  const lds_cptr shm3=(lds_cptr)shm;
  const unsigned lds0=(unsigned)(uintptr_t)shm;
  float*wsf=(float*)(shm+LDS_WS)+wid*64;
  const unsigned koff=(unsigned)((lane*DM+wid*8)*2);
  const unsigned voff=(unsigned)(((16*(wid&3)+(lane>>2))*DM+(wid>>2)*32+(lane&3)*8)*2);
  const unsigned kdst=lds0+LDS_K+wid*1024, vdst=lds0+LDS_V+wid*1024;
  #define DMA_K(t,slot) glds16s(Kh+(long)(t)*KVBLK*DM,koff,(unsigned)__builtin_amdgcn_readfirstlane(kdst+(slot)))
  #define DMA_V(t,slot) glds16s(Vh+(long)(t)*KVBLK*DM,voff,(unsigned)__builtin_amdgcn_readfirstlane(vdst+(slot)))
  const char*Kbase=shm+LDS_K; bf16x8 kf[8];
  const lds_cptr kp0=shm3+LDS_K+hi*1024+r32*16; const lds_cptr vp0=shm3+LDS_V+((lane>>4)&1)*32+(lane&3)*8+(4*hi+((lane&15)>>2))*64;
  bf16x8 qr[4];
  #pragma unroll
  for(int d0=0;d0<4;++d0)qr[d0]=*reinterpret_cast<const bf16x8*>(&Qw[(long)r32*DM+d0*16+hi*8]);
  float cq2; int t_start;
  { typedef __attribute__((address_space(3))) float lf32; lf32*relL=(lf32*)(shm3+LDS_REL); __attribute__((address_space(3))) unsigned*c2P=(__attribute__((address_space(3))) unsigned*)(shm3+LDS_C2);
    float tv=0.f,nk0=0.f,nk1=0.f,nq0=0.f,nq1=0.f,nq2=0.f,nq3=0.f;
    const float cqraw=CL[(long)(b*NHEAD+h)*SEQ+q0+wid*QBLK+r32];
    f32x4_t cv_[4]; const int pend_=((q0+QB)/KVBLK)*16-1-tid;
    { const float*clp0=CL+(long)(b*NHEAD+h)*SEQ;
      #pragma unroll
      for(int k_=0;k_<4;++k_){ const int p_=pend_-k_*NW*64; cv_[k_]=*(const f32x4_t*)(clp0+4*(p_>=0?p_:0)); } }
    if(wid==0){ tv=TOT[(b*NHEAD+h)*64+lane]; const float*nq=NRM+(long)((0*BATCH+b)*NHEAD+h)*128,*nk=NRM+(long)((1*BATCH+b)*NHEAD+h)*128; nk0=nk[2*lane]; nk1=nk[2*lane+1]; nq0=nq[4*qb]; nq1=nq[4*qb+1]; nq2=nq[4*qb+2]; nq3=nq[4*qb+3]; }
    { const bf16*Kd=K+(rowbase+q0+wid*QBLK+r32)*DM+h*D+hi*8; float dot=0.f; bf16x8 kd[4];
      #pragma unroll
      for(int d0=0;d0<4;++d0)kd[d0]=*reinterpret_cast<const bf16x8*>(Kd+d0*16);
      asm volatile("":"+v"(kd[0]),"+v"(kd[1]),"+v"(kd[2]),"+v"(kd[3]));
      #pragma unroll
      for(int d0=0;d0<4;++d0){
        #pragma unroll
        for(int e=0;e<8;++e)dot+=__uint_as_float((unsigned)(unsigned short)qr[d0][e]<<16)*__uint_as_float((unsigned)(unsigned short)kd[d0][e]<<16); }
      dot=xr_sum<32>(dot);
      dot=xr_min<16>(dot); dot=xr_min<8>(dot); dot=xr_min<4>(dot); dot=xr_min<2>(dot); dot=xr_min<1>(dot);
      if(lane==0)relL[66+wid]=dot; }
    __syncthreads();
    if(wid==0){ float inc=tv;
      _Pragma("unroll") for(int o_=1;o_<64;o_<<=1){ const float y_=xl_from_lane(inc,lane-o_); if(lane>=o_)inc+=y_; }
      const float exc=inc-tv; const float eref=__builtin_bit_cast(float,__builtin_amdgcn_readlane(__builtin_bit_cast(int,exc),2*qb)); relL[lane]=exc-eref;
      const float bk2=nk0+nk1; const float bq2=__builtin_fmaxf(nq0+nq1,nq2+nq3);
      float smin=relL[66]; _Pragma("unroll") for(int w_=1;w_<NW;++w_)smin=__builtin_fminf(smin,relL[66+w_]);
      const float Bj=sqrtf(bq2*bk2)*1.02f,Dj=(inc-eref)*1.4426950408889634f;
      const bool keep=(lane>=2*qb)||!(Dj>=Bj-smin+30.5f);
      const unsigned long long km=__ballot(keep); const int bs_=__ffsll((long long)km)-1; if(lane==0)((__attribute__((address_space(3))) int*)relL)[64]=bs_; }
    __syncthreads();
    const int bs=__builtin_amdgcn_readfirstlane(((__attribute__((address_space(3))) int*)relL)[64]); t_start=2*bs;
    const int NTl=(q0+QB)/KVBLK-t_start;
    { asm volatile("":"+v"(cv_[0]),"+v"(cv_[1]),"+v"(cv_[2]),"+v"(cv_[3]));
      #pragma unroll
      for(int k_=0;k_<4;++k_){ const int p_=pend_-k_*NW*64; if(p_>=32*bs){ const int i_=p_-32*bs; const f32x4_t v_=cv_[k_]; const float rl_=relL[p_>>5]; float e_;
        u32x4 w_; w_.x=split2((v_.x+rl_)*-1.4426950408889634f,e_); w_.y=split2((v_.y+rl_)*-1.4426950408889634f,e_); w_.z=split2((v_.z+rl_)*-1.4426950408889634f,e_); w_.w=split2((v_.w+rl_)*-1.4426950408889634f,e_);
        *(__attribute__((address_space(3))) u32x4*)(c2P+4*i_)=w_; } } }
    cq2=(cqraw+relL[2*qb+(wid>>2)])*1.4426950408889634f;
    __syncthreads(); }
  Kh+=(long)t_start*KVBLK*DM; Vh+=(long)t_start*KVBLK*DM;
  const int NT=(q0+QB)/KVBLK-t_start;
  const __attribute__((address_space(3))) unsigned* c2f=(const __attribute__((address_space(3))) unsigned*)(shm3+LDS_C2)+r32;
  unsigned qxw;
  #define QX() __builtin_bit_cast(bf16x8,(u32x4){hi?0u:0x3f803f80u,hi?0u:qxw,0u,0u})
  #define KEXT(KX0,KX1,t) do{ const unsigned wa_=c2f[(t)*64], wb_=c2f[(t)*64+32]; KX0=__builtin_bit_cast(bf16x8,(u32x4){wa_,0x3f803f80u,0u,0u}); KX1=__builtin_bit_cast(bf16x8,(u32x4){wb_,0x3f803f80u,0u,0u}); }while(0)
  DMA_K(0,0);DMA_V(0,0);DMA_K(1,SLOTB);
  float mhat,l_reg=0.f;f32x16 o[2];o[0]=f32x16{};o[1]=f32x16{}; { float e_; qxw=split2(cq2,e_); mhat=-e_; } const f32x16 zero16=f32x16{};
  const int qrel=wid*QBLK+r32;
  #define CMASK(P0,P1,t) do{int jb_=(t)-(NT-4); if(jb_>=0)cmask(P0,P1,jb_,qrel,hi);}while(0)
  bool resc=false;
  #define START(P0,P1) do{ const float rm=rowmax(P0,P1); resc=false; \
    { float e_; qxw=split2(-fadd_s(mhat,rm),e_); const float dl=fsub_s(-e_,mhat); mhat=-e_; \
      _Pragma("unroll") for(int r=0;r<16;++r){P0[r]=fsub_s(P0[r],dl);P1[r]=fsub_s(P1[r],dl);} } \
    _Pragma("unroll") for(int r=0;r<16;++r)P0[r]=__builtin_amdgcn_exp2f(P0[r]); }while(0)
  #define RESC() do{ if(resc){ asm volatile("s_waitcnt lgkmcnt(0)":::"memory"); \
      _Pragma("unroll") for(int d_=0;d_<2;++d_) _Pragma("unroll") for(int r=0;r<16;++r)o[d_][r]*=wsf[crow(r,hi)]; } }while(0)
  f32x16 pA0,pA1,pB0,pB1;
  int sl_prev=0,sl_cur=0,sl_next=SLOTB;
  #define ROT() do{sl_prev=sl_cur;sl_cur=sl_next;sl_next=(sl_next==(NSLOT-1)*SLOTB)?0:sl_next+SLOTB;}while(0)
  DMA_K(2,2*SLOTB);
  WAIT_BAR(3);
  { bf16x8 kx0_,kx1_; KEXT(kx0_,kx1_,0); const bf16x8 qx_=QX(); pA0=__builtin_amdgcn_mfma_f32_32x32x16_bf16(kx0_,qx_,zero16,0,0,0); pA1=__builtin_amdgcn_mfma_f32_32x32x16_bf16(kx1_,qx_,zero16,0,0,0); }
  qkt(pA0,pA1,Kbase,qr,r32,hi);asm volatile("s_nop 15\n\ts_nop 7":"+v"(pA0),"+v"(pA1));CMASK(pA0,pA1,0);
  START(pA0,pA1);
  _Pragma("unroll") for(int r=0;r<16;++r)pA1[r]=__builtin_amdgcn_exp2f(pA1[r]);
  WAIT_BAR(0);
  DMA_K(3,0);DMA_V(1,SLOTB);
  ROT();
  kload8(kf,kp0+sl_cur);
  WAIT_BAR(2);
  s16x4 vlo[8],vhi[8]; u32x4 pw0,pw1,pw2,pw3;
  #define PKW(P,B) cvtpk_s(P[B],P[B+1])
  #define PAF(k) __builtin_bit_cast(bf16x8,pw##k)
  #define VFR(i) (bf16x8){vlo[i][0],vlo[i][1],vlo[i][2],vlo[i][3],vhi[i][0],vhi[i][1],vhi[i][2],vhi[i][3]}
  #define PIN(x) asm volatile("":"+v"(x))
  #define MX3(a,b,c) __builtin_fmaxf(__builtin_fmaxf((a),(b)),(c))
  #define GAPA(MF,A0,A1,A2,A3,W0,W1,PW) do{ MF; sacc+=A0; sacc+=A1; sacc+=A2; sacc+=A3; PIN(sacc); W0; W1; PIN(PW); SBAR(); }while(0)
  #define EX(v) __builtin_amdgcn_exp2f(v)
  #define GAPB(MF,X,B) do{ MF; X[B]=EX(X[B]); X[B+1]=EX(X[B+1]); X[B+2]=EX(X[B+2]); X[B+3]=EX(X[B+3]); PIN(X); SBAR(); }while(0)
  #define VRD(i) do{ vlo[i]=vtr(vp_+(((i)>>2)*4096+((i)&3)*1024)); vhi[i]=vtr(vp_+(((i)>>2)*4096+((i)&3)*1024+512)); }while(0)
  #define KRD(G,j) do{ if(G){ kload2(kf,kp0+sl_next,j); SBAR(); } }while(0)
  #define STEP(C0,C1,P0,P1,t,GK,GV,GL) do{ SBAR(); \
    { bf16x8 kx0_,kx1_; KEXT(kx0_,kx1_,t); const bf16x8 qx_=QX(); C0=__builtin_amdgcn_mfma_f32_32x32x16_bf16(kx0_,qx_,zero16,0,0,0); C1=__builtin_amdgcn_mfma_f32_32x32x16_bf16(kx1_,qx_,zero16,0,0,0); } SBAR(); \
    const lds_cptr vp_=vp0+sl_prev; \
    VRD(0); SBAR(); float sacc=(P0[0]+P0[1]); \
    GAPA(C0=__builtin_amdgcn_mfma_f32_32x32x16_bf16(kf[0],qr[0],C0,0,0,0), P0[2],P0[3],P0[4],P0[5],     pw0[0]=PKW(P0,0), pw0[1]=PKW(P0,2), pw0); \
    VRD(4); SBAR(); GAPA(C1=__builtin_amdgcn_mfma_f32_32x32x16_bf16(kf[1],qr[0],C1,0,0,0), P0[6],P0[7],P0[8],P0[9],     pw0[2]=PKW(P0,4), pw0[3]=PKW(P0,6), pw0); \
    VRD(1); SBAR(); GAPA(C0=__builtin_amdgcn_mfma_f32_32x32x16_bf16(kf[2],qr[1],C0,0,0,0),   P0[10],P0[11],P0[12],P0[13], pw1[0]=PKW(P0,8), pw1[1]=PKW(P0,10), pw1); \
    VRD(5); SBAR(); GAPA(C1=__builtin_amdgcn_mfma_f32_32x32x16_bf16(kf[3],qr[1],C1,0,0,0),   P0[14],P0[15],P1[0],P1[1],   pw1[2]=PKW(P0,12),pw1[3]=PKW(P0,14), pw1); \
    VRD(2); SBAR(); GAPA(C0=__builtin_amdgcn_mfma_f32_32x32x16_bf16(kf[4],qr[2],C0,0,0,0),   P1[2],P1[3],P1[4],P1[5],     pw2[0]=PKW(P1,0), pw2[1]=PKW(P1,2), pw2); \
    VRD(6); SBAR(); GAPA(C1=__builtin_amdgcn_mfma_f32_32x32x16_bf16(kf[5],qr[2],C1,0,0,0),   P1[6],P1[7],P1[8],P1[9],     pw2[2]=PKW(P1,4), pw2[3]=PKW(P1,6), pw2); \
    VRD(3); SBAR(); GAPA(C0=__builtin_amdgcn_mfma_f32_32x32x16_bf16(kf[6],qr[3],C0,0,0,0),   P1[10],P1[11],P1[12],P1[13], pw3[0]=PKW(P1,8), pw3[1]=PKW(P1,10), pw3); \
    VRD(7); SBAR(); GAPA(C1=__builtin_amdgcn_mfma_f32_32x32x16_bf16(kf[7],qr[3],C1,0,0,0),   P1[14],P1[15],0.f,0.f,       pw3[2]=PKW(P1,12),pw3[3]=PKW(P1,14), pw3); \
    l_reg+=sacc; \
    if(GK){DMA_K((t)+3,sl_cur);} if(GV){DMA_V((t)+1,sl_next);} \
    CMASK(C0,C1,t); \
    { float a=MX3(C0[0],C0[1],C1[0]),b=MX3(C0[2],C0[3],C1[1]); a=MX3(a,C1[2],C1[3]); \
      _Pragma("unroll") for(int r=4;r<16;r+=4){a=MX3(a,C0[r],C0[r+1]);b=MX3(b,C0[r+2],C0[r+3]);a=MX3(a,C1[r],C1[r+1]);b=MX3(b,C1[r+2],C1[r+3]);} \
      float rm=__builtin_fmaxf(a,b); { auto rr=__builtin_amdgcn_permlane32_swap(__float_as_uint(rm),__float_as_uint(rm),false,false); rm=__builtin_fmaxf(__uint_as_float(rr[0]),__uint_as_float(rr[1])); } \
      resc=false; \
      if(__builtin_expect(__any(rm>(float)THRL),0)){ float e_; qxw=split2(-(mhat+__builtin_fmaxf(rm,0.f)),e_); const float dl=-e_-mhat; mhat=-e_; \
        _Pragma("unroll") for(int r=0;r<16;++r){C0[r]-=dl;C1[r]-=dl;} \
        const float f=__builtin_amdgcn_exp2f(-dl); l_reg*=f; if(hi==0)wsf[r32]=f; resc=true; } } \
    SBAR(); \
    GAPB(o[0]=__builtin_amdgcn_mfma_f32_32x32x16_bf16(PAF(0),VFR(0),o[0],0,0,0), C0,0); \
    GAPB(o[1]=__builtin_amdgcn_mfma_f32_32x32x16_bf16(PAF(0),VFR(4),o[1],0,0,0), C0,4); \
    KRD(GL,0); GAPB(o[0]=__builtin_amdgcn_mfma_f32_32x32x16_bf16(PAF(1),VFR(1),o[0],0,0,0), C0,8); \
    KRD(GL,1); GAPB(o[1]=__builtin_amdgcn_mfma_f32_32x32x16_bf16(PAF(1),VFR(5),o[1],0,0,0), C0,12); \
    KRD(GL,2); GAPB(o[0]=__builtin_amdgcn_mfma_f32_32x32x16_bf16(PAF(2),VFR(2),o[0],0,0,0), C1,0); \
    KRD(GL,3); GAPB(o[1]=__builtin_amdgcn_mfma_f32_32x32x16_bf16(PAF(2),VFR(6),o[1],0,0,0), C1,4); \
    GAPB(o[0]=__builtin_amdgcn_mfma_f32_32x32x16_bf16(PAF(3),VFR(3),o[0],0,0,0), C1,8); \
    GAPB(o[1]=__builtin_amdgcn_mfma_f32_32x32x16_bf16(PAF(3),VFR(7),o[1],0,0,0), C1,12); \
    }while(0)
  int t=1;
  #undef CMASK
  #define CMASK(P0,P1,t) do{}while(0)
  for(;t+5<NT;t+=2){
    STEP(pB0,pB1,pA0,pA1,t,true,true,true);     WAIT_BAR(2); RESC(); ROT();
    STEP(pA0,pA1,pB0,pB1,t+1,true,true,true);   WAIT_BAR(2); RESC(); ROT();
  }
  #undef CMASK
  #define CMASK(P0,P1,t) do{int jb_=(t)-(NT-4); if(jb_>=0)cmask(P0,P1,jb_,qrel,hi);}while(0)
  #define ENDW(tt) do{ if((tt)+3<NT){WAIT_BAR(2);} else if((tt)+2<NT){WAIT_BAR(1);} else {WAIT_BAR(0);} }while(0)
  for(;t+1<NT;t+=2){
    STEP(pB0,pB1,pA0,pA1,t,(t+3<NT),(t+1<NT),(t+1<NT));       ENDW(t);   RESC(); ROT();
    STEP(pA0,pA1,pB0,pB1,t+1,(t+4<NT),(t+2<NT),(t+2<NT));     ENDW(t+1); RESC(); ROT();
  }
  STEP(pB0,pB1,pA0,pA1,NT-1,false,false,false); RESC();
  { float sacc=pB0[0]+pB0[1]; _Pragma("unroll") for(int r=2;r<16;++r)sacc+=pB0[r]; _Pragma("unroll") for(int r=0;r<16;++r)sacc+=pB1[r]; l_reg+=sacc;
    pw0=(u32x4){PKW(pB0,0),PKW(pB0,2),PKW(pB0,4),PKW(pB0,6)};pw1=(u32x4){PKW(pB0,8),PKW(pB0,10),PKW(pB0,12),PKW(pB0,14)};pw2=(u32x4){PKW(pB1,0),PKW(pB1,2),PKW(pB1,4),PKW(pB1,6)};pw3=(u32x4){PKW(pB1,8),PKW(pB1,10),PKW(pB1,12),PKW(pB1,14)};
    const int vb0=(int)(lds0+LDS_V)+((lane>>4)&1)*32+(lane&3)*8+(4*hi+((lane&15)>>2))*64;
    SBAR(); pv(o,vb0+sl_cur,PAF(0),PAF(1),PAF(2),PAF(3)); }
  #undef PKW
  #undef PAF
  #undef VFR
  #undef PIN
  #undef MX3
  #undef GAPA
  #undef GAPB
  #undef EX
  #undef VRD
  #undef KRD
  #undef STEP
  #undef ENDW
  unsigned nxt_=0u; if(tid==0)nxt_=__hip_atomic_fetch_add(qown,1u,__ATOMIC_RELAXED,__HIP_MEMORY_SCOPE_AGENT);
  {auto rr=__builtin_amdgcn_permlane32_swap(__float_as_uint(l_reg),__float_as_uint(l_reg),false,false);l_reg=__uint_as_float(rr[0])+__uint_as_float(rr[1]);}
  if(hi==0)wsf[32+r32]=l_reg;asm volatile("s_waitcnt lgkmcnt(0)":::"memory");
  float rli[16];
  #pragma unroll
  for(int r=0;r<16;++r)rli[r]=__builtin_amdgcn_rcpf(wsf[32+crow(r,hi)]);
  bf16*Ow=O+(rowbase+q0+wid*QBLK)*DM+h*D;
  { bf16*stg=(bf16*)(shm+LDS_OST)+wid*2048;
    #pragma unroll
    for(int r=0;r<16;++r){const int orow=crow(r,hi);
      #pragma unroll
      for(int d0=0;d0<2;++d0)stg[orow*64+d0*32+r32]=__float2bfloat16(o[d0][r]*rli[r]);}
    asm volatile("s_waitcnt lgkmcnt(0)":::"memory");
    int le_=lane; asm volatile("":"+v"(le_));
    #pragma unroll
    for(int i=0;i<4;++i){const int row=i*8+(le_>>3),ch=le_&7; const u32x4 v=*(const u32x4*)(stg+row*64+ch*8); const u32x4 gv=*(const u32x4*)(Gt+(rowbase+q0+wid*QBLK+row)*DM+h*D+ch*8); u32x4 w;
      #pragma unroll
      for(int e=0;e<4;++e){ const float o0=__uint_as_float(v[e]<<16),o1=__uint_as_float(v[e]&0xffff0000u),g0=__uint_as_float(gv[e]<<16),g1=__uint_as_float(gv[e]&0xffff0000u);
        const float s0=g0*__builtin_amdgcn_rcpf(1.f+__builtin_amdgcn_exp2f(-1.4426950408889634f*g0)),s1=g1*__builtin_amdgcn_rcpf(1.f+__builtin_amdgcn_exp2f(-1.4426950408889634f*g1)); w[e]=cvtpk_s(o0*s0,o1*s1); }
      ATTN_STORE16(Ow+(long)row*DM+ch*8,w);} }
  if(tid==0)((__attribute__((address_space(3))) unsigned*)(shm3+LDS_REL))[65]=(nxt_<512u)?(qbase+nxt_):0xfffffffeu;
  asm volatile("s_waitcnt lgkmcnt(0)\n\ts_barrier":::"memory");
  #undef KEXT
  #undef QX
  #undef DMA_K
  #undef DMA_V
  #undef CMASK
  #undef START
  #undef RESC
  #undef ROT
}
constexpr int ATTN_LDS_BYTES=LDS_REL+512;
struct AttnTensors { const bf16* Q; const bf16* K; const bf16* V; bf16* O; const bf16* G; const float* CL; const float* TOT; const float* NRM; };
struct AttnUnit { int bh; int qb; };
struct DynOrder {
  unsigned*qhead; int xcc,wid0; __attribute__((address_space(3))) unsigned*slot;
  __device__ __forceinline__ int fresh_tid()const{ int t; asm volatile("v_mbcnt_lo_u32_b32 %0, -1, 0\n\tv_mbcnt_hi_u32_b32 %0, -1, %0":"=v"(t)); return t+wid0*64; }
  __device__ __forceinline__ bool next(int,AttnUnit&u)const{
    unsigned v=*slot;
    if(v==0xfffffffeu){ __syncthreads();
      if(fresh_tid()==0){ unsigned w=0xffffffffu; for(int k=0;k<8;++k){ const int qx=(xcc+k)&7; const unsigned n=__hip_atomic_fetch_add(qhead+64*qx,1u,__ATOMIC_RELAXED,__HIP_MEMORY_SCOPE_AGENT); if(n<512u){w=(unsigned)qx*512u+n;break;} } *slot=w; }
      __syncthreads(); v=*slot; }
    if(v==0xffffffffu)return false;
    const int qx=(int)(v>>9),n=(int)(v&511u),g=3-(n>>7); u.bh=qx*NHEAD+((n>>3)&15); u.qb=8*g+7-(n&7); return true; }
  __device__ __forceinline__ void a_ready(const AttnUnit&)const{}
  __device__ __forceinline__ void done(const AttnUnit&)const{}
};
template<class Sched,int THRL=8> __device__ __forceinline__ void attn_phase(char*lds,const AttnTensors&T,const Sched&S){
  AttnUnit u;
  for(int i=0;S.next(i,u);++i){ S.a_ready(u); attn_unit<THRL>(u.bh/NHEAD,u.bh%NHEAD,u.qb,T.Q,T.K,T.V,T.O,T.G,T.CL,T.TOT,T.NRM,lds,S.fresh_tid(),S.qhead+64*S.xcc,(unsigned)S.xcc*512u); S.done(u); }
}
#undef SBAR
#undef WAIT_BAR
}
#define GAS __attribute__((address_space(1)))
#define LAS __attribute__((address_space(3)))
typedef unsigned short bf16;
typedef unsigned v4u __attribute__((ext_vector_type(4)));
typedef float f32x4 __attribute__((ext_vector_type(4)));
typedef float f32x16 __attribute__((ext_vector_type(16)));
typedef short bf16x8 __attribute__((ext_vector_type(8)));
typedef short s16x4 __attribute__((ext_vector_type(4)));
constexpr int NWAVES = 8, NTHR = 512;
constexpr int NB = 8, SQ = 8192, DM = 1024, MT = NB * SQ;
constexpr int FOX_IN = 4112, KVW = 6144, BIN = 4096;
constexpr float LOG2E = 1.4426950408889634f;
constexpr float C2A = 0.125f * LOG2E;
constexpr float C2B = 0.08838834764831845f * LOG2E;
constexpr size_t MiB = 1u << 20;
constexpr size_t WS_RS1 = 0, WS_RS2 = 256 * 1024, WS_RS3 = 512 * 1024, CTL_ZERO_BYTES = 1 * MiB + 8192 + 16384;
constexpr size_t WS_NRM = 768 * 1024, WS_QH = 1024 * 1024;
constexpr size_t WS_BAR = 1 * MiB + 8192;
constexpr size_t WS_RS0 = 1 * MiB + 64 * 1024;
constexpr size_t WS_WINA = 2 * MiB, WS_WOUTA = 18 * MiB, WS_WKV = 22 * MiB, WS_WINB = 34 * MiB, WS_WOUTB = 50 * MiB, WS_WF = 54 * MiB;
constexpr size_t WS_Q = 184 * MiB, WS_K = 312 * MiB, WS_V = 440 * MiB, WS_G = 568 * MiB, WS_CL = 696 * MiB, WS_TOT = 700 * MiB, WS_O = 704 * MiB;
constexpr size_t WS_KV = 184 * MiB;
constexpr size_t WS_U = 56 * MiB;
constexpr size_t WS_LSE = 952 * MiB, WS_MA = 956 * MiB, WS_END = 1020 * MiB; constexpr int U_SPLIT_ROWS = 16384;
constexpr size_t U_BYTES_PER_BATCH = (size_t)SQ * BIN * 2, LSE_BYTES_PER_BATCH = (size_t)SQ * 24 * 4;
constexpr int RING_BYTES = 131072, LDS_BYTES = 147456;

__device__ __forceinline__ unsigned f2bf(float f) { unsigned u = __builtin_bit_cast(unsigned, f); return (u + 0x7fffu + ((u >> 16) & 1u)) >> 16; }
__device__ __forceinline__ unsigned pk2(float lo, float hi) { return f2bf(lo) | (f2bf(hi) << 16); }
typedef float f32x2_t __attribute__((ext_vector_type(2))); typedef __bf16 bf16x2_t __attribute__((ext_vector_type(2)));
__device__ __forceinline__ unsigned cvtpk(float lo, float hi) { f32x2_t v = {lo, hi}; bf16x2_t b = __builtin_convertvector(v, bf16x2_t); return __builtin_bit_cast(unsigned, b); }
__device__ __forceinline__ float bflo(unsigned w) { return __uint_as_float(w << 16); }
__device__ __forceinline__ float bfhi(unsigned w) { return __uint_as_float(w & 0xffff0000u); }
__device__ __forceinline__ float wave_sum(float v) {
    v = xr_sum<1>(v); v = xr_sum<2>(v); v = xr_sum<4>(v); v = xr_sum<8>(v); v = xr_sum<16>(v); v = xr_sum<32>(v);
    return v;
}
__device__ __forceinline__ float silu_f(float g) { return g * __builtin_amdgcn_rcpf(1.f + __builtin_amdgcn_exp2f(-LOG2E * g)); }

__device__ __forceinline__ void p0_transpose_item(const float* W, int K, int ldw, int nblk, const float* gain, bf16* WT, LAS float* scr, int item, int lane) {
    const int kb = item / nblk, nb = item % nblk, k0 = 64 * kb, n0 = 32 * nb;
    float wv_[32], gv_[32];
#pragma unroll
    for (int i = 0; i < 32; ++i) { const int kk = 2 * i + (lane >> 5); wv_[i] = W[(size_t)(k0 + kk) * ldw + n0 + (lane & 31)]; gv_[i] = gain ? gain[k0 + kk] : 1.f; }
#pragma unroll
    for (int i = 0; i < 32; ++i) { const int kk = 2 * i + (lane >> 5); scr[kk * 33 + (lane & 31)] = gv_[i] * wv_[i]; }
    asm volatile("s_waitcnt lgkmcnt(0)" ::: "memory");
    const int c = lane & 7;
#pragma unroll
    for (int j = 0; j < 4; ++j) { const int n = (lane >> 3) + 8 * j; const LAS float* s = scr + (8 * c) * 33 + n;
        v4u o; o.x = pk2(s[0 * 33], s[1 * 33]); o.y = pk2(s[2 * 33], s[3 * 33]); o.z = pk2(s[4 * 33], s[5 * 33]); o.w = pk2(s[6 * 33], s[7 * 33]);
        *(GAS v4u*)(WT + (size_t)(n0 + n) * K + k0 + 8 * c) = o; }
    asm volatile("s_waitcnt lgkmcnt(0)" ::: "memory");
}

#define RLX_AGENT __ATOMIC_RELAXED, __HIP_MEMORY_SCOPE_AGENT
#define XB_TMO      128
#define XB_XCNT(j)  (256  + 64 * (j))
#define XB_XSUB(j)  (1280 + 64 * (j))
#define XB_XGEN(j)  (2304 + 64 * (j))
#define XB_TOP      3328
#define XB_TOPGEN   3392
#define XCD_BAR_WORDS 3456
#define XB_SPIN_CAP (1u << 18)

__device__ __forceinline__ unsigned xb_ld(unsigned* p)              { return __hip_atomic_load(p, __ATOMIC_RELAXED, __HIP_MEMORY_SCOPE_AGENT); }
__device__ __forceinline__ unsigned xb_add(unsigned* p, unsigned v) { return __hip_atomic_fetch_add(p, v, __ATOMIC_RELAXED, __HIP_MEMORY_SCOPE_AGENT); }
__device__ __forceinline__ unsigned xb_xcc_id() { return (unsigned)__builtin_amdgcn_s_getreg((3 << 11) | 20) & 0xFu; }
#define XB_SPIN(cond, bar) do { unsigned _sp = 0; while (cond) { __builtin_amdgcn_s_sleep(1); \
    if ((++_sp & 255u) == 0u) { if (xb_ld(&(bar)[XB_TMO])) break; if (_sp > XB_SPIN_CAP) { atomicAdd(&(bar)[XB_TMO], 1u); break; } } } } while (0)

struct XcdBarrier {
    unsigned* bar; unsigned x;
    volatile LAS unsigned* st;
};

__device__ __forceinline__ XcdBarrier xcd_barrier_post(unsigned* bar, volatile LAS unsigned* st) {
    XcdBarrier b; b.bar = bar; b.x = xb_xcc_id(); b.st = st;
    if (threadIdx.x == 0) (void)xb_add(&bar[XB_XCNT(b.x)], 1u);
    return b;
}
__device__ __forceinline__ void xcd_barrier_complete(unsigned* bar, unsigned x, unsigned& nloc, unsigned& nx) {
    const unsigned G = gridDim.x * gridDim.y * gridDim.z;
    unsigned sum, cnt, mine, sp = 0u;
    for (;;) {
        sum = 0u; cnt = 0u; mine = 0u;
#pragma unroll
        for (unsigned j = 0; j < 16; ++j) { const unsigned c = xb_ld(&bar[XB_XCNT(j)]); sum += c; cnt += (c > 0u) ? 1u : 0u; mine = (j == x) ? c : mine; }
        if (sum == G) break;
        __builtin_amdgcn_s_sleep(1);
        if ((++sp & 255u) == 0u) { if (xb_ld(&bar[XB_TMO])) break; if (sp > XB_SPIN_CAP) { atomicAdd(&bar[XB_TMO], 1u); break; } }
    }
    nloc = mine > 0u ? mine : 1u; nx = cnt > 0u ? cnt : 1u;
}

__device__ __forceinline__ void xcd_barrier(const XcdBarrier& b) {
    asm volatile("s_waitcnt vmcnt(0)" ::: "memory");
    __syncthreads();
    if (threadIdx.x == 0) {
        unsigned* bar = b.bar;
        __builtin_amdgcn_s_waitcnt(0);
        unsigned nloc = b.st[0], nx = b.st[1];
        if (nloc == 0u) { xcd_barrier_complete(bar, b.x, nloc, nx); b.st[0] = nloc; b.st[1] = nx; }
        const unsigned old = xb_add(&bar[XB_XSUB(b.x)], 1u);
        const unsigned gen = old / nloc;
        if (old + 1u == (gen + 1u) * nloc) {
            __builtin_amdgcn_fence(__ATOMIC_RELEASE, "agent");
            asm volatile("s_waitcnt vmcnt(0)" ::: "memory");
            const unsigned og = xb_add(&bar[XB_TOP], 1u);
            const unsigned tg = og / nx;
            if (og + 1u == (tg + 1u) * nx) xb_add(&bar[XB_TOPGEN], 1u);
            else XB_SPIN(xb_ld(&bar[XB_TOPGEN]) == tg, bar);
            __builtin_amdgcn_fence(__ATOMIC_ACQUIRE, "agent");
            xb_add(&bar[XB_XGEN(b.x)], 1u);
            asm volatile("s_waitcnt vmcnt(0)" ::: "memory");
        } else {
            XB_SPIN(xb_ld(&bar[XB_XGEN(b.x)]) == gen, bar);
            __builtin_amdgcn_fence(__ATOMIC_ACQUIRE, "agent");
            asm volatile("s_waitcnt vmcnt(0)" ::: "memory");
        }
    }
    __syncthreads();
}

struct Args { const float* in[12]; float* out; unsigned char* ws; int ph_lo, ph_hi, nbc, pad; };

__device__ __forceinline__ void f_item(LAS unsigned char* lds, const bf16* hb, const bf16* Wf, const float* bfv, const float* rowss, float* CL, float* TOT, int item, int wid, int lane) {
    const int b = item >> 6, blk = item & 63, fr = lane & 15, fq = lane >> 4;
    const int tok0 = b * SQ + blk * 128 + wid * 16;
    f32x4 acc = (f32x4){0.f, 0.f, 0.f, 0.f};
    const bf16* xa = hb + (size_t)(tok0 + fr) * DM + fq * 8; const bf16* wb = Wf + (size_t)fr * DM + fq * 8;
#pragma unroll 1
    for (int k8 = 0; k8 < 4; ++k8) { bf16x8 a8[8], w8[8];
#pragma unroll
        for (int q = 0; q < 8; ++q) { a8[q] = *(const bf16x8*)(xa + (k8 * 8 + q) * 32); w8[q] = *(const bf16x8*)(wb + (k8 * 8 + q) * 32); }
        asm volatile("" : "+v"(a8[0]), "+v"(a8[1]), "+v"(a8[2]), "+v"(a8[3]), "+v"(a8[4]), "+v"(a8[5]), "+v"(a8[6]), "+v"(a8[7]));
#pragma unroll
        for (int q = 0; q < 8; ++q) acc = __builtin_amdgcn_mfma_f32_16x16x32_bf16(a8[q], w8[q], acc, 0, 0, 0); }
    const float bias = bfv[fr]; float s[4]; float run = 0.f;
#pragma unroll
    for (int e = 0; e < 4; ++e) { const float rs = __builtin_amdgcn_rsqf(rowss[tok0 + 4 * fq + e] * (1.0f / 1024.0f) + 1e-6f); const float f = acc[e] * rs + bias;
        const float ls = fminf(f, 0.f) - log1pf(__expf(-fabsf(f))); run += ls; s[e] = run; }
    float pre = 0.f;
#pragma unroll
    for (int j = 0; j < 3; ++j) { const float tj = xl_from_lane(run, fr + 16 * j); if (j < fq) pre += tj; }
    LAS float* wtot = (LAS float*)lds;
    if (fq == 3) wtot[wid * 16 + fr] = pre + run;
    __syncthreads();
    float wpre = 0.f, all = 0.f;
#pragma unroll
    for (int w = 0; w < 8; ++w) { const float t = wtot[w * 16 + fr]; all += t; if (w < wid) wpre += t; }
    const float base = wpre + pre;
    *(f32x4*)(CL + (size_t)(b * 16 + fr) * SQ + blk * 128 + wid * 16 + 4 * fq) = (f32x4){base + s[0], base + s[1], base + s[2], base + s[3]};
    if (wid == 0 && fq == 0) TOT[(b * 16 + fr) * 64 + blk] = all;
    __syncthreads();
}

__device__ __forceinline__ unsigned offb(unsigned row, unsigned ch) { return 256u * row + 16u * (ch ^ (((row & 3) << 2) | ((row >> 2) & 3))); }
__device__ __forceinline__ int crow(int r, int hi) { return (r & 3) + 8 * (r >> 2) + 4 * hi; }
__device__ __forceinline__ int t5_bucket(int dist) {
    if (dist < 16) return dist;
    int b = 16;
    b += dist >= 22; b += dist >= 30; b += dist >= 40; b += dist >= 54; b += dist >= 73; b += dist >= 99; b += dist >= 134; b += dist >= 182;
    b += dist >= 246; b += dist >= 332; b += dist >= 450; b += dist >= 609; b += dist >= 825; b += dist >= 1117; b += dist >= 1513;
    return b;
}
#define BATT_DECODE(IT, KG, UG, LSEP, DD, RR, PP, GH) do { const int bl_ = (IT) / 768, r_ = (IT) % 768, g_ = r_ >> 8, h_ = (r_ >> 5) & 7, pi_ = r_ & 31; \
    DD = (g_ == 0) ? 1 : (g_ == 1) ? 4 : 16; const int ppr_ = 32 / DD; RR = pi_ / ppr_; PP = pi_ % ppr_; GH = g_ * 8 + h_; \
    KG = KV + ((((size_t)(b0 + bl_) * 3 + g_) * 2) * 8 + h_) * ((size_t)SQ * 128); UG = (bl_ < 2 ? U + (size_t)bl_ * SQ * BIN : U2 + (size_t)(bl_ - 2) * SQ * BIN) + g_ * 1024 + h_ * 128; LSEP = LSE + (size_t)bl_ * SQ * 24; } while (0)
#define BATT_LOADK(KG, DD, RR, PP) do { const long koff_ = ((long)(RR) * (SQ / (DD)) + 256 * (PP) - 128 + row0) * 128 + ch0 * 8; const long kstr_ = 4096; \
    _Pragma("unroll") for (int i = 0; i < 12; ++i) kreg[i] = ((PP) > 0 || i >= 4) ? *(const v4u*)((KG) + koff_ + i * kstr_) : (v4u){0u, 0u, 0u, 0u}; } while (0)
__device__ __forceinline__ void battn_phase(LAS unsigned char* lds, const bf16* KV, bf16* U, bf16* U2, float* LSE, const float* relb, int b0, int nitems, int vcu, int G, int tid_in, int wid, int reps) {
    int row0, ch0;
    { int t0 = tid_in; asm volatile("" : "+v"(t0)); row0 = t0 >> 4; ch0 = t0 & 15; }
    LAS float* lut = (LAS float*)(lds + 98304);
    LAS float* wsf = (LAS float*)(lds + 98304 + 1024) + wid * 32;
    LAS bf16* stg = (LAS bf16*)(lds + 98304 + 2048 + wid * 4096);
    const int total = nitems * reps;
    int it = vcu; if (it >= total) return;
    const bf16* Kg; bf16* Ug; float* LSEp; int d, rr, pp, gh;
    v4u kreg[12];
    { const int itm = it % nitems; BATT_DECODE(itm, Kg, Ug, LSEp, d, rr, pp, gh); BATT_LOADK(Kg, d, rr, pp); }
    for (;;) {
        const bool dry = it + nitems < total;
        int tid = tid_in; asm volatile("" : "+v"(tid));
        const int lane = tid & 63, r32 = lane & 31, hi = lane >> 5; const unsigned loff = offb((unsigned)(tid >> 4), (unsigned)(tid & 15));
        bf16x8 qf[8];
        { const size_t qtok_ = (size_t)((256 * pp + 32 * wid + r32) * d + rr);
#pragma unroll
          for (int d0 = 0; d0 < 8; ++d0) qf[d0] = *(const bf16x8*)(Ug + qtok_ * BIN + d0 * 16 + hi * 8); }
        if (tid < 192) { const int rel_ = tid - 32; lut[tid] = (rel_ >= 0 && rel_ <= 128) ? relb[t5_bucket(rel_ * d) * 24 + gh] * LOG2E : 0.f; }
#pragma unroll
        for (int i = 0; i < 12; ++i) *(LAS v4u*)(lds + i * 8192 + loff) = kreg[i];
        __syncthreads();
        v4u vreg[12];
        { const long koff_ = ((long)rr * (SQ / d) + 256 * pp - 128 + (tid >> 4)) * 128 + (tid & 15) * 8; const long kstr_ = 4096;
#pragma unroll
          for (int i = 0; i < 12; ++i) vreg[i] = (pp > 0 || i >= 4) ? *(const v4u*)(Kg + (size_t)8 * SQ * 128 + koff_ + i * kstr_) : (v4u){0u, 0u, 0u, 0u}; }
        f32x16 s[5];
        const unsigned xr = ((r32 & 3) << 2) | ((r32 >> 2) & 3);
#pragma unroll
        for (int kb = 0; kb < 5; ++kb) { s[kb] = (f32x16){0.f,0.f,0.f,0.f,0.f,0.f,0.f,0.f,0.f,0.f,0.f,0.f,0.f,0.f,0.f,0.f};
            const LAS unsigned char* tb = lds + (wid + kb) * 8192 + 256 * r32;
#pragma unroll
            for (int d0 = 0; d0 < 8; ++d0) { const bf16x8 kf = *(const LAS bf16x8*)(tb + 16 * ((unsigned)(2 * d0 + hi) ^ xr)); s[kb] = __builtin_amdgcn_mfma_f32_32x32x16_bf16(kf, qf[d0], s[kb], 0, 0, 0); } }
        float mx = -INFINITY;
        const int e_ = r32 - 4 * hi; const LAS float* lp = lut + (e_ + 32);
#pragma unroll
        for (int kb = 0; kb < 5; ++kb) {
            if (pp == 0 && wid + kb < 4) {
#pragma unroll
                for (int r = 0; r < 16; ++r) s[kb][r] = -INFINITY;
            } else {
#pragma unroll
                for (int r = 0; r < 16; ++r) { const int cr = (r & 3) + 8 * (r >> 2); float v = s[kb][r] + lp[128 - 32 * kb - cr];
                    if (kb == 0) v = (e_ <= cr) ? v : -INFINITY;
                    if (kb == 4) v = (e_ >= cr) ? v : -INFINITY;
                    s[kb][r] = v; mx = fmaxf(mx, v); }
            }
        }
        mx = xr_max<32>(mx);
        float l = 0.f;
#pragma unroll
        for (int kb = 0; kb < 5; ++kb)
#pragma unroll
            for (int r = 0; r < 16; ++r) { const float p = __builtin_amdgcn_exp2f(s[kb][r] - mx); s[kb][r] = p; l += p; }
        l = xr_sum<32>(l);
        bf16x8 pf[5][2];
#pragma unroll
        for (int kb = 0; kb < 5; ++kb)
#pragma unroll
            for (int ks = 0; ks < 2; ++ks) { v4u w; w.x = cvtpk(s[kb][8 * ks + 0], s[kb][8 * ks + 1]); w.y = cvtpk(s[kb][8 * ks + 2], s[kb][8 * ks + 3]); w.z = cvtpk(s[kb][8 * ks + 4], s[kb][8 * ks + 5]); w.w = cvtpk(s[kb][8 * ks + 6], s[kb][8 * ks + 7]);
                pf[kb][ks] = __builtin_bit_cast(bf16x8, w); }
        __syncthreads();
#pragma unroll
        for (int i = 0; i < 12; ++i) *(LAS v4u*)(lds + i * 8192 + loff) = vreg[i];
        if (hi == 0) wsf[r32] = __builtin_amdgcn_rcpf(l);
        __syncthreads();
        bf16* const Uc = Ug; float* const Lc = LSEp; const int dc = d, rrc = rr, ppc = pp, ghc = gh;
        const int nit = it + G; const bool has_next = nit < total;
        if (has_next) { const int itm = nit % nitems; BATT_DECODE(itm, Kg, Ug, LSEp, d, rr, pp, gh); BATT_LOADK(Kg, d, rr, pp); }
        f32x16 o[4];
        int l2 = lane; asm volatile("" : "+v"(l2));
        const unsigned blk = (l2 >> 4) & 1, qq = (l2 & 15) >> 2, p4 = l2 & 3;
#pragma unroll
        for (int c = 0; c < 4; ++c) { o[c] = (f32x16){0.f,0.f,0.f,0.f,0.f,0.f,0.f,0.f,0.f,0.f,0.f,0.f,0.f,0.f,0.f,0.f};
#pragma unroll
            for (int kb = 0; kb < 5; ++kb)
#pragma unroll
                for (int ks = 0; ks < 2; ++ks) { s16x4 vv[2];
#pragma unroll
                    for (int t = 0; t < 2; ++t) { const unsigned row = 16 * ks + 8 * t + 4 * hi + qq; const LAS unsigned char* ap = lds + (wid + kb) * 8192 + offb(row, 4 * c + 2 * blk + (p4 >> 1)) + 8 * (p4 & 1);
                        vv[t] = __builtin_bit_cast(s16x4, __builtin_amdgcn_ds_read_tr16_b64_v4i16((LAS s16x4*)ap)); }
                    const bf16x8 vf = (bf16x8){vv[0][0], vv[0][1], vv[0][2], vv[0][3], vv[1][0], vv[1][1], vv[1][2], vv[1][3]};
                    o[c] = __builtin_amdgcn_mfma_f32_32x32x16_bf16(pf[kb][ks], vf, o[c], 0, 0, 0); } }
        float rl[16];
#pragma unroll
        for (int r = 0; r < 16; ++r) rl[r] = wsf[crow(r, hi)];
#pragma unroll
        for (int hc = 0; hc < 2; ++hc) {
#pragma unroll
            for (int r = 0; r < 16; ++r) { const int qr_ = crow(r, hi);
#pragma unroll
                for (int cc = 0; cc < 2; ++cc) stg[qr_ * 64 + cc * 32 + r32] = (bf16)cvtpk(o[2 * hc + cc][r] * rl[r], 0.f); }
#pragma unroll
            for (int i = 0; i < 4; ++i) { const int row = i * 8 + (l2 >> 3), ch = l2 & 7; const v4u v = *(const LAS v4u*)(stg + row * 64 + ch * 8);
                const size_t tok = (size_t)((256 * ppc + 32 * wid + row) * dc + rrc); if (!dry) *(v4u*)(Uc + tok * BIN + hc * 64 + ch * 8) = v; }
        }
        if (hi == 0 && !dry) Lc[(size_t)((256 * ppc + 32 * wid + r32) * dc + rrc) * 24 + ghc] = mx + __builtin_amdgcn_logf(l);
        __syncthreads();
        if (!has_next) break;
        it = nit;
    }
}
#ifndef PHASE_MASK
#define PHASE_MASK 0xffff
#endif
#define EN(k) ((PHASE_MASK >> (k)) & 1)
#ifndef PROBE_GEMM_REPS
#define PROBE_GEMM_REPS 1
#endif
#ifndef PROBE_BATT_REPS
#define PROBE_BATT_REPS 1
#endif
#ifndef PROBE_RES_REPS
#define PROBE_RES_REPS 1
#endif
#ifndef PROBE_MEM_REPS
#define PROBE_MEM_REPS 1
#endif
#ifndef PROBE_ATT_REPS
#define PROBE_ATT_REPS 1
#endif
enum { K_PRO = 0, K_AIN, K_AATT, K_AOUT, K_KV, K_BIN, K_BATT, K_BMRG, K_BOUT, K_FIN };
__global__ void __launch_bounds__(NTHR, 2) yoco_fwd(Args args) {
    extern __shared__ __attribute__((aligned(16))) unsigned char lds_raw[];
    cg::grid_group grid = cg::this_grid();
    LAS unsigned char* lds = (LAS unsigned char*)lds_raw;
    const int wid0 = __builtin_amdgcn_readfirstlane(threadIdx.x >> 6);
#define INP(k) ({ int k_ = (k); asm volatile("" : "+s"(k_)); (const float*)(GAS const float*)args.in[k_]; })
    volatile LAS unsigned* bst = (volatile LAS unsigned*)((LAS unsigned char*)lds_raw + LDS_BYTES - 64);
    if (threadIdx.x < 2) bst[threadIdx.x] = 0u;
    __syncthreads();
    (void)xcd_barrier_post((unsigned*)(args.ws + WS_BAR), bst);

    for (int ph = args.ph_lo; ; ++ph) {
        int G = gridDim.x; asm volatile("" : "+s"(G)); int bx = blockIdx.x; asm volatile("" : "+s"(bx)); int nbc = args.nbc; asm volatile("" : "+s"(nbc));
        const int vcu = (G % 8 == 0) ? (bx % 8) * (G / 8) + bx / 8 : bx;
        const int lnch = (nbc == 8) ? 0 : (nbc == 4) ? 1 : (nbc == 2) ? 2 : 3, nch = 1 << lnch;
        const int n_phase = 8 + 6 * nch + 1;
        const int NGW = G * NWAVES;
        if (ph >= args.ph_hi || ph >= n_phase) break;
        int kind, layer = 0, chunk = 0;
        if (ph == 0) kind = K_PRO;
        else if (ph < 7) { layer = (ph - 1) / 3; kind = K_AIN + (ph - 1) % 3; }
        else if (ph == 7) kind = K_KV;
        else if (ph < 8 + 6 * nch) { const int q = ph - 8, j = q / 3; layer = j >> lnch; chunk = j & (nch - 1); kind = K_BATT + (q - 3 * j); }
        else kind = K_FIN;

        for (int pass_ = 0; pass_ < 2; ++pass_) {
        if (pass_ == 1) { if (kind != K_BOUT && kind != K_KV) break; const int j = (kind == K_KV) ? 0 : (layer << lnch) + chunk + 1; if (j >= 2 * nch) break; layer = j >> lnch; chunk = j & (nch - 1); kind = K_BIN; }
        int tid; asm volatile("v_mbcnt_lo_u32_b32 %0, -1, 0\n\tv_mbcnt_hi_u32_b32 %0, -1, %0" : "=v"(tid)); tid += wid0 * 64;
        GAS unsigned char* ws = (GAS unsigned char*)args.ws; asm volatile("" : "+s"(ws)); GAS float* outg = (GAS float*)args.out; asm volatile("" : "+s"(outg)); float* out = (float*)outg; bf16* HB = (bf16*)out; bf16* LOP = HB + (size_t)MT * DM;
        const int lane = tid & 63, wid = __builtin_amdgcn_readfirstlane(tid >> 6); const int gw = vcu * NWAVES + wid;
        if (EN(K_PRO) && kind == K_PRO) {
            const float* x = INP(0); const float* norm_a = INP(2); const float* w_in_a = INP(3); const float* w_out_a = INP(5); const float* norm_kv = INP(6); const float* w_kv = INP(7); const float* norm_b = INP(8); const float* w_in_b = INP(9); const float* w_out_b = INP(10);
            for (int rp_ = 0; rp_ < PROBE_MEM_REPS; ++rp_) {
            LAS float* scr = (LAS float*)(lds + wid * 16384);
            constexpr int I_INA = 16 * 128, I_OUT = 16 * 32, I_KV = 16 * 192, I_INB = 16 * 128;
            constexpr int NITEMS = 2 * I_INA + 2 * I_OUT + I_KV + 2 * I_INB + 2 * I_OUT + 32;
#pragma unroll 1
            for (int it = gw; it < NITEMS; it += NGW) {
                int r = it;
                if (r < 2 * I_INA) { const int i = r / I_INA; p0_transpose_item(w_in_a + (size_t)i * DM * FOX_IN, DM, FOX_IN, 128, norm_a + i * DM, (bf16*)(ws + WS_WINA + (size_t)i * 8 * MiB), scr, r % I_INA, lane); continue; } r -= 2 * I_INA;
                if (r < 2 * I_OUT) { const int i = r / I_OUT; p0_transpose_item(w_out_a + (size_t)i * DM * DM, DM, DM, 32, nullptr, (bf16*)(ws + WS_WOUTA + (size_t)i * 2 * MiB), scr, r % I_OUT, lane); continue; } r -= 2 * I_OUT;
                if (r < I_KV) { p0_transpose_item(w_kv, DM, KVW, 192, norm_kv, (bf16*)(ws + WS_WKV), scr, r, lane); continue; } r -= I_KV;
                if (r < 2 * I_INB) { const int i = r / I_INB; p0_transpose_item(w_in_b + (size_t)i * DM * BIN, DM, BIN, 128, norm_b + i * DM, (bf16*)(ws + WS_WINB + (size_t)i * 8 * MiB), scr, r % I_INB, lane); continue; } r -= 2 * I_INB;
                if (r < 2 * I_OUT) { const int i = r / I_OUT; p0_transpose_item(w_out_b + (size_t)i * DM * DM, DM, DM, 32, nullptr, (bf16*)(ws + WS_WOUTB + (size_t)i * 2 * MiB), scr, r % I_OUT, lane); continue; } r -= 2 * I_OUT;
                { const int i = r >> 4, n = r & 15;
#pragma unroll 4
                  for (int j = 0; j < 16; ++j) { const int k = lane + 64 * j; ((bf16*)(ws + WS_WF))[(i * 16 + n) * DM + k] = (bf16)f2bf(norm_a[i * DM + k] * w_in_a[(size_t)i * DM * FOX_IN + (size_t)k * FOX_IN + 4096 + n]); } }
            }
            float* RS0 = (float*)(ws + WS_RS0);
#pragma unroll 1
            for (int m = gw; m < MT; m += NGW) {
                const f32x4* xr = (const f32x4*)(x + (size_t)m * DM) + lane; unsigned long long* hrow = (unsigned long long*)(HB + (size_t)m * DM) + lane;
                f32x4 v[4]; float s = 0.f;
#pragma unroll
                for (int j = 0; j < 4; ++j) v[j] = xr[64 * j];
                asm volatile("" : "+v"(v[0]), "+v"(v[1]), "+v"(v[2]), "+v"(v[3]));
#pragma unroll
                for (int j = 0; j < 4; ++j) s += (v[j].x * v[j].x + v[j].y * v[j].y) + (v[j].z * v[j].z + v[j].w * v[j].w);
                s = wave_sum(s);
#pragma unroll
                for (int j = 0; j < 4; ++j) { const unsigned h0 = cvtpk(v[j].x, v[j].y), h1 = cvtpk(v[j].z, v[j].w);
                    hrow[64 * j] = (unsigned long long)h0 | ((unsigned long long)h1 << 32); }
                if (lane == 0) RS0[m] = s;
            }
            }
        }
        else if (EN(K_AIN) && (kind == K_AIN || kind == K_KV || kind == K_BIN)) {
            pg8::Gemm g; pg8::EpiBf16Row E;
            if (kind == K_AIN) {
                const float* rs = (const float*)(ws + (layer == 0 ? WS_RS0 : WS_RS1));
#pragma unroll 1
                for (int it = vcu; it < 512; it += G)
                    f_item(lds, HB, (const bf16*)(ws + WS_WF) + (size_t)layer * 16 * DM, INP(4) + layer * 16, rs, (float*)(ws + WS_CL), (float*)(ws + WS_TOT), it, wid, lane);
                g = pg8::Gemm{HB, (const bf16*)(ws + WS_WINA + (size_t)layer * 8 * MiB), MT, 4096, DM, DM};
                E = pg8::EpiBf16Row{(bf16*)(ws + WS_Q), DM, rs, DM, (size_t)(WS_K - WS_Q) / 2, DM, C2A, nullptr, 0, 0, (unsigned*)(ws + WS_NRM) + (size_t)layer * 32768};
            } else if (kind == K_KV) {
                g = pg8::Gemm{HB, (const bf16*)(ws + WS_WKV), MT, KVW, DM, DM};
                E = pg8::EpiBf16Row{(bf16*)(ws + WS_KV), KVW, (const float*)(ws + WS_RS2), 0, 0, 0, 1.f, nullptr, 0, 1, nullptr};
            } else {
                const size_t row0 = (size_t)chunk * nbc * SQ;
                g = pg8::Gemm{HB + row0 * DM, (const bf16*)(ws + WS_WINB + (size_t)layer * 8 * MiB), nbc * SQ, BIN, DM, DM};
                E = pg8::EpiBf16Row{(bf16*)(ws + WS_U), BIN, (const float*)(ws + (layer == 0 ? WS_RS2 : WS_RS3)) + row0, 0, 0, 3072, C2B, HB + (size_t)MT * DM, U_SPLIT_ROWS, 0, nullptr};
            }
            pg8::StaticOrder S; S.init(g.M, g.N, G, bx);
            for (int rep_ = 0; rep_ < PROBE_GEMM_REPS; ++rep_) pg8::gemm_phase<pg8::EpiBf16Row, pg8::StaticOrder, true, true>(lds, g, S, E, tid);
        }
        else if (EN(K_AATT) && kind == K_AATT) {
            const attn_body::AttnTensors AT{(const attn_body::bf16*)(ws + WS_Q), (const attn_body::bf16*)(ws + WS_K), (const attn_body::bf16*)(ws + WS_V), (attn_body::bf16*)(ws + WS_O),
                                            (const attn_body::bf16*)(ws + WS_G), (const float*)(ws + WS_CL), (const float*)(ws + WS_TOT), (const float*)(ws + WS_NRM) + (size_t)layer * 32768};
            const attn_body::DynOrder S{(unsigned*)(ws + WS_QH) + layer * 512, (int)(__builtin_amdgcn_s_getreg((3 << 11) | 20) & 7), wid0, (LAS unsigned*)(lds + attn_body::LDS_REL + 260)};
            if (tid == 0) *S.slot = 0xfffffffeu;
            __syncthreads();
            attn_body::attn_phase<attn_body::DynOrder, 24>((char*)lds_raw, AT, S);
#if PROBE_ATT_REPS > 1
            { const attn_body::DynOrder S2{(unsigned*)(ws + WS_QH) + 1024 + layer * 512, S.xcc, wid0, S.slot}; __syncthreads(); attn_body::attn_phase<attn_body::DynOrder, 24>((char*)lds_raw, AT, S2); }
#endif

        }
        else if (EN(K_AOUT) && (kind == K_AOUT || kind == K_BOUT)) {
            pg8::Gemm g; pg8::EpiResid E;
            if (kind == K_AOUT) {
                g = pg8::Gemm{(const bf16*)(ws + WS_O), (const bf16*)(ws + WS_WOUTA + (size_t)layer * 2 * MiB), MT, DM, DM, DM};
                E = pg8::EpiResid{HB, LOP, nullptr, (float*)(ws + (layer == 0 ? WS_RS1 : WS_RS2)), DM, 0, layer == 0 ? INP(0) : (const float*)nullptr};
            } else {
                const size_t row0 = (size_t)chunk * nbc * SQ;
                g = pg8::Gemm{(const bf16*)(ws + WS_MA), (const bf16*)(ws + WS_WOUTB + (size_t)layer * 2 * MiB), nbc * SQ, DM, DM, DM};
                E = pg8::EpiResid{HB + row0 * DM, LOP + row0 * DM, layer == 0 ? (float*)nullptr : (float*)(ws + WS_KV) + (size_t)chunk * nbc * pg8::FIN_BSTRIDE, layer == 0 ? (float*)(ws + WS_RS3) + row0 : (float*)nullptr, DM, 0, nullptr};
            }
            pg8::StaticOrder S; S.init(g.M, g.N, G, bx);
#if PROBE_RES_REPS > 1
            { pg8::EpiResid E2 = E; E2.dry = 1; pg8::gemm_phase<pg8::EpiResid, pg8::StaticOrder, true, true>(lds, g, S, E2, tid); }
#endif
            pg8::gemm_phase<pg8::EpiResid, pg8::StaticOrder, true, true>(lds, g, S, E, tid);
        }
        else if (EN(K_BATT) && kind == K_BATT) {
            battn_phase(lds, (const bf16*)(ws + WS_KV), (bf16*)(ws + WS_U), HB + (size_t)MT * DM, (float*)(ws + WS_LSE), INP(1), chunk * nbc, nbc * 768, vcu, G, tid, wid, PROBE_BATT_REPS);
        }
        else if (EN(K_BMRG) && kind == K_BMRG) {
            const float* LSE = (const float*)(ws + WS_LSE); const bf16* U = (const bf16*)(ws + WS_U);
#pragma unroll 1
            for (int m = gw; m < nbc * SQ; m += NGW) {
                const int hh = lane >> 3; const float* lp = LSE + (size_t)m * 24 + hh;
                float l0 = lp[0], l1 = lp[8], l2 = lp[16];
                const bf16* urow = (m < U_SPLIT_ROWS ? U + (size_t)m * BIN : (const bf16*)(HB + (size_t)MT * DM) + (size_t)(m - U_SPLIT_ROWS) * BIN) + 16 * lane;
                v4u a[2], b[2], c[2], gt[2];
#pragma unroll
                for (int j = 0; j < 2; ++j) { a[j] = *(const v4u*)(urow + 8 * j); b[j] = *(const v4u*)(urow + 1024 + 8 * j); c[j] = *(const v4u*)(urow + 2048 + 8 * j); gt[j] = *(const v4u*)(urow + 3072 + 8 * j); }
                asm volatile("" : "+v"(l0), "+v"(l1), "+v"(l2), "+v"(a[0]), "+v"(a[1]), "+v"(b[0]), "+v"(b[1]), "+v"(c[0]), "+v"(c[1]), "+v"(gt[0]), "+v"(gt[1]));
                const float mxl = fmaxf(l0, fmaxf(l1, l2));
                float w0 = __builtin_amdgcn_exp2f(l0 - mxl), w1 = __builtin_amdgcn_exp2f(l1 - mxl), w2 = __builtin_amdgcn_exp2f(l2 - mxl); const float inv = __builtin_amdgcn_rcpf(w0 + w1 + w2); w0 *= inv; w1 *= inv; w2 *= inv;
#pragma unroll
                for (int j = 0; j < 2; ++j) { v4u o;
#pragma unroll
                    for (int e = 0; e < 4; ++e) { const float v0 = (w0 * bflo(a[j][e]) + w1 * bflo(b[j][e]) + w2 * bflo(c[j][e])) * silu_f(bflo(gt[j][e])), v1 = (w0 * bfhi(a[j][e]) + w1 * bfhi(b[j][e]) + w2 * bfhi(c[j][e])) * silu_f(bfhi(gt[j][e])); o[e] = cvtpk(v0, v1); }
                    *(v4u*)((bf16*)(ws + WS_MA) + (size_t)m * DM + 16 * lane + 8 * j) = o; }
            }
        }
        else if (EN(K_FIN) && kind == K_FIN) {
            const f32x4* gp0 = (const f32x4*)INP(11) + lane;
            for (int rp_ = 0; rp_ < PROBE_MEM_REPS; ++rp_)
#pragma unroll 1
            for (int m = gw; m < MT; m += NGW) {
                f32x4* orow = (f32x4*)(out + (size_t)m * DM) + lane; f32x4 v[4]; float s = 0.f;
                const f32x4* irow = (const f32x4*)((const float*)(ws + WS_KV) + (size_t)(m >> 13) * pg8::FIN_BSTRIDE + (size_t)(m & 8191) * DM) + lane;
#pragma unroll
                for (int j = 0; j < 4; ++j) v[j] = irow[64 * j];
                f32x4 gfin[4];
#pragma unroll
                for (int j = 0; j < 4; ++j) gfin[j] = gp0[64 * j];
                asm volatile("" : "+v"(v[0]), "+v"(v[1]), "+v"(v[2]), "+v"(v[3]), "+v"(gfin[0]), "+v"(gfin[1]), "+v"(gfin[2]), "+v"(gfin[3]));
#pragma unroll
                for (int j = 0; j < 4; ++j) s += (v[j].x * v[j].x + v[j].y * v[j].y) + (v[j].z * v[j].z + v[j].w * v[j].w);
                const float rs = 1.0f / sqrtf(wave_sum(s) * (1.0f / 1024.0f) + 1e-6f);
#pragma unroll
                for (int j = 0; j < 4; ++j) orow[64 * j] = v[j] * rs * gfin[j];
            }
        }
        }
        if (ph + 1 < args.ph_hi && ph + 1 < n_phase) { if (args.ph_lo > (1 << 24)) grid.sync();
            { XcdBarrier xbar; xbar.bar = (unsigned*)(args.ws + WS_BAR); xbar.x = xb_xcc_id(); xbar.st = bst; xcd_barrier(xbar); } }
    }
}

extern "C" void kernel_launch(void* const* d_in, const int* in_sizes, int n_in, void* d_out, int out_size, void* d_ws, size_t ws_size, hipStream_t stream) {
    static int grid = 0, nbc = 1;
    if (grid == 0) {
        if (n_in != 12 || in_sizes[0] != MT * DM || out_size != MT * DM || ws_size < WS_END) { fprintf(stderr, "kernel_launch: unexpected shapes / workspace (n_in %d, ws %zu); nothing launched\n", n_in, ws_size); grid = -1; return; }
        int dev = 0, cus = 0, per_cu = 0;
        if (hipGetDevice(&dev) != hipSuccess || hipDeviceGetAttribute(&cus, hipDeviceAttributeMultiprocessorCount, dev) != hipSuccess) { grid = -1; return; }
        if (hipFuncSetAttribute((const void*)yoco_fwd, hipFuncAttributeMaxDynamicSharedMemorySize, LDS_BYTES) != hipSuccess) { fprintf(stderr, "kernel_launch: hipFuncSetAttribute failed\n"); grid = -1; return; }
        if (hipOccupancyMaxActiveBlocksPerMultiprocessor(&per_cu, (const void*)yoco_fwd, NTHR, LDS_BYTES) != hipSuccess || per_cu < 1) { fprintf(stderr, "kernel_launch: occupancy query gave %d\n", per_cu); per_cu = 1; }
        (void)hipGetLastError();
        grid = cus;
        nbc = 4;
    }
    if (grid < 0) return;
    (void)hipMemsetAsync((char*)d_ws, 0, CTL_ZERO_BYTES, stream);
    Args a{};
    for (int i = 0; i < 12; ++i) a.in[i] = (const float*)d_in[i];
    a.out = (float*)d_out; a.ws = (unsigned char*)d_ws; a.ph_lo = 0; a.ph_hi = 1 << 20; a.nbc = nbc; a.pad = 0;
    void* kargs[] = {&a};
    hipError_t e = hipLaunchCooperativeKernel((const void*)yoco_fwd, dim3(grid), dim3(NTHR), kargs, LDS_BYTES, stream);
    if (e != hipSuccess) fprintf(stderr, "kernel_launch: cooperative launch failed: %s (grid %d)\n", hipGetErrorString(e), grid);
}
```
